# Optimizing an MI355X kernel written in HIP

```python
import math
import jax, jax.numpy as jnp
from jax import lax
import numpy as np

D_MODEL = 2048
BATCH = 4
SEQ = 4096
DEPTH = 1

GRID_W = 64
CTX_LEN = 256
HA_HEADS = 8
HA_DK = 128
HA_DV = 128
GB_HEADS = 8
GB_DK = 128
GB_DV = 128
CONV_K = 5
CHUNK = 64
N_EXPERTS = 16
CAPACITY_FACTOR = 2
D_EXPERT = 1024
NORM_EPS = 1e-6

HA_QK = HA_HEADS * HA_DK
HA_V = HA_HEADS * HA_DV
GB_QK = GB_HEADS * GB_DK
GB_V = GB_HEADS * GB_DV
GB_QKV = 2 * GB_QK + GB_V
IN_SPLITS = (HA_QK, HA_QK, HA_QK, HA_V, HA_V, GB_QKV, GB_V, 2 * GB_HEADS, 2 * GB_HEADS, 2 * D_MODEL)
N_IN = sum(IN_SPLITS)
SPLIT_POINTS = tuple(sum(IN_SPLITS[:k]) for k in range(1, len(IN_SPLITS)))

kernel_name = 'hybrid_hgrn2_gdn_ec_moe_dit_layer'


def rms_norm(x, gain):
    xf = x.astype(jnp.float32)
    y = xf * lax.rsqrt(jnp.mean(xf * xf, axis=-1, keepdims=True) + NORM_EPS)
    return (y * gain.astype(jnp.float32)).astype(x.dtype)


def head_rms_norm(o, gain, n_heads):
    b, t, w = o.shape
    oh = o.reshape(b, t, n_heads, w // n_heads)
    oh = oh * lax.rsqrt(jnp.mean(oh * oh, axis=-1, keepdims=True) + NORM_EPS)
    return oh.reshape(b, t, w) * gain.astype(jnp.float32)


def l2_normalize(a):
    return a * lax.rsqrt(jnp.sum(a * a, axis=-1, keepdims=True) + NORM_EPS)


def to_heads(a, n_heads):
    b, t, w = a.shape
    return a.reshape(b, t, n_heads, w // n_heads).transpose(0, 2, 1, 3)


def from_heads(a):
    b, h, t, d = a.shape
    return a.transpose(0, 2, 1, 3).reshape(b, t, h * d)


def to_col_major(a, rows):
    b, t, w = a.shape
    return a.reshape(b, rows, GRID_W, w).transpose(0, 2, 1, 3).reshape(b, t, w)


def from_col_major(a, rows):
    b, t, w = a.shape
    return a.reshape(b, GRID_W, rows, w).transpose(0, 2, 1, 3).reshape(b, t, w)


def centred_depthwise_conv(a, w):
    return lax.conv_general_dilated(
        a, w.astype(a.dtype)[:, None, :], window_strides=(1,),
        padding=[(CONV_K // 2, CONV_K // 2)],
        dimension_numbers=('NWC', 'WIO', 'NWC'), feature_group_count=a.shape[-1])


def modulate(h, shift, scale):
    return h * (1 + scale) + shift


def _tril(inclusive):
    i = jnp.arange(CHUNK)
    return (i[:, None] >= i[None, :]) if inclusive else (i[:, None] > i[None, :])


def hgrn2_chunk(state, xs):
    q, k, v, g = xs
    G = jnp.cumsum(g, axis=2)
    mask = _tril(True)[:, :, None]
    diff = G[:, :, :, None, :] - G[:, :, None, :, :]
    decay = jnp.where(mask, jnp.exp(jnp.where(mask, diff, 0.0)), 0.0)
    scores = jnp.einsum('bhik,bhjk,bhijk->bhij', q, k, decay)
    o = (jnp.einsum('bhik,bhkv->bhiv', q * jnp.exp(G), state)
         + jnp.einsum('bhij,bhjv->bhiv', scores, v))
    G_last = G[:, :, -1, :]
    state = (jnp.exp(G_last)[..., None] * state
             + jnp.einsum('bhjk,bhjv->bhkv', k * jnp.exp(G_last[:, :, None, :] - G), v))
    return state, o


def gdn_chunk(state, xs):
    q, k, v, g, beta = xs
    G = jnp.cumsum(g, axis=-1)
    incl = _tril(True)
    strict = _tril(False)
    diff = G[..., :, None] - G[..., None, :]
    gamma = jnp.where(incl, jnp.exp(jnp.where(incl, diff, 0.0)), 0.0)
    kk = jnp.einsum('bhik,bhjk->bhij', k, k)
    m = jnp.eye(CHUNK, dtype=jnp.float32) + jnp.where(strict, beta[..., :, None] * kk * gamma, 0.0)
    rhs = jnp.concatenate([v * beta[..., None], k * (beta * jnp.exp(G))[..., None]], axis=-1)
    sol = lax.linalg.triangular_solve(m, rhs, left_side=True, lower=True, unit_diagonal=True)
    u, w = sol[..., :GB_DV], sol[..., GB_DV:]
    v_new = u - jnp.einsum('bhik,bhkv->bhiv', w, state)
    qk = jnp.einsum('bhik,bhjk->bhij', q, k) * gamma
    o = (jnp.einsum('bhik,bhkv->bhiv', q * jnp.exp(G)[..., None], state)
         + jnp.einsum('bhij,bhjv->bhiv', qk, v_new))
    G_last = G[..., -1]
    state = (jnp.exp(G_last)[..., None, None] * state
             + jnp.einsum('bhjk,bhjv->bhkv', k * jnp.exp(G_last[..., None] - G)[..., None], v_new))
    return state, o


def _scan_chunks(chunk_fn, state, seqs):
    b, h, t = seqs[0].shape[:3]
    n = t // CHUNK
    xs = tuple(jnp.moveaxis(a.reshape((b, h, n, CHUNK) + a.shape[3:]), 2, 0) for a in seqs)
    state, o = lax.scan(chunk_fn, state, xs)
    return state, jnp.moveaxis(o, 0, 2).reshape(b, h, t, o.shape[-1])


def _context_prefixed_scan(chunk_fn, state0, ctx_seqs, lat_seqs, reverse):
    if reverse:
        ctx_seqs = tuple(jnp.flip(a, axis=2) for a in ctx_seqs)
        lat_seqs = tuple(jnp.flip(a, axis=2) for a in lat_seqs)
    s_ctx, o_ctx = _scan_chunks(chunk_fn, state0, ctx_seqs)
    _, o_lat = _scan_chunks(chunk_fn, s_ctx, lat_seqs)
    if reverse:
        o_ctx = jnp.flip(o_ctx, axis=2)
        o_lat = jnp.flip(o_lat, axis=2)
    return o_ctx, o_lat


def hgrn2_branch(ctx_parts, lat_parts, lb_fwd, lb_bwd):
    def prep(q, f_logit, i, lower):
        f_logit = f_logit.astype(jnp.float32)
        lower = lower.astype(jnp.float32)
        f = lower + (1.0 - lower) * jax.nn.sigmoid(f_logit)
        k = (1.0 - lower) * jax.nn.sigmoid(-f_logit)
        return (to_heads(jax.nn.silu(q.astype(jnp.float32)), HA_HEADS), to_heads(k, HA_HEADS),
                to_heads(i.astype(jnp.float32), HA_HEADS), to_heads(jnp.log(f), HA_HEADS))
    qc, fcf, fcb, ic = ctx_parts
    ql, flf, flb, il = lat_parts
    s0 = jnp.zeros((qc.shape[0], HA_HEADS, HA_DK, HA_DV), jnp.float32)
    oc_f, ol_f = _context_prefixed_scan(hgrn2_chunk, s0, prep(qc, fcf, ic, lb_fwd), prep(ql, flf, il, lb_fwd), False)
    oc_b, ol_b = _context_prefixed_scan(hgrn2_chunk, s0, prep(qc, fcb, ic, lb_bwd), prep(ql, flb, il, lb_bwd), True)
    return from_heads(oc_f + oc_b), from_heads(ol_f + ol_b)


def gdn_branch(ctx_parts, lat_parts, conv_w, a_log, dt_bias):
    def prep(qkv, a_logit, b_logit):
        y = jax.nn.silu(centred_depthwise_conv(qkv, conv_w).astype(jnp.float32))
        q, k, v = jnp.split(y, [GB_QK, 2 * GB_QK], axis=-1)
        q = l2_normalize(to_heads(q, GB_HEADS)) * (GB_DK ** -0.5)
        k = l2_normalize(to_heads(k, GB_HEADS))
        v = to_heads(v, GB_HEADS)
        a_f, a_b = jnp.split(a_logit.astype(jnp.float32), 2, axis=-1)
        b_f, b_b = jnp.split(b_logit.astype(jnp.float32), 2, axis=-1)
        def gates(a, bl, d):
            g = -jnp.exp(a_log[d].astype(jnp.float32)) * jax.nn.softplus(a + dt_bias[d].astype(jnp.float32))
            return g.transpose(0, 2, 1), jax.nn.sigmoid(bl).transpose(0, 2, 1)
        g_f, beta_f = gates(a_f, b_f, 0)
        g_b, beta_b = gates(a_b, b_b, 1)
        return (q, k, v, g_f, beta_f), (q, k, v, g_b, beta_b)
    c_fwd, c_bwd = prep(*ctx_parts)
    l_fwd, l_bwd = prep(*lat_parts)
    s0 = jnp.zeros((ctx_parts[0].shape[0], GB_HEADS, GB_DK, GB_DV), jnp.float32)
    oc_f, ol_f = _context_prefixed_scan(gdn_chunk, s0, c_fwd, l_fwd, False)
    oc_b, ol_b = _context_prefixed_scan(gdn_chunk, s0, c_bwd, l_bwd, True)
    return from_heads(oc_f + oc_b), from_heads(ol_f + ol_b)


def token_mixer(h_lat, h_ctx, rows, need_ctx, w_in, conv_w, a_log, dt_bias, lb_fwd, lb_bwd,
                ha_gain, gb_gain, w_ba, w_bb, w_out):
    pl = jnp.split(h_lat @ w_in, SPLIT_POINTS, axis=-1)
    pc = jnp.split(h_ctx @ w_in, SPLIT_POINTS, axis=-1)
    oA_c, oA_l = hgrn2_branch((pc[0], pc[1], pc[2], pc[3]), (pl[0], pl[1], pl[2], pl[3]), lb_fwd, lb_bwd)
    lat_b = tuple(to_col_major(p, rows) for p in (pl[5], pl[7], pl[8]))
    oB_c, oB_l = gdn_branch((pc[5], pc[7], pc[8]), lat_b, conv_w, a_log, dt_bias)
    oB_l = from_col_major(oB_l, rows)

    def merge(oA, oB, parts, dtype):
        yA = head_rms_norm(oA * jax.nn.sigmoid(parts[4].astype(jnp.float32)), ha_gain, HA_HEADS).astype(dtype)
        yB = (head_rms_norm(oB, gb_gain, GB_HEADS) * jax.nn.silu(parts[6].astype(jnp.float32))).astype(dtype)
        gate_a, gate_b = jnp.split(jax.nn.sigmoid(parts[9]), 2, axis=-1)
        return (gate_a * (yA @ w_ba) + gate_b * (yB @ w_bb)) @ w_out

    y_lat = merge(oA_l, oB_l, pl, h_lat.dtype)
    y_ctx = merge(oA_c, oB_c, pc, h_ctx.dtype) if need_ctx else None
    return y_lat, y_ctx


def expert_choice_ffn(h, router_w, w_gate, w_up, w_down):
    b, n, d = h.shape
    cap = max(1, (CAPACITY_FACTOR * n) // N_EXPERTS)
    aff = jax.nn.softmax(jnp.einsum('bnd,de->bne', h, router_w).astype(jnp.float32), axis=-1)
    gate, idx = lax.top_k(jnp.swapaxes(aff, 1, 2), cap)
    xs = jax.vmap(lambda hb, ib: hb[ib])(h, idx)
    a = jnp.einsum('becd,edf->becf', xs, w_gate)
    u = jnp.einsum('becd,edf->becf', xs, w_up)
    y = jnp.einsum('becf,efd->becd', jax.nn.silu(a) * u, w_down) * gate[..., None].astype(h.dtype)
    return jax.vmap(lambda yb, ib: jnp.zeros((n, d), yb.dtype).at[ib.reshape(-1)].add(yb.reshape(-1, d)))(y, idx)


def setup_inputs(seed: int = 0) -> dict:
    key = jax.random.key(seed)
    ks = jax.random.split(key, 24)
    f32 = jnp.float32

    def nrm(k, shape, scale):
        return jax.random.normal(k, shape, f32) * scale

    dt = jnp.exp(jax.random.uniform(ks[12], (DEPTH, 2, GB_HEADS), f32, minval=math.log(1e-3), maxval=math.log(1e-1)))
    return {
        'x': nrm(ks[0], (BATCH, SEQ, D_MODEL), 1.0),
        'c': nrm(ks[1], (BATCH, D_MODEL), 1.0),
        'ctx': nrm(ks[2], (BATCH, CTX_LEN, D_MODEL), 1.0),
        'c_ctx': nrm(ks[3], (D_MODEL,), 1.0),
        'ada_w': nrm(ks[4], (DEPTH, D_MODEL, 6 * D_MODEL), 0.5 * D_MODEL ** -0.5),
        'ada_b': nrm(ks[5], (DEPTH, 6 * D_MODEL), 0.01),
        'norm_mix': 1.0 + nrm(ks[6], (DEPTH, D_MODEL), 0.02),
        'norm_ffn': 1.0 + nrm(ks[7], (DEPTH, D_MODEL), 0.02),
        'w_in': nrm(ks[8], (DEPTH, D_MODEL, N_IN), D_MODEL ** -0.5),
        'gdn_conv': nrm(ks[9], (DEPTH, CONV_K, GB_QKV), CONV_K ** -0.5),
        'gdn_a_log': jnp.log(jax.random.uniform(ks[10], (DEPTH, 2, GB_HEADS), f32, minval=1.0, maxval=16.0)),
        'gdn_dt_bias': dt + jnp.log(-jnp.expm1(-dt)),
        'hgrn_lb': 1.0 + nrm(ks[11], (2, DEPTH + 1, HA_QK), 0.1),
        'hgrn_norm': 1.0 + nrm(ks[13], (DEPTH, HA_V), 0.02),
        'gdn_norm': 1.0 + nrm(ks[14], (DEPTH, GB_V), 0.02),
        'w_branch_a': nrm(ks[15], (DEPTH, HA_V, D_MODEL), HA_V ** -0.5),
        'w_branch_b': nrm(ks[16], (DEPTH, GB_V, D_MODEL), GB_V ** -0.5),
        'w_out': nrm(ks[17], (DEPTH, D_MODEL, D_MODEL), D_MODEL ** -0.5),
        'router_w': nrm(ks[18], (DEPTH, D_MODEL, N_EXPERTS), D_MODEL ** -0.5),
        'w_gate': nrm(ks[19], (DEPTH, N_EXPERTS, D_MODEL, D_EXPERT), D_MODEL ** -0.5),
        'w_up': nrm(ks[20], (DEPTH, N_EXPERTS, D_MODEL, D_EXPERT), D_MODEL ** -0.5),
        'w_down': nrm(ks[21], (DEPTH, N_EXPERTS, D_EXPERT, D_MODEL), D_EXPERT ** -0.5),
        'final_norm': 1.0 + nrm(ks[22], (D_MODEL,), 0.02),
    }


def reference(x, c, ctx, c_ctx, ada_w, ada_b, norm_mix, norm_ffn, w_in, gdn_conv, gdn_a_log, gdn_dt_bias,
              hgrn_lb, hgrn_norm, gdn_norm, w_branch_a, w_branch_b, w_out, router_w, w_gate, w_up, w_down,
              final_norm):
    rows = x.shape[1] // GRID_W
    lower = jnp.cumsum(jax.nn.softmax(hgrn_lb.astype(jnp.float32), axis=1), axis=1)
    x_lat, x_ctx = x, ctx
    for l in range(DEPTH):
        need_ctx = l < DEPTH - 1
        ml = [m[:, None, :] for m in jnp.split(jax.nn.silu(c) @ ada_w[l] + ada_b[l], 6, axis=-1)]
        mc = jnp.split(jax.nn.silu(c_ctx) @ ada_w[l] + ada_b[l], 6, axis=-1)
        h_lat = modulate(rms_norm(x_lat, norm_mix[l]), ml[0], ml[1])
        h_ctx = modulate(rms_norm(x_ctx, norm_mix[l]), mc[0], mc[1])
        y_lat, y_ctx = token_mixer(h_lat, h_ctx, rows, need_ctx, w_in[l], gdn_conv[l], gdn_a_log[l], gdn_dt_bias[l],
                                   lower[0, l], lower[1, l], hgrn_norm[l], gdn_norm[l],
                                   w_branch_a[l], w_branch_b[l], w_out[l])
        x_lat = x_lat + ml[2] * y_lat
        h2 = modulate(rms_norm(x_lat, norm_ffn[l]), ml[3], ml[4])
        x_lat = x_lat + ml[5] * expert_choice_ffn(h2, router_w[l], w_gate[l], w_up[l], w_down[l])
        if need_ctx:
            x_ctx = x_ctx + mc[2] * y_ctx
            h2c = modulate(rms_norm(x_ctx, norm_ffn[l]), mc[3], mc[4])
            x_ctx = x_ctx + mc[5] * expert_choice_ffn(h2c, router_w[l], w_gate[l], w_up[l], w_down[l])
    return rms_norm(x_lat, final_norm)
```

```cpp
#include <hip/hip_runtime.h>
#include <hip/hip_cooperative_groups.h>
#include <cstdio>
#include <cstdint>
namespace cg = cooperative_groups;

#ifndef ONE_LAUNCH
#define ONE_LAUNCH 1
#endif

#define LAS __attribute__((address_space(3)))
typedef unsigned short bf16_t;
typedef short bf16x8 __attribute__((ext_vector_type(8)));
typedef float f32x4 __attribute__((ext_vector_type(4)));
typedef float f32x2 __attribute__((ext_vector_type(2)));
typedef unsigned u32x4 __attribute__((ext_vector_type(4)));
typedef unsigned u32x2 __attribute__((ext_vector_type(2)));

constexpr int D = 2048, NB = 4, SEQ = 4096, CTXL = 256;
constexpr int MLAT = NB * SEQ, MCTX = NB * CTXL, MTOT = MLAT + MCTX;
constexpr int NIN = 13344, NPW = 13568, PC = 13312;
constexpr int C_HQ = 0, C_FF = 1024, C_FB = 2048, C_HI = 3072, C_OG = 4096, C_GQ = 5120, C_GK = 6144, C_GV = 7168, C_Z = 8192, C_GA = 9216, C_GB = 11264;
constexpr int NE = 16, CAP = 512, DE = 1024;
constexpr float EPS = 1e-6f;
constexpr int NTHR = 512, NWAVES = 8;
constexpr int LDS_BYTES = 147456;

constexpr size_t WS_BAR = 0;
constexpr size_t WS_MOD = 16384;
constexpr size_t WS_AFF = WS_MOD + 245760;
constexpr size_t WS_IDX = WS_AFF + 1048576;
constexpr size_t WS_GATEV = WS_IDX + 131072;
constexpr size_t WS_INV = WS_GATEV + 131072;
constexpr size_t WS_AB = WS_INV + 1048576;
constexpr size_t WS_WAB = WS_AB + 2228224;
constexpr size_t WS_WOUT = WS_WAB + 8388608;
constexpr size_t WS_R1 = WS_WOUT + 8388608;
constexpr size_t WS_R2 = WS_R1 + 126877696;
constexpr size_t WS_P = WS_R2 + 134217728;
constexpr size_t WS_HALO = WS_P + 463470592;
constexpr size_t WS_WIN8 = WS_HALO + 6684672;
constexpr size_t WS_END = WS_WIN8 + 10485760;
constexpr size_t R2_H8 = 100663296;
constexpr size_t R1_WINT = 0, R1_H = 55574528, R1_YAB = 0, R1_H2 = 0;
constexpr size_t R2_OAF = 0, R2_OAB = 33554432, R2_OBF = 67108864, R2_OBB = 100663296, R2_T = 0, R2_XS = 0, R2_YE = 0;
constexpr size_t P_X1 = 0, P_WGU = 134217728, P_WD = 268435456, P_HACT = 335544320;

struct Args {
    const float *x, *c, *ctx, *c_ctx, *ada_w, *ada_b, *norm_mix, *norm_ffn, *w_in, *gdn_conv, *a_log, *dt_bias, *hgrn_lb, *hgrn_norm, *gdn_norm,
        *w_ba, *w_bb, *w_out, *router_w, *w_gate, *w_up, *w_down, *final_norm;
    float* out; unsigned char* ws; int ph_lo, ph_hi;
};

__device__ __forceinline__ float bf2f(unsigned short b) { return __uint_as_float(((unsigned)b) << 16); }
__device__ __forceinline__ float bflo(unsigned w) { return __uint_as_float(w << 16); }
__device__ __forceinline__ float bfhi(unsigned w) { return __uint_as_float(w & 0xffff0000u); }
typedef __bf16 bf16x2v __attribute__((ext_vector_type(2)));
__device__ __forceinline__ unsigned pk2(float lo, float hi) { const f32x2 v = {lo, hi}; const bf16x2v b = __builtin_convertvector(v, bf16x2v); return __builtin_bit_cast(unsigned, b); }
__device__ __forceinline__ unsigned f2bf(float f) { return pk2(f, f) & 0xffffu; }
__device__ __forceinline__ float rcp_f(float x) { return __builtin_amdgcn_rcpf(x); }
__device__ __forceinline__ float sigmoid_f(float x) { return __builtin_amdgcn_rcpf(1.f + __builtin_amdgcn_exp2f(-1.4426950408889634f * x)); }
__device__ __forceinline__ float silu_f(float x) { return x * sigmoid_f(x); }
__device__ __forceinline__ float softplus_f(float x) { return x > 20.f ? x : log1pf(__expf(x)); }
__device__ __forceinline__ float wave_sum(float v) {
#pragma unroll
    for (int o = 1; o < 64; o <<= 1) v += __shfl_xor(v, o);
    return v;
}
#define LDS_WAIT() asm volatile("s_waitcnt lgkmcnt(0)" ::: "memory")
typedef int modfx_t;
typedef int v4i_ __attribute__((ext_vector_type(4)));
__device__ __forceinline__ f32x4 mod4(const modfx_t* M, size_t idx) {
    const v4i_ q = *(const v4i_*)(M + idx); const float sc = 3.725290298461914e-09f;
    return (f32x4){(float)q.x * sc, (float)q.y * sc, (float)q.z * sc, (float)q.w * sc}; }
typedef int v8i __attribute__((ext_vector_type(8)));
typedef int v4i __attribute__((ext_vector_type(4)));
__device__ __forceinline__ unsigned pk4_fp8(float a, float b, float c, float d) { unsigned w = 0u; w = (unsigned)__builtin_amdgcn_cvt_pk_fp8_f32(a, b, (int)w, false); w = (unsigned)__builtin_amdgcn_cvt_pk_fp8_f32(c, d, (int)w, true); return w; }
constexpr float W8_SCALE = 64.f;

namespace pg8 {
constexpr int BM = 256, BK = 64, HALF = 128, HTB = HALF * BK * 2, STAGE_BYTES = 8 * HTB, NXCD = 8, WGM = 8;
__device__ __forceinline__ int lds_byte(int r, int c) { const int st = (r >> 4) * 2 + (c >> 5), rr = r & 15, cc = c & 31, ob = rr * 64 + cc * 2; return st * 1024 + (ob ^ (((ob >> 9) & 1) << 5)); }
__device__ __forceinline__ void stage_rc(int b, int& R, int& C) { const int st = b / 1024, sb = b % 1024, swz = sb ^ (((sb >> 9) & 1) << 5); R = (st >> 1) * 16 + swz / 64; C = (st & 1) * 32 + (swz % 64) / 2; }
__device__ __forceinline__ int perm32(int rho) { const int n = rho >> 4, i = rho & 15; return 8 * (i >> 2) + 4 * n + (i & 3); }
struct Unit { int pm, pn; const char* A; const char* B; int half; };
__device__ __forceinline__ unsigned cvt_pk_bf16(float lo, float hi) { unsigned r; asm volatile("v_cvt_pk_bf16_f32 %0, %1, %2" : "=v"(r) : "v"(lo), "v"(hi)); return r; }

struct SchedPlain {
    int nM, nN, nwg, G, c; const char* A; const char* B; size_t tA, tB; int pair; size_t hoff; int remap; int ubeg, uend;
    __device__ __forceinline__ void init(int M, int N, int G_, int c_, const void* A_, const void* B_, size_t tA_, size_t tB_, int pair_ = 0, size_t hoff_ = 0, int remap_ = 0) { nM = M / BM; nN = N / BM; nwg = nM * nN; G = G_; c = c_; A = (const char*)A_; B = (const char*)B_; tA = tA_; tB = tB_; pair = pair_; hoff = hoff_; remap = remap_; ubeg = 0; uend = nwg; }
    __device__ __forceinline__ bool next(int i, Unit& u) const {
        const int hf = pair ? (i & 1) : 1; if (pair) i >>= 1;
        const long L = (long)ubeg + (long)i * G + c; if (L >= uend) return false;
        int wgid = (int)L; { const int q = nwg / NXCD, r = nwg % NXCD, xcd = wgid % NXCD, off = wgid / NXCD; wgid = (xcd < r ? xcd * (q + 1) : r * (q + 1) + (xcd - r) * q) + off; }
        const int nig = WGM * nN, gid = wgid / nig, fm = gid * WGM, gsz = (nM - fm) < WGM ? (nM - fm) : WGM;
        u.pm = fm + ((wgid % nig) % gsz); u.pn = (wgid % nig) / gsz; u.half = hf;
        const int pnd = u.pn;
        if (remap == 1) u.pn = (u.pn < 16) ? u.pn : (u.pn < 28 ? u.pn + 4 : 52);
        else if (remap == 2) u.pn = (u.pn < 4) ? 16 + u.pn : 28 + u.pn;
        else if (remap == 3) u.pn = (u.pn < 4) ? 16 + u.pn : 32 + u.pn;
        else if (remap == 4) u.pn = 32 + u.pn;
        const size_t ho = (pair && hf) ? hoff : 0; u.A = A + (size_t)u.pm * tA + ho; u.B = B + (size_t)(remap == 3 ? pnd : u.pn) * tB + ho; return true;
    }
};
struct SchedTwo {
    SchedPlain a, b; int na, nextra, G, c;
    __device__ __forceinline__ bool next(int i, Unit& u) const {
        const long L = (long)i * G + c;
        if (L < na) { SchedPlain t = a; t.G = 1; t.c = 0; t.ubeg = (int)L; t.uend = (int)L + 1; return t.next(0, u); }
        if (L < na + nextra) { SchedPlain t = b; t.G = 1; t.c = 0; t.ubeg = (int)(L - na); t.uend = t.ubeg + 1; return t.next(0, u); }
        return false;
    }
};
struct SchedMoe {
    int G, c; const char* A; const char* B; size_t tA, tB;
    __device__ __forceinline__ bool next(int i, Unit& u) const {
        const long L = (long)i * G + c; if (L >= 1024) return false;
        const int e = (int)L >> 6, r = (int)L & 63, pn = r >> 3, q = r & 7, b = q >> 1, hf = q & 1;
        u.pm = (b * 16 + e) * 2 + hf; u.pn = pn; u.half = 1; u.A = A + (size_t)u.pm * tA; u.B = B + (size_t)(e * 8 + pn) * tB; return true;
    }
};

template <class Epi, class Sched, bool MID, bool F8 = false>
__device__ __forceinline__ void gemm_phase(LAS unsigned char* lds, const int K, const int lda, const int ldb, const Sched& S, const Epi& E) {
    int tid = threadIdx.x; asm volatile("" : "+v"(tid));
    const int wid = __builtin_amdgcn_readfirstlane(tid >> 6), lane = tid & 63, wr = wid >> 2, wc = wid & 3, fr = lane & 15, fq = lane >> 4;
    const int nt = K / BK;
    unsigned voffA[2], voffB[2];
#pragma unroll
    for (int i = 0; i < 2; ++i) { int R, C; stage_rc(tid * 16 + i * 8192, R, C); const int Rb = Epi::PERM ? ((R & ~31) + perm32(R & 31)) : R;
        voffA[i] = (unsigned)(R * lda + C) * 2u; voffB[i] = (unsigned)(Rb * ldb + C) * 2u; }
    const size_t kstep = (size_t)(BK * 2);
    const size_t hstepA = (size_t)HALF * lda * 2, hstepB = (size_t)HALF * ldb * 2;
    const unsigned ldsw = (unsigned)wid * 1024u;
    const int aoff = F8 ? lds_byte(wr * 64 + fr, 32 * (fq >> 1) + 16 * (fq & 1)) : lds_byte(wr * 64 + fr, fq * 8), boff = F8 ? lds_byte(wc * 32 + fr, 32 * (fq >> 1) + 16 * (fq & 1)) : lds_byte(wc * 32 + fr, fq * 8);
#define PG8_SA(b, h) (((b) * 2 + (h)) * HTB)
#define PG8_SB(b, h) ((4 + (b) * 2 + (h)) * HTB)
#define PG8_STAGE(bufoff, gbase, voff) do { _Pragma("unroll") for (int _i = 0; _i < 2; ++_i) \
        __builtin_amdgcn_global_load_lds((const unsigned*)((const char*)(gbase) + (voff)[_i]), (LAS unsigned*)(lds + (bufoff) + ldsw + _i * 8192), 16, 0, 0); } while (0)
#define PG8_LDA(dst, b, h) do { if constexpr (F8) { _Pragma("unroll") for (int m = 0; m < 4; ++m) { const v4i lo_ = *(const LAS v4i*)(lds + PG8_SA(b, h) + aoff + m * 2048), hi_ = *(const LAS v4i*)(lds + PG8_SA(b, h) + aoff + m * 2048 + 16); \
            dst##8[m] = __builtin_shufflevector(lo_, hi_, 0, 1, 2, 3, 4, 5, 6, 7); } } \
        else { _Pragma("unroll") for (int m = 0; m < 4; ++m) _Pragma("unroll") for (int k = 0; k < 2; ++k) dst[m][k] = *(const LAS bf16x8*)(lds + PG8_SA(b, h) + aoff + m * 2048 + k * 1024); } } while (0)
#define PG8_LDB(dst, b, h) do { if constexpr (F8) { _Pragma("unroll") for (int n = 0; n < 2; ++n) { const v4i lo_ = *(const LAS v4i*)(lds + PG8_SB(b, h) + boff + n * 2048), hi_ = *(const LAS v4i*)(lds + PG8_SB(b, h) + boff + n * 2048 + 16); \
            dst##8[n] = __builtin_shufflevector(lo_, hi_, 0, 1, 2, 3, 4, 5, 6, 7); } } \
        else { _Pragma("unroll") for (int n = 0; n < 2; ++n) _Pragma("unroll") for (int k = 0; k < 2; ++k) dst[n][k] = *(const LAS bf16x8*)(lds + PG8_SB(b, h) + boff + n * 2048 + k * 1024); } } while (0)
#define PG8_MMA(ai, bj, At, Bt) do { __builtin_amdgcn_s_setprio(1); if constexpr (F8) { _Pragma("unroll") for (int m = 0; m < 4; ++m) _Pragma("unroll") for (int n = 0; n < 2; ++n) \
        asm volatile("v_mfma_scale_f32_16x16x128_f8f6f4 %0, %1, %2, %0, %3, %3 op_sel_hi:[0,0,0]" : "+v"(acc[ai][bj][m][n]) : "v"(Bt##8[n]), "v"(At##8[m]), "v"(sc8)); } \
        else { _Pragma("unroll") for (int m = 0; m < 4; ++m) _Pragma("unroll") for (int n = 0; n < 2; ++n) _Pragma("unroll") for (int k = 0; k < 2; ++k) \
        acc[ai][bj][m][n] = __builtin_amdgcn_mfma_f32_16x16x32_bf16(Bt[n][k], At[m][k], acc[ai][bj][m][n], 0, 0, 0); } __builtin_amdgcn_s_setprio(0); } while (0)
#define PG8_WAIT_V(n) asm volatile("s_waitcnt vmcnt(" #n ")" ::: "memory")
#define PG8_WAIT_L(n) asm volatile("s_waitcnt lgkmcnt(" #n ")" ::: "memory")
#define PG8_BAR __builtin_amdgcn_s_barrier()
#define PG8_SCHED __builtin_amdgcn_sched_barrier(0)
    Unit cur, nxt; int ui = 0;
    if (!S.next(0, cur)) return;
    f32x4 acc[2][2][4][2];
#pragma unroll
    for (int a = 0; a < 2; ++a)
#pragma unroll
        for (int b = 0; b < 2; ++b)
#pragma unroll
            for (int m = 0; m < 4; ++m)
#pragma unroll
                for (int n = 0; n < 2; ++n) acc[a][b][m][n] = (f32x4){0.f, 0.f, 0.f, 0.f};
    bf16x8 At[4][2], B0[2][2], B1[2][2]; v8i At8[4], B08[2], B18[2]; const int sc8 = 0x7F7F7F7F;
    const char* cA = cur.A; const char* cB = cur.B;
    PG8_STAGE(PG8_SB(0, 0), cB, voffB); PG8_STAGE(PG8_SB(0, 1), cB + hstepB, voffB); PG8_STAGE(PG8_SA(0, 0), cA, voffA); PG8_STAGE(PG8_SA(0, 1), cA + hstepA, voffA);
    if (wr == 1) PG8_BAR;
    PG8_WAIT_V(2); PG8_BAR;
    PG8_STAGE(PG8_SB(1, 0), cB + kstep, voffB); PG8_STAGE(PG8_SA(1, 0), cA + kstep, voffA); PG8_STAGE(PG8_SB(1, 1), cB + hstepB + kstep, voffB);
    PG8_WAIT_V(6); PG8_BAR;
    for (;;) {
        const bool has_next = S.next(ui + 1, nxt);
        const char* nA = has_next ? nxt.A : cA; const char* nB = has_next ? nxt.B : cB;
#pragma unroll 1
        for (int t = 0; t < nt; t += 2) {
            const bool last = (t == nt - 2);
            const char* a1 = cA + (size_t)(t + 1) * kstep;
            const char* a2 = last ? nA : cA + (size_t)(t + 2) * kstep; const char* b2 = last ? nB : cB + (size_t)(t + 2) * kstep;
            const char* a3 = a2 + kstep; const char* b3 = b2 + kstep;
            PG8_LDB(B0, 0, 0); PG8_LDB(B1, 0, 1); PG8_SCHED; PG8_LDA(At, 0, 0); PG8_STAGE(PG8_SA(1, 1), a1 + hstepA, voffA);
            PG8_WAIT_V(8); PG8_WAIT_L(0); PG8_BAR; PG8_MMA(0, 0, At, B0); PG8_MMA(0, 1, At, B1); PG8_BAR; PG8_SCHED;
            PG8_LDA(At, 0, 1); PG8_STAGE(PG8_SB(0, 0), b2, voffB); PG8_STAGE(PG8_SB(0, 1), b2 + hstepB, voffB); PG8_STAGE(PG8_SA(0, 0), a2, voffA);
            PG8_WAIT_V(8); PG8_WAIT_L(0); PG8_BAR; PG8_MMA(1, 0, At, B0); PG8_MMA(1, 1, At, B1); PG8_BAR; PG8_SCHED;
            PG8_LDB(B0, 1, 0); PG8_LDB(B1, 1, 1); PG8_SCHED; PG8_LDA(At, 1, 0); PG8_STAGE(PG8_SA(0, 1), a2 + hstepA, voffA);
            PG8_WAIT_V(8); PG8_WAIT_L(0); PG8_BAR; PG8_MMA(0, 0, At, B0); PG8_MMA(0, 1, At, B1); PG8_BAR; PG8_SCHED;
            PG8_LDA(At, 1, 1); PG8_STAGE(PG8_SB(1, 0), b3, voffB); PG8_STAGE(PG8_SB(1, 1), b3 + hstepB, voffB); PG8_STAGE(PG8_SA(1, 0), a3, voffA);
            PG8_WAIT_V(8); PG8_WAIT_L(0); PG8_BAR; PG8_MMA(1, 0, At, B0); PG8_MMA(1, 1, At, B1); PG8_BAR; PG8_SCHED;
        }
        if (wr == 0) PG8_BAR;
        if constexpr (F8) asm volatile("s_nop 15\n\ts_nop 15" ::: "memory");
        bool fin = true;
        int fr_e = fr, fq_e = fq; asm volatile("" : "+v"(fr_e), "+v"(fq_e));
        if constexpr (MID) { fin = (cur.half != 0); if (!fin) E.mid(acc, cur, wr, wc, fr_e, fq_e); }
        if (fin) E(acc, cur, wr, wc, fr_e, fq_e);
        if (!has_next) break;
        if (fin) {
#pragma unroll
        for (int a = 0; a < 2; ++a)
#pragma unroll
            for (int b = 0; b < 2; ++b)
#pragma unroll
                for (int m = 0; m < 4; ++m)
#pragma unroll
                    for (int n = 0; n < 2; ++n) acc[a][b][m][n] = (f32x4){0.f, 0.f, 0.f, 0.f};
        }
        cur = nxt; cA = nA; cB = nB; ++ui;
        if (wr == 1) PG8_BAR;
    }
    PG8_WAIT_V(0);
    PG8_BAR;
#undef PG8_SA
#undef PG8_SB
#undef PG8_STAGE
#undef PG8_LDA
#undef PG8_LDB
#undef PG8_MMA
#undef PG8_WAIT_V
#undef PG8_WAIT_L
#undef PG8_BAR
#undef PG8_SCHED
}

struct EpiP {
    static constexpr bool PERM = true;
    bf16_t* P; float* AB; float osc;
    __device__ __forceinline__ void operator()(const f32x4 (&acc)[2][2][4][2], const Unit& u, int wr, int wc, int fr, int fq) const {
        const int row0 = u.pm * BM + wr * 64 + fr;
        if (u.pn < 52) {
            const int col0 = u.pn * BM + wc * 32 + 8 * fq;
#pragma unroll
            for (int ai = 0; ai < 2; ++ai)
#pragma unroll
                for (int m = 0; m < 4; ++m) { bf16_t* rowp = P + (size_t)(row0 + ai * HALF + m * 16) * PC + col0;
#pragma unroll
                    for (int bj = 0; bj < 2; ++bj) { const f32x4 v0 = acc[ai][bj][m][0] * osc, v1 = acc[ai][bj][m][1] * osc;
                        u32x4 w; w.x = cvt_pk_bf16(v0[0], v0[1]); w.y = cvt_pk_bf16(v0[2], v0[3]); w.z = cvt_pk_bf16(v1[0], v1[1]); w.w = cvt_pk_bf16(v1[2], v1[3]);
                        *(u32x4*)(rowp + bj * HALF) = w; } }
        } else if (wc == 0) {
#pragma unroll
            for (int ai = 0; ai < 2; ++ai)
#pragma unroll
                for (int m = 0; m < 4; ++m) { float* rp = AB + (size_t)(row0 + ai * HALF + m * 16) * 32 + 8 * fq;
                    *(f32x4*)rp = acc[ai][0][m][0]; *(f32x4*)(rp + 4) = acc[ai][0][m][1]; }
        }
    }
};
struct EpiMerge {
    static constexpr bool PERM = true;
    const bf16_t* P; bf16_t* T;
    __device__ __forceinline__ void mid(f32x4 (&acc)[2][2][4][2], const Unit& u, int wr, int wc, int fr, int fq) const {
        const bf16_t* base = P + (size_t)(u.pm * BM + wr * 64 + fr) * PC + (u.pn * BM + wc * 32 + 8 * fq);
#pragma unroll
        for (int ai = 0; ai < 2; ++ai) {
            u32x4 xa[4][2], xb[4][2];
#pragma unroll
            for (int m = 0; m < 4; ++m)
#pragma unroll
                for (int bj = 0; bj < 2; ++bj) { const bf16_t* rowp = base + (size_t)(ai * HALF + m * 16) * PC + bj * HALF; xa[m][bj] = *(const u32x4*)(rowp + C_GA); xb[m][bj] = *(const u32x4*)(rowp + C_GB); }
#pragma unroll
            for (int m = 0; m < 4; ++m)
#pragma unroll
                for (int bj = 0; bj < 2; ++bj) {
                    const unsigned wa[4] = {xa[m][bj].x, xa[m][bj].y, xa[m][bj].z, xa[m][bj].w}, wb[4] = {xb[m][bj].x, xb[m][bj].y, xb[m][bj].z, xb[m][bj].w};
#pragma unroll
                    for (int j = 0; j < 4; ++j) {
                        const float r0 = (1.f + __expf(-bflo(wb[j]))) * __builtin_amdgcn_rcpf(1.f + __expf(-bflo(wa[j]))), r1 = (1.f + __expf(-bfhi(wb[j]))) * __builtin_amdgcn_rcpf(1.f + __expf(-bfhi(wa[j])));
                        acc[ai][bj][m][j >> 1][(j & 1) * 2] *= r0; acc[ai][bj][m][j >> 1][(j & 1) * 2 + 1] *= r1; } }
            asm volatile("" ::: "memory"); }
    }
    __device__ __forceinline__ void operator()(const f32x4 (&acc)[2][2][4][2], const Unit& u, int wr, int wc, int fr, int fq) const {
        const int row0 = u.pm * BM + wr * 64 + fr, col0 = u.pn * BM + wc * 32 + 8 * fq;
#pragma unroll
        for (int ai = 0; ai < 2; ++ai) {
            u32x4 xb[4][2];
#pragma unroll
            for (int m = 0; m < 4; ++m)
#pragma unroll
                for (int bj = 0; bj < 2; ++bj) xb[m][bj] = *(const u32x4*)(P + (size_t)(row0 + ai * HALF + m * 16) * PC + col0 + C_GB + bj * HALF);
#pragma unroll
            for (int m = 0; m < 4; ++m) { const size_t row = (size_t)(row0 + ai * HALF + m * 16);
#pragma unroll
                for (int bj = 0; bj < 2; ++bj) {
                    const unsigned wb[4] = {xb[m][bj].x, xb[m][bj].y, xb[m][bj].z, xb[m][bj].w}; float g[8];
#pragma unroll
                    for (int j = 0; j < 4; ++j) { g[2 * j] = sigmoid_f(bflo(wb[j])); g[2 * j + 1] = sigmoid_f(bfhi(wb[j])); }
                    const f32x4 v0 = acc[ai][bj][m][0], v1 = acc[ai][bj][m][1];
                    u32x4 w; w.x = cvt_pk_bf16(v0[0] * g[0], v0[1] * g[1]); w.y = cvt_pk_bf16(v0[2] * g[2], v0[3] * g[3]); w.z = cvt_pk_bf16(v1[0] * g[4], v1[1] * g[5]); w.w = cvt_pk_bf16(v1[2] * g[6], v1[3] * g[7]);
                    *(u32x4*)(T + row * D + col0 + bj * HALF) = w; } }
            asm volatile("" ::: "memory"); }
    }
};
struct EpiX1 {
    static constexpr bool PERM = false;
    const float* x; const modfx_t* mod; const float* ada_b; bf16_t* X1;
    __device__ __forceinline__ void operator()(const f32x4 (&acc)[2][2][4][2], const Unit& u, int wr, int wc, int fr, int fq) const {
        const int row0 = u.pm * BM + wr * 64 + fr, col0 = u.pn * BM + wc * 32 + 4 * fq, b = u.pm >> 4;
        f32x4 mv[2][2];
#pragma unroll
        for (int bj = 0; bj < 2; ++bj)
#pragma unroll
            for (int n = 0; n < 2; ++n) { const int c = col0 + bj * HALF + n * 16; mv[bj][n] = mod4(mod, (size_t)b * 12288 + 2 * D + c) + *(const f32x4*)(ada_b + 2 * D + c); }
#pragma unroll
        for (int ai = 0; ai < 2; ++ai) {
            f32x4 xi[4][2][2];
#pragma unroll
            for (int m = 0; m < 4; ++m)
#pragma unroll
                for (int bj = 0; bj < 2; ++bj)
#pragma unroll
                    for (int n = 0; n < 2; ++n) xi[m][bj][n] = *(const f32x4*)(x + (size_t)(row0 + ai * HALF + m * 16) * D + col0 + bj * HALF + n * 16);
#pragma unroll
            for (int m = 0; m < 4; ++m) { const size_t off = (size_t)(row0 + ai * HALF + m * 16) * D + col0;
#pragma unroll
                for (int bj = 0; bj < 2; ++bj)
#pragma unroll
                    for (int n = 0; n < 2; ++n) { const f32x4 o = xi[m][bj][n] + mv[bj][n] * acc[ai][bj][m][n];
                        *(u32x2*)(X1 + off + bj * HALF + n * 16) = (u32x2){cvt_pk_bf16(o[0], o[1]), cvt_pk_bf16(o[2], o[3])}; } }
            asm volatile("" ::: "memory"); }
    }
};
struct EpiHact {
    static constexpr bool PERM = true;
    unsigned char* H;
    __device__ __forceinline__ void operator()(const f32x4 (&acc)[2][2][4][2], const Unit& u, int wr, int wc, int fr, int fq) const {
        const int row0 = u.pm * BM + wr * 64 + fr, col0 = u.pn * HALF + wc * 32 + 8 * fq;
#pragma unroll
        for (int ai = 0; ai < 2; ++ai)
#pragma unroll
            for (int m = 0; m < 4; ++m) { const f32x4 a0 = acc[ai][0][m][0] * (1.f / W8_SCALE), a1 = acc[ai][0][m][1] * (1.f / W8_SCALE), u0 = acc[ai][1][m][0] * (1.f / W8_SCALE), u1 = acc[ai][1][m][1] * (1.f / W8_SCALE);
                u32x2 w; w.x = pk4_fp8(silu_f(a0[0]) * u0[0], silu_f(a0[1]) * u0[1], silu_f(a0[2]) * u0[2], silu_f(a0[3]) * u0[3]);
                w.y = pk4_fp8(silu_f(a1[0]) * u1[0], silu_f(a1[1]) * u1[1], silu_f(a1[2]) * u1[2], silu_f(a1[3]) * u1[3]);
                *(u32x2*)(H + (size_t)(row0 + ai * HALF + m * 16) * DE + col0) = w; }
    }
};
struct EpiYE {
    static constexpr bool PERM = true;
    const float* gatev; bf16_t* Y;
    __device__ __forceinline__ void operator()(const f32x4 (&acc)[2][2][4][2], const Unit& u, int wr, int wc, int fr, int fq) const {
        const int row0 = u.pm * BM + wr * 64 + fr, col0 = u.pn * BM + wc * 32 + 8 * fq;
        float g[2][4];
#pragma unroll
        for (int ai = 0; ai < 2; ++ai)
#pragma unroll
            for (int m = 0; m < 4; ++m) g[ai][m] = gatev[row0 + ai * HALF + m * 16] * (1.f / W8_SCALE);
#pragma unroll
        for (int ai = 0; ai < 2; ++ai)
#pragma unroll
            for (int m = 0; m < 4; ++m) { const int row = row0 + ai * HALF + m * 16;
#pragma unroll
                for (int bj = 0; bj < 2; ++bj) { const f32x4 v0 = acc[ai][bj][m][0] * g[ai][m], v1 = acc[ai][bj][m][1] * g[ai][m];
                    u32x4 w; w.x = cvt_pk_bf16(v0[0], v0[1]); w.y = cvt_pk_bf16(v0[2], v0[3]); w.z = cvt_pk_bf16(v1[0], v1[1]); w.w = cvt_pk_bf16(v1[2], v1[3]);
                    *(u32x4*)(Y + (size_t)row * D + col0 + bj * HALF) = w; } }
    }
};
}

__device__ __forceinline__ void tr_item(const float* W, int ldw, int k0, int n0, bf16_t* WT, size_t dst_row, int ldk, int koff, LAS float* scr, int lane, const bool f8 = false) {
    f32x4 v[8];
#pragma unroll
    for (int i = 0; i < 8; ++i) v[i] = *(const f32x4*)(W + (size_t)(k0 + 8 * i + (lane >> 3)) * ldw + n0 + (lane & 7) * 4);
#pragma unroll
    for (int i = 0; i < 8; ++i) { LAS float* p = scr + (8 * i + (lane >> 3)) * 33 + (lane & 7) * 4; p[0] = v[i].x; p[1] = v[i].y; p[2] = v[i].z; p[3] = v[i].w; }
    LDS_WAIT(); asm volatile("" ::: "memory");
    const int c = lane & 7;
    if (!f8) {
#pragma unroll
    for (int j = 0; j < 4; ++j) { const int n = (lane >> 3) + 8 * j; const LAS float* s = scr + (8 * c) * 33 + n;
        u32x4 o; o.x = pk2(s[0 * 33], s[1 * 33]); o.y = pk2(s[2 * 33], s[3 * 33]); o.z = pk2(s[4 * 33], s[5 * 33]); o.w = pk2(s[6 * 33], s[7 * 33]);
        *(u32x4*)(WT + (dst_row + n) * (size_t)ldk + koff + k0 + 8 * c) = o; }
    } else {
#pragma unroll
    for (int j = 0; j < 4; ++j) { const int n = (lane >> 3) + 8 * j; const LAS float* s = scr + (8 * c) * 33 + n;
        u32x2 o; o.x = pk4_fp8(s[0 * 33] * W8_SCALE, s[1 * 33] * W8_SCALE, s[2 * 33] * W8_SCALE, s[3 * 33] * W8_SCALE); o.y = pk4_fp8(s[4 * 33] * W8_SCALE, s[5 * 33] * W8_SCALE, s[6 * 33] * W8_SCALE, s[7 * 33] * W8_SCALE);
        *(u32x2*)((unsigned char*)WT + (dst_row + n) * (size_t)ldk + koff + k0 + 8 * c) = o; }
    }
    LDS_WAIT(); asm volatile("" ::: "memory");
}

__device__ __forceinline__ void phase_prep(const Args& a, LAS unsigned char* lds) {
    const int tid = threadIdx.x, lane = tid & 63, wave = tid >> 6, G = gridDim.x;
    int* MOD = (int*)(a.ws + WS_MOD);
    LAS float* sc = (LAS float*)lds;
    for (int it = blockIdx.x; it < 256; it += G) {
        const int ks = it >> 3, cb = it & 7, k0 = ks * 64;
        __syncthreads();
        if (tid < 320) { const int v = tid >> 6, r = tid & 63; const float cv = (v < 4) ? a.c[v * D + k0 + r] : a.c_ctx[k0 + r]; sc[v * 64 + r] = silu_f(cv); }
        __syncthreads();
        float acc[5][3];
#pragma unroll
        for (int v = 0; v < 5; ++v)
#pragma unroll
            for (int i = 0; i < 3; ++i) acc[v][i] = 0.f;
        const float* wp = a.ada_w + (size_t)k0 * 12288 + cb * 1536 + tid;
#pragma unroll 8
        for (int r = 0; r < 64; ++r) {
            const float w0 = wp[(size_t)r * 12288], w1 = wp[(size_t)r * 12288 + 512], w2 = wp[(size_t)r * 12288 + 1024];
#pragma unroll
            for (int v = 0; v < 5; ++v) { const float s = sc[v * 64 + r]; acc[v][0] += s * w0; acc[v][1] += s * w1; acc[v][2] += s * w2; }
        }
#pragma unroll
        for (int v = 0; v < 5; ++v)
#pragma unroll
            for (int i = 0; i < 3; ++i) atomicAdd(MOD + v * 12288 + cb * 1536 + tid + 512 * i, __float2int_rn(acc[v][i] * 268435456.f));
    }
    __syncthreads();
    LAS float* scr = (LAS float*)(lds + wave * 16384);
    const int gw = blockIdx.x * NWAVES + wave, NGW = G * NWAVES;
    bf16_t* WinT = (bf16_t*)(a.ws + WS_R1 + R1_WINT); bf16_t* WabT = (bf16_t*)(a.ws + WS_WAB); bf16_t* WoutT = (bf16_t*)(a.ws + WS_WOUT);
    constexpr int I_IN = 32 * 417, I_BA = 16 * 64, I_OUT = 32 * 64;
    for (int it = gw; it < I_IN + 2 * I_BA + I_OUT; it += NGW) {
        int r = it;
        if (r < I_IN) { const int kb = r / 417, nb = r % 417, n0 = nb * 32; const size_t dr = (n0 < 9216) ? n0 : (n0 == 9216 ? 13312 : n0 - 32);
            if (dr >= 4096 && dr < 5120) tr_item(a.w_in, NIN, kb * 64, n0, (bf16_t*)(a.ws + WS_WIN8), dr - 4096, D, 0, scr, lane, true);
            else if (dr >= 9216 && dr < 13312) tr_item(a.w_in, NIN, kb * 64, n0, (bf16_t*)(a.ws + WS_WIN8), 1024 + (dr - 9216), D, 0, scr, lane, true);
            else tr_item(a.w_in, NIN, kb * 64, n0, WinT, dr, D, 0, scr, lane);
            continue; }
        r -= I_IN;
        if (r < I_BA) { tr_item(a.w_ba, D, (r >> 6) * 64, (r & 63) * 32, WabT, (r & 63) * 32, D, 0, scr, lane); continue; }
        r -= I_BA;
        if (r < I_BA) { tr_item(a.w_bb, D, (r >> 6) * 64, (r & 63) * 32, WabT, (r & 63) * 32, D, 1024, scr, lane); continue; }
        r -= I_BA;
        tr_item(a.w_out, D, (r >> 6) * 64, (r & 63) * 32, WoutT, (r & 63) * 32, D, 0, scr, lane);
    }
    { u32x4* z = (u32x4*)(WinT + (size_t)13344 * D); const int n16 = 224 * D * 2 / 16;
      for (int i = blockIdx.x * NTHR + tid; i < n16; i += G * NTHR) z[i] = (u32x4){0u, 0u, 0u, 0u}; }
}

__device__ __forceinline__ void phase_norm1(const Args& a) {
    const int tid = threadIdx.x, lane = tid & 63, wave = tid >> 6, G = gridDim.x;
    const modfx_t* MOD = (const modfx_t*)(a.ws + WS_MOD); bf16_t* H = (bf16_t*)(a.ws + WS_R1 + R1_H);
    f32x4 v[8], vn[8];
    { const int r0 = blockIdx.x * NWAVES + wave; if (r0 < MTOT) { const float* src = (r0 < MLAT) ? a.x + (size_t)r0 * D : a.ctx + (size_t)(r0 - MLAT) * D;
#pragma unroll
        for (int j = 0; j < 8; ++j) v[j] = *(const f32x4*)(src + lane * 4 + 256 * j); } }
    for (int r = blockIdx.x * NWAVES + wave; r < MTOT; r += G * NWAVES) {
        const int mv = (r < MLAT) ? (r >> 12) : 4;
        { const int rn = r + G * NWAVES; if (rn < MTOT) { const float* srcn = (rn < MLAT) ? a.x + (size_t)rn * D : a.ctx + (size_t)(rn - MLAT) * D;
#pragma unroll
            for (int j = 0; j < 8; ++j) vn[j] = *(const f32x4*)(srcn + lane * 4 + 256 * j); } }
        float ss = 0.f;
#pragma unroll
        for (int j = 0; j < 8; ++j) ss += (v[j].x * v[j].x + v[j].y * v[j].y) + (v[j].z * v[j].z + v[j].w * v[j].w);
        const float rstd = rsqrtf(wave_sum(ss) * (1.f / D) + EPS);
#pragma unroll
        for (int j = 0; j < 8; ++j) { const int c = lane * 4 + 256 * j;
            const f32x4 nm = *(const f32x4*)(a.norm_mix + c);
            const f32x4 sh = mod4(MOD, mv * 12288 + c) + *(const f32x4*)(a.ada_b + c);
            const f32x4 scl = mod4(MOD, mv * 12288 + D + c) + *(const f32x4*)(a.ada_b + D + c);
            const f32x4 h = v[j] * rstd * nm * (scl + 1.f) + sh;
            u32x2 w; w.x = pk2(h.x, h.y); w.y = pk2(h.z, h.w);
            *(u32x2*)(H + (size_t)r * D + c) = w;
            if (r < MLAT) *(unsigned*)(a.ws + WS_R2 + R2_H8 + (size_t)r * D + c) = pk4_fp8(h.x, h.y, h.z, h.w); }
#pragma unroll
        for (int j = 0; j < 8; ++j) v[j] = vn[j];
    }
}

__device__ __forceinline__ void scan_hgrn_naive(const Args& a, LAS unsigned char* lds, int b, int h, int dir) {
    const int tid = threadIdx.x, v = tid >> 2, dq = tid & 3, tok = tid >> 4, c8 = (tid & 15) * 8;
    LAS float* Lq = (LAS float*)lds; LAS float* Lk = Lq + 4096; LAS float* Lf = Lk + 4096; LAS float* Lv = Lf + 4096;
    const bf16_t* P = (const bf16_t*)(a.ws + WS_P);
    bf16_t* O = (bf16_t*)((unsigned char*)a.out + (dir ? R2_OAB : R2_OAF));
    float lo8[8];
#pragma unroll
    for (int j = 0; j < 8; ++j) { const int d = h * 128 + c8 + j; const float l0 = a.hgrn_lb[(dir * 2 + 0) * 1024 + d], l1 = a.hgrn_lb[(dir * 2 + 1) * 1024 + d]; lo8[j] = 1.f / (1.f + __expf(l1 - l0)); }
    float S[32];
#pragma unroll
    for (int i = 0; i < 32; ++i) S[i] = 0.f;
    const int cf = dir ? C_FB : C_FF;
    for (int p0 = 0; p0 < CTXL + SEQ; p0 += 32) {
        __syncthreads();
        { const int p = p0 + tok;
          const int row = (p < CTXL) ? (MLAT + b * CTXL + (dir ? CTXL - 1 - p : p)) : (b * SEQ + (dir ? SEQ - 1 - (p - CTXL) : (p - CTXL)));
          const bf16_t* pr = P + (size_t)row * PC + h * 128 + c8;
          const u32x4 rq = *(const u32x4*)(pr + C_HQ), rf = *(const u32x4*)(pr + cf), ri = *(const u32x4*)(pr + C_HI);
          const unsigned wq[4] = {rq.x, rq.y, rq.z, rq.w}, wf[4] = {rf.x, rf.y, rf.z, rf.w}, wi[4] = {ri.x, ri.y, ri.z, ri.w};
          float oq[8], ok[8], of[8], ov[8];
#pragma unroll
          for (int j = 0; j < 8; ++j) {
              const float xq = (j & 1) ? bfhi(wq[j >> 1]) : bflo(wq[j >> 1]), xf = (j & 1) ? bfhi(wf[j >> 1]) : bflo(wf[j >> 1]), xi = (j & 1) ? bfhi(wi[j >> 1]) : bflo(wi[j >> 1]);
              const float sg = sigmoid_f(xf), lo = lo8[j];
              oq[j] = silu_f(xq); of[j] = lo + (1.f - lo) * sg; ok[j] = (1.f - lo) * (1.f - sg); ov[j] = xi; }
          const int o = tok * 128 + c8;
          *(LAS f32x4*)(Lq + o) = (f32x4){oq[0], oq[1], oq[2], oq[3]}; *(LAS f32x4*)(Lq + o + 4) = (f32x4){oq[4], oq[5], oq[6], oq[7]};
          *(LAS f32x4*)(Lk + o) = (f32x4){ok[0], ok[1], ok[2], ok[3]}; *(LAS f32x4*)(Lk + o + 4) = (f32x4){ok[4], ok[5], ok[6], ok[7]};
          *(LAS f32x4*)(Lf + o) = (f32x4){of[0], of[1], of[2], of[3]}; *(LAS f32x4*)(Lf + o + 4) = (f32x4){of[4], of[5], of[6], of[7]};
          *(LAS f32x4*)(Lv + o) = (f32x4){ov[0], ov[1], ov[2], ov[3]}; *(LAS f32x4*)(Lv + o + 4) = (f32x4){ov[4], ov[5], ov[6], ov[7]};
        }
        __syncthreads();
        for (int tt = 0; tt < 32; ++tt) {
            const float vv = Lv[tt * 128 + v];
            float o = 0.f;
            const int base = tt * 128 + dq * 32;
#pragma unroll
            for (int i = 0; i < 32; i += 4) {
                const f32x4 f4 = *(const LAS f32x4*)(Lf + base + i), k4 = *(const LAS f32x4*)(Lk + base + i), q4 = *(const LAS f32x4*)(Lq + base + i);
                S[i] = f4.x * S[i] + k4.x * vv; o += q4.x * S[i];
                S[i + 1] = f4.y * S[i + 1] + k4.y * vv; o += q4.y * S[i + 1];
                S[i + 2] = f4.z * S[i + 2] + k4.z * vv; o += q4.z * S[i + 2];
                S[i + 3] = f4.w * S[i + 3] + k4.w * vv; o += q4.w * S[i + 3];
            }
            o += __shfl_xor(o, 1); o += __shfl_xor(o, 2);
            const int p = p0 + tt;
            if (p >= CTXL && dq == 0) { const int pos = dir ? SEQ - 1 - (p - CTXL) : (p - CTXL); O[(size_t)(b * SEQ + pos) * 1024 + h * 128 + v] = (bf16_t)f2bf(o); }
        }
    }
}

__device__ __forceinline__ void scan_gdn_naive(const Args& a, LAS unsigned char* lds, int b, int h, int dir) {
    const int tid = threadIdx.x, v = tid >> 2, dq = tid & 3, tok = tid >> 4, c8 = (tid & 15) * 8;
    LAS float* Lq = (LAS float*)lds; LAS float* Lk = Lq + 4096; LAS float* Lv = Lk + 4096; LAS float* Lg = Lv + 4096; LAS float* Lb = Lg + 32;
    const bf16_t* P = (const bf16_t*)(a.ws + WS_P); const float* AB = (const float*)(a.ws + WS_AB);
    bf16_t* O = (bf16_t*)((unsigned char*)a.out + (dir ? R2_OBB : R2_OBF));
    const float Acoef = -__expf(a.a_log[dir * 8 + h]), dtb = a.dt_bias[dir * 8 + h];
    float S[32];
#pragma unroll
    for (int i = 0; i < 32; ++i) S[i] = 0.f;
    for (int p0 = 0; p0 < CTXL + SEQ; p0 += 32) {
        __syncthreads();
        { const int p = p0 + tok; const bool isc = p < CTXL;
          const int L = isc ? CTXL : SEQ;
          const int sn = isc ? (dir ? CTXL - 1 - p : p) : (dir ? SEQ - 1 - (p - CTXL) : (p - CTXL));
          float aq[8], ak[8], av[8];
#pragma unroll
          for (int j = 0; j < 8; ++j) { aq[j] = 0.f; ak[j] = 0.f; av[j] = 0.f; }
          int rowc = 0;
#pragma unroll 1
          for (int tap = 0; tap < 5; ++tap) {
              const int s2 = sn + tap - 2;
              const int s2c = s2 < 0 ? 0 : (s2 >= L ? L - 1 : s2);
              const int row = isc ? (MLAT + b * CTXL + s2c) : (b * SEQ + (s2c & 63) * 64 + (s2c >> 6));
              if (tap == 2) rowc = row;
              const float ok = (s2 >= 0 && s2 < L) ? 1.f : 0.f;
              const bf16_t* pr = P + (size_t)row * PC + h * 128 + c8;
              const u32x4 rq = *(const u32x4*)(pr + C_GQ), rk = *(const u32x4*)(pr + C_GK), rv = *(const u32x4*)(pr + C_GV);
              const float* cw = a.gdn_conv + (size_t)tap * 3072 + h * 128 + c8;
              const f32x4 wq0 = *(const f32x4*)(cw), wq1 = *(const f32x4*)(cw + 4), wk0 = *(const f32x4*)(cw + 1024), wk1 = *(const f32x4*)(cw + 1028), wv0 = *(const f32x4*)(cw + 2048), wv1 = *(const f32x4*)(cw + 2052);
              const float cq[8] = {wq0.x, wq0.y, wq0.z, wq0.w, wq1.x, wq1.y, wq1.z, wq1.w}, ck[8] = {wk0.x, wk0.y, wk0.z, wk0.w, wk1.x, wk1.y, wk1.z, wk1.w}, cv[8] = {wv0.x, wv0.y, wv0.z, wv0.w, wv1.x, wv1.y, wv1.z, wv1.w};
              const unsigned uq[4] = {rq.x, rq.y, rq.z, rq.w}, uk[4] = {rk.x, rk.y, rk.z, rk.w}, uv[4] = {rv.x, rv.y, rv.z, rv.w};
#pragma unroll
              for (int j = 0; j < 8; ++j) {
                  const float xq = (j & 1) ? bfhi(uq[j >> 1]) : bflo(uq[j >> 1]), xk = (j & 1) ? bfhi(uk[j >> 1]) : bflo(uk[j >> 1]), xv = (j & 1) ? bfhi(uv[j >> 1]) : bflo(uv[j >> 1]);
                  aq[j] += ok * cq[j] * xq; ak[j] += ok * ck[j] * xk; av[j] += ok * cv[j] * xv; }
          }
          float sq = 0.f, sk = 0.f;
#pragma unroll
          for (int j = 0; j < 8; ++j) { aq[j] = silu_f(aq[j]); ak[j] = silu_f(ak[j]); av[j] = silu_f(av[j]); sq += aq[j] * aq[j]; sk += ak[j] * ak[j]; }
#pragma unroll
          for (int o = 1; o < 16; o <<= 1) { sq += __shfl_xor(sq, o); sk += __shfl_xor(sk, o); }
          const float rq_ = rsqrtf(sq + EPS) * 0.08838834764831845f, rk_ = rsqrtf(sk + EPS);
          const int o = tok * 128 + c8;
          *(LAS f32x4*)(Lq + o) = (f32x4){aq[0] * rq_, aq[1] * rq_, aq[2] * rq_, aq[3] * rq_}; *(LAS f32x4*)(Lq + o + 4) = (f32x4){aq[4] * rq_, aq[5] * rq_, aq[6] * rq_, aq[7] * rq_};
          *(LAS f32x4*)(Lk + o) = (f32x4){ak[0] * rk_, ak[1] * rk_, ak[2] * rk_, ak[3] * rk_}; *(LAS f32x4*)(Lk + o + 4) = (f32x4){ak[4] * rk_, ak[5] * rk_, ak[6] * rk_, ak[7] * rk_};
          *(LAS f32x4*)(Lv + o) = (f32x4){av[0], av[1], av[2], av[3]}; *(LAS f32x4*)(Lv + o + 4) = (f32x4){av[4], av[5], av[6], av[7]};
          if ((tid & 15) == 0) { const float al = AB[(size_t)rowc * 32 + dir * 8 + h], bl = AB[(size_t)rowc * 32 + 16 + dir * 8 + h];
              Lg[tok] = __expf(Acoef * softplus_f(al + dtb)); Lb[tok] = sigmoid_f(bl); }
        }
        __syncthreads();
        for (int tt = 0; tt < 32; ++tt) {
            const float vv = Lv[tt * 128 + v], eg = Lg[tt], be = Lb[tt];
            const int base = tt * 128 + dq * 32;
            float ks = 0.f;
#pragma unroll
            for (int i = 0; i < 32; i += 4) { const f32x4 k4 = *(const LAS f32x4*)(Lk + base + i);
                S[i] *= eg; S[i + 1] *= eg; S[i + 2] *= eg; S[i + 3] *= eg;
                ks += k4.x * S[i] + k4.y * S[i + 1] + k4.z * S[i + 2] + k4.w * S[i + 3]; }
            ks += __shfl_xor(ks, 1); ks += __shfl_xor(ks, 2);
            const float err = be * (vv - ks);
            float o = 0.f;
#pragma unroll
            for (int i = 0; i < 32; i += 4) { const f32x4 k4 = *(const LAS f32x4*)(Lk + base + i), q4 = *(const LAS f32x4*)(Lq + base + i);
                S[i] += k4.x * err; S[i + 1] += k4.y * err; S[i + 2] += k4.z * err; S[i + 3] += k4.w * err;
                o += q4.x * S[i] + q4.y * S[i + 1] + q4.z * S[i + 2] + q4.w * S[i + 3]; }
            o += __shfl_xor(o, 1); o += __shfl_xor(o, 2);
            const int p = p0 + tt;
            if (p >= CTXL && dq == 0) { const int sn = dir ? SEQ - 1 - (p - CTXL) : (p - CTXL); const int pos = (sn & 63) * 64 + (sn >> 6);
                O[(size_t)(b * SEQ + pos) * 1024 + h * 128 + v] = (bf16_t)f2bf(o); }
        }
    }
}


__device__ __forceinline__ int gdn_row(int b, bool isc, int n) { return isc ? (MLAT + b * CTXL + n) : (b * SEQ + (n & 63) * 64 + (n >> 6)); }
__device__ __forceinline__ void gdnprep_halo(const Args& a) {
    const int tid = threadIdx.x;
    const bf16_t* P = (const bf16_t*)(a.ws + WS_P); bf16_t* HALO = (bf16_t*)(a.ws + WS_HALO);
    for (int t = blockIdx.x; t < NB * 8 * 68; t += gridDim.x) {
        const int cc = t % 68, bh = t / 68, b = bh >> 3, h = bh & 7; const bool isc = cc < 4; const int L = isc ? CTXL : SEQ, n0 = 64 * (isc ? cc : cc - 4);
        if (tid < 192) { const int hr = tid / 48, c16 = tid % 48; const int n = (hr < 2) ? n0 - 2 + hr : n0 + 62 + hr;
            u32x4 v = (u32x4){0u, 0u, 0u, 0u};
            if (n >= 0 && n < L) v = *(const u32x4*)(P + (size_t)gdn_row(b, isc, n) * PC + C_GQ + (c16 >> 4) * 1024 + h * 128 + (c16 & 15) * 8);
            *(u32x4*)(HALO + ((size_t)t * 4 + hr) * 384 + c16 * 8) = v; }
    }
}
__device__ __forceinline__ void gdnprep_conv(const Args& a, LAS unsigned char* lds) {
    const int tid = threadIdx.x;
    constexpr int RAW = 0, PRAW = 784, CW = 53312;
    bf16_t* P = (bf16_t*)(a.ws + WS_P); const bf16_t* HALO = (const bf16_t*)(a.ws + WS_HALO);
    constexpr int NT = NB * 8 * 68;
    u32x4 rr[7]; float cwr[4];
#define GP_LOAD(t_) do { const int cc_ = (t_) % 68, bh_ = (t_) / 68, b_ = bh_ >> 3, h_ = bh_ & 7; const bool isc_ = cc_ < 4; const int n0_ = 64 * (isc_ ? cc_ : cc_ - 4); \
        _Pragma("unroll") for (int k = 0; k < 7; ++k) { int piece = tid + NTHR * k; piece = piece < 68 * 48 ? piece : 68 * 48 - 1; const int wr_ = piece / 48, c16 = piece % 48; \
            const bf16_t* src = (wr_ >= 2 && wr_ < 66) ? (P + (size_t)gdn_row(b_, isc_, n0_ + wr_ - 2) * PC + C_GQ + (c16 >> 4) * 1024 + h_ * 128 + (c16 & 15) * 8) \
                                                      : (HALO + ((size_t)(t_) * 4 + (wr_ < 2 ? wr_ : wr_ - 64)) * 384 + c16 * 8); \
            rr[k] = *(const u32x4*)src; } \
        _Pragma("unroll") for (int k = 0; k < 4; ++k) { int i = tid + NTHR * k; i = i < 1920 ? i : 1919; const int tap = i / 384, c3 = i % 384; cwr[k] = a.gdn_conv[(size_t)tap * 3072 + (c3 >> 7) * 1024 + h_ * 128 + (c3 & 127)]; } } while (0)
    if ((int)blockIdx.x < NT) GP_LOAD((int)blockIdx.x);
    for (int t = blockIdx.x; t < NT; t += gridDim.x) {
        const int cc = t % 68, bh = t / 68, b = bh >> 3, h = bh & 7; const bool isc = cc < 4; const int n0 = 64 * (isc ? cc : cc - 4);
        __syncthreads();
#pragma unroll
        for (int k = 0; k < 4; ++k) { const int i = tid + NTHR * k; if (i < 1920) ((LAS float*)(lds + CW))[i] = cwr[k]; }
#pragma unroll
        for (int k = 0; k < 7; ++k) { const int piece = tid + NTHR * k; if (piece < 68 * 48) { const int wr_ = piece / 48, c16 = piece % 48; *(LAS u32x4*)(lds + RAW + wr_ * PRAW + c16 * 16) = rr[k]; } }
        if (t + (int)gridDim.x < NT) GP_LOAD(t + (int)gridDim.x);
        if (tid < 128) {
            const int dirg = tid >> 6, nl = tid & 63; float* ABw = (float*)(a.ws + WS_AB);
            const size_t row = (size_t)gdn_row(b, isc, n0 + nl);
            const float al = ABw[row * 32 + dirg * 8 + h], bl = ABw[row * 32 + 16 + dirg * 8 + h];
            const float g = -__expf(a.a_log[dirg * 8 + h]) * softplus_f(al + a.dt_bias[dirg * 8 + h]);
            float Gc = g;
#pragma unroll
            for (int o = 1; o < 64; o <<= 1) { const float t = dirg ? __shfl_down(Gc, o) : __shfl_up(Gc, o); if (dirg ? (nl + o < 64) : (nl >= o)) Gc += t; }
            ABw[row * 32 + dirg * 8 + h] = Gc; ABw[row * 32 + 16 + dirg * 8 + h] = sigmoid_f(bl);
        }
        __syncthreads();
        {
            const int cg = tid & 31, tg = tid >> 5, nb = 4 * tg;
#pragma unroll 1
            for (int ten = 0; ten < 3; ++ten) {
                f32x4 wt[5];
#pragma unroll
                for (int tap = 0; tap < 5; ++tap) wt[tap] = *(const LAS f32x4*)((const LAS float*)(lds + CW) + tap * 384 + ten * 128 + 4 * cg);
                f32x4 acc[4];
#pragma unroll
                for (int u = 0; u < 4; ++u) acc[u] = (f32x4){0.f, 0.f, 0.f, 0.f};
#pragma unroll
                for (int rw_ = 0; rw_ < 8; ++rw_) { const u32x2 x = *(const LAS u32x2*)(lds + RAW + (nb + rw_) * PRAW + (ten * 128 + 4 * cg) * 2);
                    const f32x4 xv = (f32x4){bflo(x.x), bfhi(x.x), bflo(x.y), bfhi(x.y)};
#pragma unroll
                    for (int u = 0; u < 4; ++u) { const int tap = rw_ - u; if (tap >= 0 && tap < 5) acc[u] += wt[tap] * xv; } }
                float ss[4];
#pragma unroll
                for (int u = 0; u < 4; ++u) { acc[u].x = silu_f(acc[u].x); acc[u].y = silu_f(acc[u].y); acc[u].z = silu_f(acc[u].z); acc[u].w = silu_f(acc[u].w);
                    ss[u] = (acc[u].x * acc[u].x + acc[u].y * acc[u].y) + (acc[u].z * acc[u].z + acc[u].w * acc[u].w); }
                if (ten < 2) {
#pragma unroll
                    for (int o = 1; o < 32; o <<= 1) {
#pragma unroll
                        for (int u = 0; u < 4; ++u) ss[u] += __shfl_xor(ss[u], o); }
#pragma unroll
                    for (int u = 0; u < 4; ++u) { const float sc = rsqrtf(ss[u] + EPS) * (ten == 0 ? 0.08838834764831845f : 1.f); acc[u] = acc[u] * sc; }
                }
#pragma unroll
                for (int u = 0; u < 4; ++u) *(u32x2*)(P + (size_t)gdn_row(b, isc, n0 + nb + u) * PC + C_GQ + ten * 1024 + h * 128 + 4 * cg) = (u32x2){pk2(acc[u].x, acc[u].y), pk2(acc[u].z, acc[u].w)};
            }
        }
    }
}

#undef GP_LOAD

typedef short bf16x4 __attribute__((ext_vector_type(4)));
__device__ __forceinline__ unsigned cvtpk(float lo, float hi) { return pk2(lo, hi); }
__device__ __forceinline__ bf16x8 pack_tiles(const f32x4 t0, const f32x4 t1) {
    u32x4 r; r.x = cvtpk(t0[0], t0[1]); r.y = cvtpk(t0[2], t0[3]); r.z = cvtpk(t1[0], t1[1]); r.w = cvtpk(t1[2], t1[3]); return __builtin_bit_cast(bf16x8, r); }
__device__ __forceinline__ bf16x4 pack_tile(const f32x4 t) { u32x2 r; r.x = cvtpk(t[0], t[1]); r.y = cvtpk(t[2], t[3]); return __builtin_bit_cast(bf16x4, r); }
__device__ __forceinline__ bf16x8 lds_a_perm(const LAS unsigned char* p, int fq) {
    const u32x2 lo = *(const LAS u32x2*)(p + 8 * fq), hi = *(const LAS u32x2*)(p + 32 + 8 * fq);
    u32x4 r; r.x = lo.x; r.y = lo.y; r.z = hi.x; r.w = hi.y; return __builtin_bit_cast(bf16x8, r); }
#define MFMA32(A, B, C) __builtin_amdgcn_mfma_f32_16x16x32_bf16((A), (B), (C), 0, 0, 0)
#define MFMA16(A, B, C) __builtin_amdgcn_mfma_f32_16x16x16bf16_1k((A), (B), (C), 0, 0, 0)

__device__ __forceinline__ void scan_hgrn_mfma(const Args& a, LAS unsigned char* lds, const int b, const int h, const int dir) {
    int tid0 = threadIdx.x; asm volatile("" : "+v"(tid0)); const int w = __builtin_amdgcn_readfirstlane(tid0 >> 6);
    const int d = tid0 & 127, tq = tid0 >> 7;
    constexpr int QM = 0, KM = 17408, QT = 34816, KHT = 52224, VT = 70656, AM = 89088, AV = 98304, SEG = 98816;
    constexpr int PQ = 272, PT = 144;
    const bf16_t* P = (const bf16_t*)(a.ws + WS_P);
    bf16_t* O = (bf16_t*)((unsigned char*)a.out + (dir ? R2_OAB : R2_OAF));
    float lo;
    { const int ch = h * 128 + d; const float l0 = a.hgrn_lb[(dir * 2 + 0) * 1024 + ch], l1 = a.hgrn_lb[(dir * 2 + 1) * 1024 + ch]; lo = 1.f / (1.f + __expf(l1 - l0)); }
    const int cf = dir ? C_FB : C_FF;
    f32x4 S[8];
#pragma unroll
    for (int i = 0; i < 8; ++i) S[i] = (f32x4){0.f, 0.f, 0.f, 0.f};
    u32x4 rr[6];
#define HG_LOAD(cc) do { const int i_ = tid >> 3, part_ = tid & 7; const int p = 64 * (cc) + i_; \
        const int row = (p < CTXL) ? (MLAT + b * CTXL + (dir ? CTXL - 1 - p : p)) : (b * SEQ + (dir ? SEQ - 1 - (p - CTXL) : (p - CTXL))); \
        const bf16_t* pr = P + (size_t)row * PC + h * 128 + part_ * 16; \
        rr[0] = *(const u32x4*)(pr + C_HQ); rr[1] = *(const u32x4*)(pr + C_HQ + 8); rr[2] = *(const u32x4*)(pr + cf); rr[3] = *(const u32x4*)(pr + cf + 8); \
        rr[4] = *(const u32x4*)(pr + C_HI); rr[5] = *(const u32x4*)(pr + C_HI + 8); } while (0)
    { const int tid = tid0; HG_LOAD(0); }
    for (int c = 0; c < 68; ++c) {
        int tid = tid0; asm volatile("" : "+v"(tid)); const int lane = tid & 63, fr = lane & 15, fq = lane >> 4;
        __syncthreads();
        { const int i_ = tid >> 3, part_ = tid & 7;
          *(LAS u32x4*)(lds + QM + i_ * PQ + part_ * 32) = rr[0]; *(LAS u32x4*)(lds + QM + i_ * PQ + part_ * 32 + 16) = rr[1];
          *(LAS u32x4*)(lds + KM + i_ * PQ + part_ * 32) = rr[2]; *(LAS u32x4*)(lds + KM + i_ * PQ + part_ * 32 + 16) = rr[3];
          *(LAS u32x4*)(lds + QT + i_ * PQ + part_ * 32) = rr[4]; *(LAS u32x4*)(lds + QT + i_ * PQ + part_ * 32 + 16) = rr[5]; }
        if (c + 1 < 68) HG_LOAD(c + 1);
        __syncthreads();
        unsigned short ri[16];
        float fv[16], kk[16], qs[16]; float pl = 1.f;
#pragma unroll
        for (int t = 0; t < 16; ++t) { const int i_ = tq * 16 + t;
            const float xq = bf2f(*(const LAS unsigned short*)(lds + QM + i_ * PQ + d * 2)), xf = bf2f(*(const LAS unsigned short*)(lds + KM + i_ * PQ + d * 2)); ri[t] = *(const LAS unsigned short*)(lds + QT + i_ * PQ + d * 2);
            const float sg = sigmoid_f(xf); const float f = lo + (1.f - lo) * sg; kk[t] = (1.f - lo) * (1.f - sg); pl *= f; fv[t] = pl; qs[t] = silu_f(xq); }
        ((LAS float*)(lds + SEG))[tq * 128 + d] = pl;
        { u32x4 v0, v1; v0.x = ri[0] | ((unsigned)ri[1] << 16); v0.y = ri[2] | ((unsigned)ri[3] << 16); v0.z = ri[4] | ((unsigned)ri[5] << 16); v0.w = ri[6] | ((unsigned)ri[7] << 16);
          v1.x = ri[8] | ((unsigned)ri[9] << 16); v1.y = ri[10] | ((unsigned)ri[11] << 16); v1.z = ri[12] | ((unsigned)ri[13] << 16); v1.w = ri[14] | ((unsigned)ri[15] << 16);
          *(LAS u32x4*)(lds + VT + d * PT + tq * 32) = v0; *(LAS u32x4*)(lds + VT + d * PT + tq * 32 + 16) = v1; }
        __syncthreads();
        {
            const LAS float* sg = (const LAS float*)(lds + SEG);
            const float s0 = sg[d], s1 = sg[128 + d], s2 = sg[256 + d], s3 = sg[384 + d];
            const float pre = (tq == 0) ? 1.f : (tq == 1 ? s0 : (tq == 2 ? s0 * s1 : s0 * s1 * s2));
            const float pmid = s0 * s1, plast = pmid * s2 * s3, rmid = rcp_f(pmid), c1 = plast * rmid;
            unsigned kh[8];
#pragma unroll
            for (int t = 0; t < 16; ++t) {
                const float Pt = pre * fv[t], e1 = Pt * rmid, r1 = rcp_f(e1);
                const int i = tq * 16 + t;
                *(LAS unsigned short*)(lds + QM + i * PQ + d * 2) = (unsigned short)f2bf(qs[t] * e1);
                *(LAS unsigned short*)(lds + KM + i * PQ + d * 2) = (unsigned short)f2bf(kk[t] * r1);
                *(LAS unsigned short*)(lds + QT + i * PQ + d * 2) = (unsigned short)f2bf(qs[t] * Pt);
                const unsigned kb = f2bf(kk[t] * r1 * c1);
                if (t & 1) kh[t >> 1] |= kb << 16; else kh[t >> 1] = kb;
            }
            *(LAS u32x4*)(lds + KHT + d * PT + tq * 32) = (u32x4){kh[0], kh[1], kh[2], kh[3]}; *(LAS u32x4*)(lds + KHT + d * PT + tq * 32 + 16) = (u32x4){kh[4], kh[5], kh[6], kh[7]};
            if (tq == 0) ((LAS float*)(lds + AV))[d] = plast;
        }
        __syncthreads();
        {
            const int mt = w >> 1;
#pragma unroll
            for (int nn = 0; nn < 2; ++nn) { const int nt = (w & 1) * 2 + nn;
                f32x4 acc = (f32x4){0.f, 0.f, 0.f, 0.f};
                if (nt <= mt) {
#pragma unroll
                    for (int s = 0; s < 4; ++s) { const bf16x8 A = *(const LAS bf16x8*)(lds + QM + (16 * mt + fr) * PQ + (32 * s + 8 * fq) * 2), B = *(const LAS bf16x8*)(lds + KM + (16 * nt + fr) * PQ + (32 * s + 8 * fq) * 2);
                        acc = MFMA32(A, B, acc); } }
#pragma unroll
                for (int r = 0; r < 4; ++r) { const int i = 16 * mt + 4 * fq + r, j = 16 * nt + fr; *(LAS unsigned short*)(lds + AM + i * PT + j * 2) = (unsigned short)f2bf(j <= i ? acc[r] : 0.f); }
            }
        }
        __syncthreads();
        {
            bf16x8 vb[2];
#pragma unroll
            for (int s2 = 0; s2 < 2; ++s2) vb[s2] = *(const LAS bf16x8*)(lds + VT + (16 * w + fr) * PT + (32 * s2 + 8 * fq) * 2);
            if (c >= 4) {
                bf16x8 sb[4];
#pragma unroll
                for (int s = 0; s < 4; ++s) sb[s] = pack_tiles(S[2 * s], S[2 * s + 1]);
                f32x4 o[4];
#pragma unroll
                for (int mt = 0; mt < 4; ++mt) { o[mt] = (f32x4){0.f, 0.f, 0.f, 0.f};
#pragma unroll
                    for (int s = 0; s < 4; ++s) o[mt] = MFMA32(lds_a_perm(lds + QT + (16 * mt + fr) * PQ + 64 * s, fq), sb[s], o[mt]);
#pragma unroll
                    for (int s2 = 0; s2 < 2; ++s2) if (2 * s2 <= mt) o[mt] = MFMA32(*(const LAS bf16x8*)(lds + AM + (16 * mt + fr) * PT + (32 * s2 + 8 * fq) * 2), vb[s2], o[mt]);
                }
#pragma unroll
                for (int mt = 0; mt < 4; ++mt)
#pragma unroll
                    for (int r = 0; r < 4; ++r) { const int i = 16 * mt + 4 * fq + r, sidx = 64 * (c - 4) + i, pos = dir ? SEQ - 1 - sidx : sidx;
                        O[(size_t)(b * SEQ + pos) * 1024 + h * 128 + 16 * w + fr] = (bf16_t)f2bf(o[mt][r]); }
            }
#pragma unroll
            for (int dt = 0; dt < 8; ++dt) { const f32x4 a4 = *(const LAS f32x4*)(lds + AV + (16 * dt + 4 * fq) * 4); S[dt] = S[dt] * a4;
#pragma unroll
                for (int s2 = 0; s2 < 2; ++s2) S[dt] = MFMA32(*(const LAS bf16x8*)(lds + KHT + (16 * dt + fr) * PT + (32 * s2 + 8 * fq) * 2), vb[s2], S[dt]); }
        }
    }
#undef HG_LOAD
}

__device__ __forceinline__ void scan_gdn_mfma(const Args& a, LAS unsigned char* lds, const int b, const int h, const int dir) {
    int tid0 = threadIdx.x; asm volatile("" : "+v"(tid0)); const int w = __builtin_amdgcn_readfirstlane(tid0 >> 6);
    constexpr int RAW = 0, PRAW = 784;
    constexpr int LT = 0, AQK = 9216, LD = 18432, PT = 144;
    constexpr int QN = 53312, KN = 70720, PQ = 272;
    constexpr int KNT = 88128;
    constexpr int VB = 106560;
    constexpr int GT = 123968;
    constexpr int CW = 125008;
    const bf16_t* P = (const bf16_t*)(a.ws + WS_P); const float* AB = (const float*)(a.ws + WS_AB);
    bf16_t* O = (bf16_t*)((unsigned char*)a.out + (dir ? R2_OBB : R2_OBF));
    f32x4 S[8];
#pragma unroll
    for (int i = 0; i < 8; ++i) S[i] = (f32x4){0.f, 0.f, 0.f, 0.f};
    u32x4 rr[6]; float g_nx = 0.f, b_nx = 0.f;
#define GD_GEOM(c_, isc_, L_, n0_) const bool isc_ = (c_) < 4; const int L_ = isc_ ? CTXL : SEQ; const int n0_ = 64 * (isc_ ? (dir ? 3 - (c_) : (c_)) : (dir ? 63 - ((c_) - 4) : ((c_) - 4)));
#define GD_LOAD(c_) do { GD_GEOM(c_, isc, L, n0) (void)L; { const int i_ = tid >> 3, part_ = tid & 7; const int n = n0 + (dir ? 63 - i_ : i_); \
        const bf16_t* pr = P + (size_t)gdn_row(b, isc, n) * PC + C_GQ + h * 128 + part_ * 16; \
        rr[0] = *(const u32x4*)(pr); rr[1] = *(const u32x4*)(pr + 8); rr[2] = *(const u32x4*)(pr + 1024); rr[3] = *(const u32x4*)(pr + 1032); rr[4] = *(const u32x4*)(pr + 2048); rr[5] = *(const u32x4*)(pr + 2056); } \
        if (w == 0) { const int ln = tid & 63; const int n = n0 + (dir ? 63 - ln : ln); const size_t row = (size_t)gdn_row(b, isc, n); g_nx = AB[row * 32 + dir * 8 + h]; b_nx = AB[row * 32 + 16 + dir * 8 + h]; } } while (0)
    { const int tid = tid0; GD_LOAD(0); }
    for (int c = 0; c < 68; ++c) {
        GD_GEOM(c, isc, L, n0) (void)L; (void)isc;
        int tid = tid0; asm volatile("" : "+v"(tid));
        int lane = tid & 63, fr = lane & 15, fq = lane >> 4;
        __syncthreads();
        {
            const int i_ = tid >> 3, part_ = tid & 7;
            *(LAS u32x4*)(lds + QN + i_ * PQ + part_ * 32) = rr[0]; *(LAS u32x4*)(lds + QN + i_ * PQ + part_ * 32 + 16) = rr[1];
            *(LAS u32x4*)(lds + KN + i_ * PQ + part_ * 32) = rr[2]; *(LAS u32x4*)(lds + KN + i_ * PQ + part_ * 32 + 16) = rr[3];
            *(LAS u32x4*)(lds + VB + i_ * PQ + part_ * 32) = rr[4]; *(LAS u32x4*)(lds + VB + i_ * PQ + part_ * 32 + 16) = rr[5];
            const unsigned kw[8] = {rr[2].x, rr[2].y, rr[2].z, rr[2].w, rr[3].x, rr[3].y, rr[3].z, rr[3].w};
#pragma unroll
            for (int j = 0; j < 8; ++j) { *(LAS unsigned short*)(lds + KNT + (part_ * 16 + 2 * j) * PT + i_ * 2) = (unsigned short)(kw[j] & 0xffffu);
                *(LAS unsigned short*)(lds + KNT + (part_ * 16 + 2 * j + 1) * PT + i_ * 2) = (unsigned short)(kw[j] >> 16); }
        }
        const float g_in = g_nx, b_in = b_nx;
        if (c + 1 < 68) GD_LOAD(c + 1);
        if (w == 0) {
            const float G = g_in;
            const float Glast = __shfl(G, 63);
            LAS float* gt = (LAS float*)(lds + GT);
            gt[lane] = __expf(G); gt[64 + lane] = __expf(Glast - G); gt[128 + lane] = b_in; gt[192 + lane] = G;
            if (lane == 0) gt[256] = __expf(Glast);
        }
        __syncthreads();
        tid = tid0; asm volatile("" : "+v"(tid)); lane = tid & 63; fr = lane & 15; fq = lane >> 4;
        {
            const int mt = w >> 1;
            const LAS float* gt = (const LAS float*)(lds + GT);
#pragma unroll
            for (int nn = 0; nn < 2; ++nn) { const int nt = (w & 1) * 2 + nn;
                f32x4 akk = (f32x4){0.f, 0.f, 0.f, 0.f}, aqk = (f32x4){0.f, 0.f, 0.f, 0.f};
                if (nt <= mt) {
#pragma unroll
                    for (int s = 0; s < 4; ++s) { const bf16x8 Bk = *(const LAS bf16x8*)(lds + KN + (16 * nt + fr) * PQ + (32 * s + 8 * fq) * 2);
                        akk = MFMA32(*(const LAS bf16x8*)(lds + KN + (16 * mt + fr) * PQ + (32 * s + 8 * fq) * 2), Bk, akk);
                        aqk = MFMA32(*(const LAS bf16x8*)(lds + QN + (16 * mt + fr) * PQ + (32 * s + 8 * fq) * 2), Bk, aqk); } }
                const int j = 16 * nt + fr; const float Gj = gt[192 + j];
                const f32x4 Gi4 = *(const LAS f32x4*)(gt + 192 + 16 * mt + 4 * fq), bi4 = *(const LAS f32x4*)(gt + 128 + 16 * mt + 4 * fq);
#pragma unroll
                for (int r = 0; r < 4; ++r) { const int i = 16 * mt + 4 * fq + r; const float Gi = Gi4[r], bi = bi4[r];
                    const float gam = (j <= i) ? __expf(Gi - Gj) : 0.f;
                    *(LAS unsigned short*)(lds + AQK + i * PT + j * 2) = (unsigned short)f2bf(aqk[r] * gam);
                    const float Lij = (j < i) ? bi * akk[r] * gam : 0.f;
                    if (nt == mt) *(LAS unsigned short*)(lds + LD + (mt * 16 + (4 * fq + r)) * 40 + fr * 2) = (unsigned short)f2bf(-Lij);
                    else *(LAS unsigned short*)(lds + LT + i * PT + j * 2) = (unsigned short)f2bf(-Lij); }
            }
        }
        __syncthreads();
        tid = tid0; asm volatile("" : "+v"(tid)); lane = tid & 63; fr = lane & 15; fq = lane >> 4;
        if (w < 4) {
            const bf16x4 nl = *(const LAS bf16x4*)(lds + LD + (w * 16 + fr) * 40 + (4 * fq) * 2);
            f32x4 eye; eye[0] = (4 * fq + 0 == fr) ? 1.f : 0.f; eye[1] = (4 * fq + 1 == fr) ? 1.f : 0.f; eye[2] = (4 * fq + 2 == fr) ? 1.f : 0.f; eye[3] = (4 * fq + 3 == fr) ? 1.f : 0.f;
            f32x4 X = eye;
#pragma unroll
            for (int it = 0; it < 15; ++it) X = MFMA16(nl, pack_tile(X), eye);
#pragma unroll
            for (int r = 0; r < 4; ++r) *(LAS unsigned short*)(lds + LT + (16 * w + 4 * fq + r) * PT + (16 * w + fr) * 2) = (unsigned short)f2bf(X[r]);
        }
        __syncthreads();
        tid = tid0; asm volatile("" : "+v"(tid)); lane = tid & 63; fr = lane & 15; fq = lane >> 4;
        {
            const LAS float* gt = (const LAS float*)(lds + GT);
            bf16x8 sb[4];
#pragma unroll
            for (int s = 0; s < 4; ++s) sb[s] = pack_tiles(S[2 * s], S[2 * s + 1]);
            f32x4 R[4];
#pragma unroll
            for (int mt = 0; mt < 4; ++mt) { f32x4 X = (f32x4){0.f, 0.f, 0.f, 0.f};
#pragma unroll
                for (int s = 0; s < 4; ++s) X = MFMA32(lds_a_perm(lds + KN + (16 * mt + fr) * PQ + 64 * s, fq), sb[s], X);
                const f32x4 be4 = *(const LAS f32x4*)(gt + 128 + 16 * mt + 4 * fq), eg4 = *(const LAS f32x4*)(gt + 16 * mt + 4 * fq);
#pragma unroll
                for (int r = 0; r < 4; ++r) { const int i = 16 * mt + 4 * fq + r; const float vv = bf2f(*(const LAS unsigned short*)(lds + VB + i * PQ + (16 * w + fr) * 2));
                    R[mt][r] = be4[r] * (vv - eg4[r] * X[r]); } }
            f32x4 vt[4];
#pragma unroll
            for (int ab = 0; ab < 4; ++ab) { f32x4 acc = R[ab];
#pragma unroll
                for (int bb = 0; bb < ab; ++bb) acc = MFMA16(*(const LAS bf16x4*)(lds + LT + (16 * ab + fr) * PT + (16 * bb + 4 * fq) * 2), pack_tile(vt[bb]), acc);
                const f32x4 z4 = {0.f, 0.f, 0.f, 0.f}; vt[ab] = MFMA16(*(const LAS bf16x4*)(lds + LT + (16 * ab + fr) * PT + (16 * ab + 4 * fq) * 2), pack_tile(acc), z4); }
            if (c >= 4) {
                const bf16x8 vnb0 = pack_tiles(vt[0], vt[1]), vnb1 = pack_tiles(vt[2], vt[3]);
                const int ccn = n0 >> 6;
#pragma unroll
                for (int mt = 0; mt < 4; ++mt) { f32x4 o = (f32x4){0.f, 0.f, 0.f, 0.f};
#pragma unroll
                    for (int s = 0; s < 4; ++s) o = MFMA32(lds_a_perm(lds + QN + (16 * mt + fr) * PQ + 64 * s, fq), sb[s], o);
                    o = o * *(const LAS f32x4*)(gt + 16 * mt + 4 * fq);
                    o = MFMA32(lds_a_perm(lds + AQK + (16 * mt + fr) * PT, fq), vnb0, o);
                    if (mt >= 2) o = MFMA32(lds_a_perm(lds + AQK + (16 * mt + fr) * PT + 64, fq), vnb1, o);
#pragma unroll
                    for (int r = 0; r < 4; ++r) { const int i = 16 * mt + 4 * fq + r, nloc = dir ? 63 - i : i;
                        O[(size_t)(b * SEQ + nloc * 64 + ccn) * 1024 + h * 128 + 16 * w + fr] = (bf16_t)f2bf(o[r]); } }
            }
#pragma unroll
            for (int mt = 0; mt < 4; ++mt) vt[mt] = vt[mt] * *(const LAS f32x4*)(gt + 64 + 16 * mt + 4 * fq);
            const bf16x8 vsb0 = pack_tiles(vt[0], vt[1]), vsb1 = pack_tiles(vt[2], vt[3]);
            const float egl = gt[256];
#pragma unroll
            for (int dt = 0; dt < 8; ++dt) { S[dt] = S[dt] * egl;
                S[dt] = MFMA32(lds_a_perm(lds + KNT + (16 * dt + fr) * PT, fq), vsb0, S[dt]);
                S[dt] = MFMA32(lds_a_perm(lds + KNT + (16 * dt + fr) * PT + 64, fq), vsb1, S[dt]); }
        }
    }
#undef GD_LOAD
#undef GD_GEOM
}

#ifndef SCAN_MODE
#define SCAN_MODE 3
#endif
__device__ __forceinline__ void phase_scan(const Args& a, LAS unsigned char* lds) {
    for (int it = blockIdx.x; it < 128; it += gridDim.x) {
        const int ch = it & 63, b = ch >> 4, h = (ch >> 1) & 7, dir = ch & 1;
        if (it < 64) { if (SCAN_MODE & 1) scan_hgrn_mfma(a, lds, b, h, dir); else scan_hgrn_naive(a, lds, b, h, dir);
 }
        else { if (SCAN_MODE & 2) scan_gdn_mfma(a, lds, b, h, dir); else scan_gdn_naive(a, lds, b, h, dir);
 }
        __syncthreads();
    }
}

__device__ __forceinline__ void phase_mergeprep(const Args& a) {
    const int tid = threadIdx.x, lane = tid & 63, wave = tid >> 6, G = gridDim.x;
    const bf16_t* P = (const bf16_t*)(a.ws + WS_P);
    const bf16_t* OAF = (const bf16_t*)((const unsigned char*)a.out + R2_OAF); const bf16_t* OAB = (const bf16_t*)((const unsigned char*)a.out + R2_OAB);
    const bf16_t* OBF = (const bf16_t*)((const unsigned char*)a.out + R2_OBF); const bf16_t* OBB = (const bf16_t*)((const unsigned char*)a.out + R2_OBB);
    bf16_t* YAB = (bf16_t*)(a.ws + WS_R1 + R1_YAB);
    const int c0 = lane * 16;
    u32x4 L[2][6], Ln[2][6];
#define MP_LOAD(dst, r_) do { _Pragma("unroll") for (int br = 0; br < 2; ++br) { const bf16_t* o1 = (br ? OBF : OAF) + (size_t)(r_) * 1024 + c0; const bf16_t* o2 = (br ? OBB : OAB) + (size_t)(r_) * 1024 + c0; \
        const bf16_t* gp = P + (size_t)(r_) * PC + (br ? C_Z : C_OG) + c0; \
        dst[br][0] = *(const u32x4*)o1; dst[br][1] = *(const u32x4*)(o1 + 8); dst[br][2] = *(const u32x4*)o2; dst[br][3] = *(const u32x4*)(o2 + 8); dst[br][4] = *(const u32x4*)gp; dst[br][5] = *(const u32x4*)(gp + 8); } } while (0)
    { const int r0 = blockIdx.x * NWAVES + wave; if (r0 < MLAT) MP_LOAD(L, r0); }
    for (int r = blockIdx.x * NWAVES + wave; r < MLAT; r += G * NWAVES) {
        { const int rn = r + G * NWAVES; if (rn < MLAT) MP_LOAD(Ln, rn); }
#pragma unroll
        for (int br = 0; br < 2; ++br) {
            const float* gain = (br ? a.gdn_norm : a.hgrn_norm) + c0;
            float val[16], gt[16]; float ss = 0.f;
#pragma unroll
            for (int hx = 0; hx < 2; ++hx) {
                const u32x4 w1 = L[br][hx], w2 = L[br][2 + hx], wg = L[br][4 + hx];
                const unsigned u1[4] = {w1.x, w1.y, w1.z, w1.w}, u2[4] = {w2.x, w2.y, w2.z, w2.w}, ug[4] = {wg.x, wg.y, wg.z, wg.w};
#pragma unroll
                for (int j = 0; j < 4; ++j) {
                    float s0 = bflo(u1[j]) + bflo(u2[j]), s1 = bfhi(u1[j]) + bfhi(u2[j]); const float g0 = bflo(ug[j]), g1 = bfhi(ug[j]);
                    if (br == 0) { s0 *= sigmoid_f(g0); s1 *= sigmoid_f(g1); gt[8 * hx + 2 * j] = 1.f; gt[8 * hx + 2 * j + 1] = 1.f; }
                    else { gt[8 * hx + 2 * j] = silu_f(g0); gt[8 * hx + 2 * j + 1] = silu_f(g1); }
                    val[8 * hx + 2 * j] = s0; val[8 * hx + 2 * j + 1] = s1; ss += s0 * s0 + s1 * s1; }
            }
            ss += __shfl_xor(ss, 1); ss += __shfl_xor(ss, 2); ss += __shfl_xor(ss, 4);
            const float rstd = rsqrtf(ss * (1.f / 128.f) + EPS);
            unsigned ow[8];
#pragma unroll
            for (int j = 0; j < 8; ++j) { const f32x2 gn = *(const f32x2*)(gain + 2 * j);
                ow[j] = pk2(val[2 * j] * rstd * gn.x * gt[2 * j], val[2 * j + 1] * rstd * gn.y * gt[2 * j + 1]); }
            bf16_t* dst = YAB + (size_t)r * D + br * 1024 + c0;
            *(u32x4*)dst = (u32x4){ow[0], ow[1], ow[2], ow[3]}; *(u32x4*)(dst + 8) = (u32x4){ow[4], ow[5], ow[6], ow[7]};
        }
#pragma unroll
        for (int br = 0; br < 2; ++br)
#pragma unroll
            for (int k = 0; k < 6; ++k) L[br][k] = Ln[br][k];
    }
#undef MP_LOAD
}

__device__ __forceinline__ float reduce16(const float (&p)[16], const int lane) {
    float q8[8], q4[4], q2[2];
#pragma unroll
    for (int i = 0; i < 8; ++i) { const bool hi = (lane & 32) != 0; const float snd = hi ? p[i] : p[i + 8], kp = hi ? p[i + 8] : p[i]; q8[i] = kp + __shfl_xor(snd, 32); }
#pragma unroll
    for (int i = 0; i < 4; ++i) { const bool hi = (lane & 16) != 0; const float snd = hi ? q8[i] : q8[i + 4], kp = hi ? q8[i + 4] : q8[i]; q4[i] = kp + __shfl_xor(snd, 16); }
#pragma unroll
    for (int i = 0; i < 2; ++i) { const bool hi = (lane & 8) != 0; const float snd = hi ? q4[i] : q4[i + 2], kp = hi ? q4[i + 2] : q4[i]; q2[i] = kp + __shfl_xor(snd, 8); }
    float q1; { const bool hi = (lane & 4) != 0; const float snd = hi ? q2[0] : q2[1], kp = hi ? q2[1] : q2[0]; q1 = kp + __shfl_xor(snd, 4); }
    q1 += __shfl_xor(q1, 2); q1 += __shfl_xor(q1, 1);
    return q1;
}
__device__ __forceinline__ void phase_norm2(const Args& a, LAS unsigned char* lds) {
    const int tid = threadIdx.x, lane0 = tid & 63, wave = tid >> 6, G = gridDim.x;
    const modfx_t* MOD = (const modfx_t*)(a.ws + WS_MOD); const bf16_t* X1 = (const bf16_t*)(a.ws + WS_P + P_X1);
    bf16_t* H2 = (bf16_t*)(a.ws + WS_R1 + R1_H2); float* AFF = (float*)(a.ws + WS_AFF);
    LAS float* rw = (LAS float*)lds;
    for (int i = tid; i < D * NE; i += NTHR) { const int c = i >> 4, e = i & 15; rw[e * 2052 + c] = a.router_w[i]; }
    __syncthreads();
    for (int r = blockIdx.x * NWAVES + wave; r < MLAT; r += G * NWAVES) {
        int lane_o = lane0; asm volatile("" : "+v"(lane_o));
        const int lane = lane_o;
        const int b = r >> 12, n = r & 4095;
        f32x4 v[8]; float ss = 0.f;
#pragma unroll
        for (int j = 0; j < 8; ++j) { const u32x2 xw = *(const u32x2*)(X1 + (size_t)r * D + lane * 4 + 256 * j); v[j] = (f32x4){bflo(xw.x), bfhi(xw.x), bflo(xw.y), bfhi(xw.y)}; ss += (v[j].x * v[j].x + v[j].y * v[j].y) + (v[j].z * v[j].z + v[j].w * v[j].w); }
        const float rstd = rsqrtf(wave_sum(ss) * (1.f / D) + EPS);
#pragma unroll
        for (int j = 0; j < 8; ++j) { const int c = lane * 4 + 256 * j;
            const f32x4 nf = *(const f32x4*)(a.norm_ffn + c);
            const f32x4 sh = mod4(MOD, b * 12288 + 3 * D + c) + *(const f32x4*)(a.ada_b + 3 * D + c);
            const f32x4 scl = mod4(MOD, b * 12288 + 4 * D + c) + *(const f32x4*)(a.ada_b + 4 * D + c);
            v[j] = v[j] * rstd * nf * (scl + 1.f) + sh;
            *(unsigned*)((unsigned char*)H2 + (size_t)r * D + c) = pk4_fp8(v[j].x, v[j].y, v[j].z, v[j].w); }
        float p[16];
#pragma unroll
        for (int e = 0; e < 16; ++e) { float s = 0.f;
#pragma unroll
            for (int j = 0; j < 8; ++j) { const f32x4 w4 = *(const LAS f32x4*)(rw + e * 2052 + lane * 4 + 256 * j); s += (v[j].x * w4.x + v[j].y * w4.y) + (v[j].z * w4.z + v[j].w * w4.w); }
            p[e] = s; asm volatile("" ::: "memory"); }
        const float lg = reduce16(p, lane);
        float mx = lg;
#pragma unroll
        for (int o = 4; o < 64; o <<= 1) mx = fmaxf(mx, __shfl_xor(mx, o));
        const float ex = __expf(lg - mx); float den = ex;
#pragma unroll
        for (int o = 4; o < 64; o <<= 1) den += __shfl_xor(den, o);
        if ((lane & 3) == 0) AFF[(size_t)(b * NE + ((lane >> 2) & 15)) * SEQ + n] = ex / den;
    }
}

__device__ __forceinline__ void phase_topk(const Args& a, LAS unsigned char* lds) {
    const int tid = threadIdx.x, lane = tid & 63, wave = tid >> 6;
    const float* AFF = (const float*)(a.ws + WS_AFF); int* IDX = (int*)(a.ws + WS_IDX); float* GATEV = (float*)(a.ws + WS_GATEV); int* INV = (int*)(a.ws + WS_INV);
    LAS unsigned* wc = (LAS unsigned*)lds;
    LAS int* sel = (LAS int*)(lds + 256);
    const unsigned char* H2q = (const unsigned char*)(a.ws + WS_R1 + R1_H2); unsigned char* XS = (unsigned char*)a.out;
    const int nq = (gridDim.x >= 256) ? 4 : 1;
    for (int item = blockIdx.x; item < NB * NE * nq; item += gridDim.x) {
        const int be = item / nq, qtr = item % nq, b = be >> 4, e = be & 15;
        unsigned key[8];
        { const u32x4 k0 = *(const u32x4*)(AFF + (size_t)be * SEQ + tid * 8), k1 = *(const u32x4*)(AFF + (size_t)be * SEQ + tid * 8 + 4);
          key[0] = k0.x; key[1] = k0.y; key[2] = k0.z; key[3] = k0.w; key[4] = k1.x; key[5] = k1.y; key[6] = k1.z; key[7] = k1.w; }
        unsigned prefix = 0u;
        __syncthreads();
        for (int bit = 31; bit >= 0; --bit) {
            const unsigned cand = prefix | (1u << bit);
            unsigned cnt = 0;
#pragma unroll
            for (int i = 0; i < 8; ++i) cnt += (unsigned)__popcll(__ballot(key[i] >= cand));
            if (lane == 0) wc[(bit & 1) * 8 + wave] = cnt;
            __syncthreads();
            unsigned tot = 0;
#pragma unroll
            for (int w = 0; w < 8; ++w) tot += wc[(bit & 1) * 8 + w];
            if (tot >= (unsigned)CAP) prefix = cand;
        }
        const unsigned T = prefix;
        int cgt = 0, ceq = 0;
#pragma unroll
        for (int i = 0; i < 8; ++i) { cgt += key[i] > T; ceq += key[i] == T; }
        int val = cgt | (ceq << 16), inc = val;
#pragma unroll
        for (int o = 1; o < 64; o <<= 1) { const int t = __shfl_up(inc, o); if (lane >= o) inc += t; }
        __syncthreads();
        if (lane == 63) wc[16 + wave] = (unsigned)inc;
        __syncthreads();
        int base = 0, total = 0;
#pragma unroll
        for (int w = 0; w < 8; ++w) { const int t = (int)wc[16 + w]; total += t; if (w < wave) base += t; }
        const int excl = base + inc - val;
        int gt_before = excl & 0xffff, eq_before = excl >> 16;
        const int need = CAP - (total & 0xffff);
#pragma unroll
        for (int i = 0; i < 8; ++i) {
            const int n = tid * 8 + i; int slot = -1;
            if (key[i] > T) { slot = gt_before + (eq_before < need ? eq_before : need); ++gt_before; }
            else if (key[i] == T) { if (eq_before < need) slot = gt_before + eq_before; ++eq_before; }
            if (slot >= 0) { sel[slot] = n; if (qtr == 0) { IDX[be * CAP + slot] = n; GATEV[be * CAP + slot] = __uint_as_float(key[i]); } }
            if (qtr == 0) INV[(size_t)(b * SEQ + n) * NE + e] = slot;
        }
        __syncthreads();
        for (int sl = qtr * (CAP / nq) + wave; sl < (qtr + 1) * (CAP / nq); sl += NWAVES) { const int n = sel[sl];
            const u32x4* src = (const u32x4*)(H2q + (size_t)(b * SEQ + n) * D); u32x4* dst = (u32x4*)(XS + (size_t)(be * CAP + sl) * D);
#pragma unroll
            for (int j = 0; j < 2; ++j) dst[lane + 64 * j] = src[lane + 64 * j]; }
        __syncthreads();
    }
}

__device__ __forceinline__ void phase_gather(const Args& a) {
    const int tid = threadIdx.x, lane = tid & 63, wave = tid >> 6, G = gridDim.x;
    const bf16_t* H2 = (const bf16_t*)(a.ws + WS_R1 + R1_H2); const int* IDX = (const int*)(a.ws + WS_IDX); bf16_t* XS = (bf16_t*)a.out;
    for (int r = blockIdx.x * NWAVES + wave; r < NB * NE * CAP; r += G * NWAVES) {
        const int b = r >> 13; const int n = IDX[r];
        const u32x4* src = (const u32x4*)((const unsigned char*)H2 + (size_t)(b * SEQ + n) * D); u32x4* dst = (u32x4*)((unsigned char*)XS + (size_t)r * D);
#pragma unroll
        for (int j = 0; j < 2; ++j) dst[lane + 64 * j] = src[lane + 64 * j];
    }
}

__device__ __forceinline__ void phase_final(const Args& a) {
    const int tid = threadIdx.x, lane = tid & 63, wave = tid >> 6, G = gridDim.x;
    const modfx_t* MOD = (const modfx_t*)(a.ws + WS_MOD); const bf16_t* X1 = (const bf16_t*)(a.ws + WS_P + P_X1);
    const bf16_t* YE = (const bf16_t*)(a.ws + WS_P + P_WGU); const int* INV = (const int*)(a.ws + WS_INV);
    for (int r = blockIdx.x * NWAVES + wave; r < MLAT; r += G * NWAVES) {
        const int b = r >> 12;
        const int myslot = (lane < 16) ? INV[(size_t)r * NE + lane] : -1;
        u32x2 xw[8];
#pragma unroll
        for (int j = 0; j < 8; ++j) xw[j] = *(const u32x2*)(X1 + (size_t)r * D + lane * 4 + 256 * j);
        f32x4 f[8];
#pragma unroll
        for (int j = 0; j < 8; ++j) f[j] = (f32x4){0.f, 0.f, 0.f, 0.f};
        unsigned long long mask = __ballot(myslot >= 0);
        while (mask) {
            const int e0 = __builtin_ctzll(mask); mask &= mask - 1;
            const int e1 = mask ? __builtin_ctzll(mask) : -1; if (mask) mask &= mask - 1;
            const int s0 = __shfl(myslot, e0), s1 = (e1 >= 0) ? __shfl(myslot, e1) : 0;
            const bf16_t* y0 = YE + ((size_t)(b * NE + e0) * CAP + s0) * D; const bf16_t* y1 = YE + ((size_t)(b * NE + (e1 >= 0 ? e1 : e0)) * CAP + s1) * D;
            u32x2 w0[8], w1[8];
#pragma unroll
            for (int j = 0; j < 8; ++j) { w0[j] = *(const u32x2*)(y0 + lane * 4 + 256 * j); w1[j] = *(const u32x2*)(y1 + lane * 4 + 256 * j); }
            const float k1 = (e1 >= 0) ? 1.f : 0.f;
#pragma unroll
            for (int j = 0; j < 8; ++j) { f[j].x += bflo(w0[j].x) + k1 * bflo(w1[j].x); f[j].y += bfhi(w0[j].x) + k1 * bfhi(w1[j].x); f[j].z += bflo(w0[j].y) + k1 * bflo(w1[j].y); f[j].w += bfhi(w0[j].y) + k1 * bfhi(w1[j].y); }
        }
        float ss = 0.f;
#pragma unroll
        for (int j = 0; j < 8; ++j) { const int c = lane * 4 + 256 * j;
            const f32x4 m5 = mod4(MOD, b * 12288 + 5 * D + c) + *(const f32x4*)(a.ada_b + 5 * D + c);
            f[j] = (f32x4){bflo(xw[j].x), bfhi(xw[j].x), bflo(xw[j].y), bfhi(xw[j].y)} + m5 * f[j];
            ss += (f[j].x * f[j].x + f[j].y * f[j].y) + (f[j].z * f[j].z + f[j].w * f[j].w); }
        const float rstd = rsqrtf(wave_sum(ss) * (1.f / D) + EPS);
#pragma unroll
        for (int j = 0; j < 8; ++j) { const int c = lane * 4 + 256 * j; *(f32x4*)(a.out + (size_t)r * D + c) = f[j] * rstd * *(const f32x4*)(a.final_norm + c); }
    }
}

#define XB_TMO      128
#define XB_XCNT(j)  (256  + 64 * (j))
#define XB_XSUB(j)  (1280 + 64 * (j))
#define XB_XGEN(j)  (2304 + 64 * (j))
#define XB_TOP      3328
#define XB_TOPGEN   3392
#define XCD_BAR_WORDS 3456
#define XB_SPIN_CAP (1u << 18)
__device__ __forceinline__ unsigned xb_ld(unsigned* p)              { return __hip_atomic_load(p, __ATOMIC_RELAXED, __HIP_MEMORY_SCOPE_AGENT); }
__device__ __forceinline__ unsigned xb_add(unsigned* p, unsigned v) { return __hip_atomic_fetch_add(p, v, __ATOMIC_RELAXED, __HIP_MEMORY_SCOPE_AGENT); }
__device__ __forceinline__ unsigned xb_xcc_id() { return (unsigned)__builtin_amdgcn_s_getreg((3 << 11) | 20) & 0xFu; }
#define XB_SPIN(cond, bar) do { unsigned _sp = 0; while (cond) { __builtin_amdgcn_s_sleep(1); \
    if ((++_sp & 255u) == 0u) { if (xb_ld(&(bar)[XB_TMO])) break; if (_sp > XB_SPIN_CAP) { atomicAdd(&(bar)[XB_TMO], 1u); break; } } } } while (0)
struct XcdBarrier { unsigned* bar; unsigned x; volatile LAS unsigned* st; };
__device__ __forceinline__ XcdBarrier xcd_barrier_post(unsigned* bar, volatile LAS unsigned* st) {
    XcdBarrier b; b.bar = bar; b.x = xb_xcc_id(); b.st = st;
    if (threadIdx.x == 0) (void)xb_add(&bar[XB_XCNT(b.x)], 1u);
    return b;
}
__device__ __forceinline__ void xcd_barrier_complete(unsigned* bar, unsigned x, unsigned& nloc, unsigned& nx) {
    const unsigned G = gridDim.x * gridDim.y * gridDim.z;
    unsigned sum, cnt, mine, sp = 0u;
    for (;;) {
        sum = 0u; cnt = 0u; mine = 0u;
#pragma unroll
        for (unsigned j = 0; j < 16; ++j) { const unsigned c = xb_ld(&bar[XB_XCNT(j)]); sum += c; cnt += (c > 0u) ? 1u : 0u; mine = (j == x) ? c : mine; }
        if (sum == G) break;
        __builtin_amdgcn_s_sleep(1);
        if ((++sp & 255u) == 0u) { if (xb_ld(&bar[XB_TMO])) break; if (sp > XB_SPIN_CAP) { atomicAdd(&bar[XB_TMO], 1u); break; } }
    }
    nloc = mine > 0u ? mine : 1u; nx = cnt > 0u ? cnt : 1u;
}
__device__ __forceinline__ void xcd_barrier_at(unsigned* bar_, const XcdBarrier& b) {
    asm volatile("s_waitcnt vmcnt(0)" ::: "memory");
    __syncthreads();
    if (threadIdx.x == 0) {
        unsigned* bar = bar_;
        const unsigned bx = (unsigned)__builtin_amdgcn_readfirstlane((int)xb_xcc_id());
        __builtin_amdgcn_s_waitcnt(0);
        unsigned nloc = b.st[0], nx = b.st[1];
        if (nloc == 0u) { xcd_barrier_complete(bar, bx, nloc, nx); b.st[0] = nloc; b.st[1] = nx; }
        const unsigned old = xb_add(&bar[XB_XSUB(bx)], 1u);
        const unsigned gen = old / nloc;
        if (old + 1u == (gen + 1u) * nloc) {
            __builtin_amdgcn_fence(__ATOMIC_RELEASE, "agent");
            asm volatile("s_waitcnt vmcnt(0)" ::: "memory");
            const unsigned og = xb_add(&bar[XB_TOP], 1u);
            const unsigned tg = og / nx;
            if (og + 1u == (tg + 1u) * nx) xb_add(&bar[XB_TOPGEN], 1u);
            else XB_SPIN(xb_ld(&bar[XB_TOPGEN]) == tg, bar);
            __builtin_amdgcn_fence(__ATOMIC_ACQUIRE, "agent");
            xb_add(&bar[XB_XGEN(bx)], 1u);
            asm volatile("s_waitcnt vmcnt(0)" ::: "memory");
        } else {
            XB_SPIN(xb_ld(&bar[XB_XGEN(bx)]) == gen, bar);
            __builtin_amdgcn_fence(__ATOMIC_ACQUIRE, "agent");
            asm volatile("s_waitcnt vmcnt(0)" ::: "memory");
        }
    }
    __syncthreads();
}

constexpr int NPHASE = 13;
constexpr int ZFILL = 76;
__global__ void __launch_bounds__(NTHR, 2) fwd(Args a) {
    extern __shared__ __attribute__((aligned(16))) unsigned char lds_raw[];
    LAS unsigned char* lds = (LAS unsigned char*)lds_raw;
#if ONE_LAUNCH
    constexpr int lo = 0, hi = NPHASE;
#else
    const int lo = a.ph_lo, hi = a.ph_hi;
#endif
    const int G = gridDim.x, cidx = blockIdx.x;
    unsigned char* ws = a.ws;
    volatile LAS unsigned* bst = (volatile LAS unsigned*)(lds + LDS_BYTES - 16);
    if (threadIdx.x < 4) bst[threadIdx.x] = 0u;
    __syncthreads();
    XcdBarrier xbar = xcd_barrier_post((unsigned*)(ws + WS_BAR), bst);
#ifndef PHASE_MASK
#define PHASE_MASK 0xFFFF
#endif
#define IN(k) (((PHASE_MASK >> (k)) & 1) && lo <= (k) && (k) < hi)
#ifndef REPEAT_MASK
#define REPEAT_MASK 0
#endif
#define REP(k) (1 + ((REPEAT_MASK >> (k)) & 1))
#define SEAM(k) do { if (IN(k) && IN((k) + 1)) { if (gridDim.x > 1024u) cg::this_grid().sync(); else xcd_barrier_at((unsigned*)(a.ws + WS_BAR), xbar); } } while (0)
    if (IN(0)) for (int rep_ = 0; rep_ < REP(0); ++rep_) { if (rep_) cg::this_grid().sync(); phase_prep(a, lds); } SEAM(0);
    if (IN(1)) for (int rep_ = 0; rep_ < REP(1); ++rep_) { if (rep_) cg::this_grid().sync(); phase_norm1(a); } SEAM(1);
    if (IN(2)) for (int rep_ = 0; rep_ < REP(2); ++rep_) { if (rep_) cg::this_grid().sync();
        pg8::SchedTwo S; S.G = G; S.c = cidx;
        S.a.init(MTOT, 29 * 256, 1, 0, ws + WS_R1 + R1_H, ws + WS_R1 + R1_WINT, (size_t)256 * D * 2, (size_t)256 * D * 2, 0, 0, 1); S.na = S.a.nwg;
        S.b.init(MLAT, 4 * 256, 1, 0, ws + WS_R1 + R1_H, ws + WS_R1 + R1_WINT, (size_t)256 * D * 2, (size_t)256 * D * 2, 0, 0, 4);
        S.nextra = (G >= 256) ? ZFILL : 0;
        pg8::EpiP E{(bf16_t*)(ws + WS_P), (float*)(ws + WS_AB), 1.f};
        pg8::gemm_phase<pg8::EpiP, pg8::SchedTwo, false>(lds, D, D, D, S, E);
    } SEAM(2);
    if (IN(3)) for (int rep_ = 0; rep_ < REP(3); ++rep_) { if (rep_) cg::this_grid().sync();
        gdnprep_halo(a); xcd_barrier_at((unsigned*)(a.ws + WS_BAR), xbar); gdnprep_conv(a, lds); xcd_barrier_at((unsigned*)(a.ws + WS_BAR), xbar);
        if (G < 256 || cidx < 128) phase_scan(a, lds);
        if (G >= 256 && cidx < 256 - ZFILL - 128) {
            pg8::SchedPlain S; S.init(MLAT, 4 * 256, 1, 0, ws + WS_R1 + R1_H, ws + WS_R1 + R1_WINT, (size_t)256 * D * 2, (size_t)256 * D * 2, 0, 0, 4);
            S.ubeg = ZFILL + 128 + cidx; S.uend = S.ubeg + 1;
            pg8::EpiP E{(bf16_t*)(ws + WS_P), (float*)(ws + WS_AB), 1.f};
            pg8::gemm_phase<pg8::EpiP, pg8::SchedPlain, false>(lds, D, D, D, S, E);
        }
        if (G < 256 || cidx >= 128) {
            const int Gg = (G < 256) ? G : 128, cg_ = (G < 256) ? cidx : cidx - 128;
            {
                pg8::SchedPlain S; S.init(MLAT, 20 * 256, Gg, cg_, ws + WS_R2 + R2_H8, ws + WS_WIN8, (size_t)256 * D, (size_t)256 * D, 0, 0, 3);
                pg8::EpiP E{(bf16_t*)(ws + WS_P), (float*)(ws + WS_AB), 1.f / W8_SCALE};
                pg8::gemm_phase<pg8::EpiP, pg8::SchedPlain, false, true>(lds, D / 2, D / 2, D / 2, S, E);
            }
            {
                pg8::SchedPlain S; S.init(MLAT, 4 * 256, Gg, cg_, ws + WS_R1 + R1_H, ws + WS_R1 + R1_WINT, (size_t)256 * D * 2, (size_t)256 * D * 2, 0, 0, 4);
                if (G >= 256) { S.ubeg = ZFILL; S.uend = ZFILL + 128; }
                pg8::EpiP E{(bf16_t*)(ws + WS_P), (float*)(ws + WS_AB), 1.f};
                pg8::gemm_phase<pg8::EpiP, pg8::SchedPlain, false>(lds, D, D, D, S, E);
            }
            {
                const int lane = threadIdx.x & 63, wave = threadIdx.x >> 6; LAS float* scr = (LAS float*)(lds + wave * 16384);
                bf16_t* WguT = (bf16_t*)(ws + WS_R2); bf16_t* WdT = (bf16_t*)(ws + WS_R2 + 67108864);
                for (int cv = cg_ * NWAVES + wave; cv < 3 * 16384; cv += Gg * NWAVES) {
                    const int which = cv >> 14, r = cv & 16383, e = r >> 10, q = r & 1023;
                    if (which < 2) { const int kb = q >> 5, nb = q & 31, n0 = nb * 32; const size_t dr = (size_t)e * 2048 + (n0 >> 7) * 256 + (n0 & 127) + which * 128;
                        tr_item((which ? a.w_up : a.w_gate) + (size_t)e * D * DE, DE, kb * 64, n0, WguT, dr, D, 0, scr, lane, true); }
                    else { const int kb = q >> 6, nb = q & 63, n0 = nb * 32;
                        tr_item(a.w_down + (size_t)e * DE * D, D, kb * 64, n0, WdT, (size_t)e * 2048 + n0, DE, 0, scr, lane, true); } }
            }
        }
    } SEAM(3);
    if (IN(4)) for (int rep_ = 0; rep_ < REP(4); ++rep_) { if (rep_) cg::this_grid().sync(); phase_mergeprep(a); } SEAM(4);
    if (IN(5)) for (int rep_ = 0; rep_ < REP(5); ++rep_) { if (rep_) cg::this_grid().sync();
        pg8::SchedPlain S; S.init(MLAT, D, G, cidx, ws + WS_R1 + R1_YAB, ws + WS_WAB, (size_t)256 * D * 2, (size_t)256 * D * 2, 1, (size_t)1024 * 2);
        pg8::EpiMerge E{(const bf16_t*)(ws + WS_P), (bf16_t*)a.out};
        pg8::gemm_phase<pg8::EpiMerge, pg8::SchedPlain, true>(lds, 1024, D, D, S, E);
    } SEAM(5);
    if (IN(6)) for (int rep_ = 0; rep_ < REP(6); ++rep_) { if (rep_) cg::this_grid().sync();
        pg8::SchedPlain S; S.init(MLAT, D, G, cidx, (const void*)a.out, ws + WS_WOUT, (size_t)256 * D * 2, (size_t)256 * D * 2);
        pg8::EpiX1 E{a.x, (const modfx_t*)(ws + WS_MOD), a.ada_b, (bf16_t*)(ws + WS_P + P_X1)};
        pg8::gemm_phase<pg8::EpiX1, pg8::SchedPlain, false>(lds, D, D, D, S, E);
    } SEAM(6);
    if (IN(7)) for (int rep_ = 0; rep_ < REP(7); ++rep_) { if (rep_) cg::this_grid().sync(); phase_norm2(a, lds); } SEAM(7);
    if (IN(8)) for (int rep_ = 0; rep_ < REP(8); ++rep_) { if (rep_) cg::this_grid().sync(); phase_topk(a, lds); } SEAM(8);
    if (IN(9)) for (int rep_ = 0; rep_ < REP(9); ++rep_) { (void)rep_; }
    if (IN(10)) for (int rep_ = 0; rep_ < REP(10); ++rep_) { if (rep_) cg::this_grid().sync();
        pg8::SchedMoe S{G, cidx, (const char*)a.out, (const char*)(ws + WS_R2), (size_t)256 * D, (size_t)256 * D};
        pg8::EpiHact E{(unsigned char*)(ws + WS_P + P_HACT)};
        pg8::gemm_phase<pg8::EpiHact, pg8::SchedMoe, false, true>(lds, D / 2, D / 2, D / 2, S, E);
    } SEAM(10);
    if (IN(11)) for (int rep_ = 0; rep_ < REP(11); ++rep_) { if (rep_) cg::this_grid().sync();
        pg8::SchedMoe S{G, cidx, (const char*)(ws + WS_P + P_HACT), (const char*)(ws + WS_R2 + 67108864), (size_t)256 * DE, (size_t)256 * DE};
        pg8::EpiYE E{(const float*)(ws + WS_GATEV), (bf16_t*)(ws + WS_P + P_WGU)};
        pg8::gemm_phase<pg8::EpiYE, pg8::SchedMoe, false, true>(lds, DE / 2, DE / 2, DE / 2, S, E);
    } SEAM(11);
    if (IN(12)) for (int rep_ = 0; rep_ < REP(12); ++rep_) { if (rep_) cg::this_grid().sync(); phase_final(a); }
#undef IN
#undef SEAM
}

extern "C" void kernel_launch(void* const* d_in, const int* in_sizes, int n_in, void* d_out, int out_size, void* d_ws, size_t ws_size, hipStream_t stream) {
    static int grid = 0;
    if (grid == 0) {
        if (n_in != 23 || out_size != MLAT * D || ws_size < WS_END) { fprintf(stderr, "kernel_launch: unexpected shapes: n_in %d out %d ws %zu (need %zu)\n", n_in, out_size, ws_size, (size_t)WS_END); grid = -1; return; }
        int dev = 0, cus = 0, per_cu = 0;
        if (hipGetDevice(&dev) != hipSuccess || hipDeviceGetAttribute(&cus, hipDeviceAttributeMultiprocessorCount, dev) != hipSuccess) { grid = -1; return; }
        if (hipFuncSetAttribute((const void*)fwd, hipFuncAttributeMaxDynamicSharedMemorySize, LDS_BYTES) != hipSuccess) { fprintf(stderr, "kernel_launch: hipFuncSetAttribute failed\n"); grid = -1; return; }
        if (hipOccupancyMaxActiveBlocksPerMultiprocessor(&per_cu, (const void*)fwd, NTHR, LDS_BYTES) != hipSuccess || per_cu < 1) { fprintf(stderr, "kernel_launch: occupancy query says %d\n", per_cu); per_cu = 1; }
        (void)hipGetLastError();
        grid = cus;
    }
    if (grid < 0) return;
    Args a{};
    a.x = (const float*)d_in[0]; a.c = (const float*)d_in[1]; a.ctx = (const float*)d_in[2]; a.c_ctx = (const float*)d_in[3]; a.ada_w = (const float*)d_in[4]; a.ada_b = (const float*)d_in[5];
    a.norm_mix = (const float*)d_in[6]; a.norm_ffn = (const float*)d_in[7]; a.w_in = (const float*)d_in[8]; a.gdn_conv = (const float*)d_in[9]; a.a_log = (const float*)d_in[10]; a.dt_bias = (const float*)d_in[11];
    a.hgrn_lb = (const float*)d_in[12]; a.hgrn_norm = (const float*)d_in[13]; a.gdn_norm = (const float*)d_in[14]; a.w_ba = (const float*)d_in[15]; a.w_bb = (const float*)d_in[16]; a.w_out = (const float*)d_in[17];
    a.router_w = (const float*)d_in[18]; a.w_gate = (const float*)d_in[19]; a.w_up = (const float*)d_in[20]; a.w_down = (const float*)d_in[21]; a.final_norm = (const float*)d_in[22];
    a.out = (float*)d_out; a.ws = (unsigned char*)d_ws;
    (void)hipMemsetAsync((char*)d_ws + WS_BAR, 0, 16384 + 245760, stream);
#if ONE_LAUNCH
    a.ph_lo = 0; a.ph_hi = NPHASE;
    void* args[] = {&a};
    hipError_t e = hipLaunchCooperativeKernel((const void*)fwd, dim3(grid), dim3(NTHR), args, LDS_BYTES, stream);
    if (e != hipSuccess) fprintf(stderr, "kernel_launch: cooperative launch failed: %s (grid %d)\n", hipGetErrorString(e), grid);
#else
    for (int p = 0; p < NPHASE; ++p) { a.ph_lo = p; a.ph_hi = p + 1; hipLaunchKernelGGL(fwd, dim3(grid), dim3(NTHR), LDS_BYTES, stream, a); }
#endif
}
```

```cpp
#include <hip/hip_runtime.h>
#include <hip/hip_cooperative_groups.h>
#include <cstdio>
#include <cstdint>
namespace cg = cooperative_groups;

#ifndef ONE_LAUNCH
#define ONE_LAUNCH 1
#endif

#define LAS __attribute__((address_space(3)))
typedef unsigned short bf16_t;
typedef short bf16x8 __attribute__((ext_vector_type(8)));
typedef float f32x4 __attribute__((ext_vector_type(4)));
typedef float f32x2 __attribute__((ext_vector_type(2)));
typedef unsigned u32x4 __attribute__((ext_vector_type(4)));
typedef unsigned u32x2 __attribute__((ext_vector_type(2)));

constexpr int D = 2048, NB = 4, SEQ = 4096, CTXL = 256;
constexpr int MLAT = NB * SEQ, MCTX = NB * CTXL, MTOT = MLAT + MCTX;
constexpr int NIN = 13344, NPW = 13568, PC = 13312;
constexpr int C_HQ = 0, C_FF = 1024, C_FB = 2048, C_HI = 3072, C_OG = 4096, C_GQ = 5120, C_GK = 6144, C_GV = 7168, C_Z = 8192, C_GA = 9216, C_GB = 11264;
constexpr int NE = 16, CAP = 512, DE = 1024;
constexpr float EPS = 1e-6f;
constexpr int NTHR = 512, NWAVES = 8;
constexpr int LDS_BYTES = 147456;

constexpr size_t WS_BAR = 0;
constexpr size_t WS_MOD = 16384;
constexpr size_t WS_AFF = WS_MOD + 245760;
constexpr size_t WS_IDX = WS_AFF + 1048576;
constexpr size_t WS_GATEV = WS_IDX + 131072;
constexpr size_t WS_INV = WS_GATEV + 131072;
constexpr size_t WS_AB = WS_INV + 1048576;
constexpr size_t WS_WAB = WS_AB + 2228224;
constexpr size_t WS_WOUT = WS_WAB + 8388608;
constexpr size_t WS_R1 = WS_WOUT + 8388608;
constexpr size_t WS_R2 = WS_R1 + 126877696;
constexpr size_t WS_P = WS_R2 + 134217728;
constexpr size_t WS_HALO = WS_P + 463470592;
constexpr size_t WS_WIN8 = WS_HALO + 6684672;
constexpr size_t WS_END = WS_WIN8 + 10485760;
constexpr size_t R2_H8 = 100663296;
constexpr size_t R1_WINT = 0, R1_H = 55574528, R1_YAB = 0, R1_H2 = 0;
constexpr size_t R2_OAF = 0, R2_OAB = 33554432, R2_OBF = 67108864, R2_OBB = 100663296, R2_T = 0, R2_XS = 0, R2_YE = 0;
constexpr size_t P_X1 = 0, P_WGU = 134217728, P_WD = 268435456, P_HACT = 335544320;

struct Args {
    const float *x, *c, *ctx, *c_ctx, *ada_w, *ada_b, *norm_mix, *norm_ffn, *w_in, *gdn_conv, *a_log, *dt_bias, *hgrn_lb, *hgrn_norm, *gdn_norm,
        *w_ba, *w_bb, *w_out, *router_w, *w_gate, *w_up, *w_down, *final_norm;
    float* out; unsigned char* ws; int ph_lo, ph_hi;
};

__device__ __forceinline__ float bf2f(unsigned short b) { return __uint_as_float(((unsigned)b) << 16); }
__device__ __forceinline__ float bflo(unsigned w) { return __uint_as_float(w << 16); }
__device__ __forceinline__ float bfhi(unsigned w) { return __uint_as_float(w & 0xffff0000u); }
typedef __bf16 bf16x2v __attribute__((ext_vector_type(2)));
__device__ __forceinline__ unsigned pk2(float lo, float hi) { const f32x2 v = {lo, hi}; const bf16x2v b = __builtin_convertvector(v, bf16x2v); return __builtin_bit_cast(unsigned, b); }
__device__ __forceinline__ unsigned f2bf(float f) { return pk2(f, f) & 0xffffu; }
__device__ __forceinline__ float rcp_f(float x) { return __builtin_amdgcn_rcpf(x); }
__device__ __forceinline__ float sigmoid_f(float x) { return __builtin_amdgcn_rcpf(1.f + __builtin_amdgcn_exp2f(-1.4426950408889634f * x)); }
__device__ __forceinline__ float silu_f(float x) { return x * sigmoid_f(x); }
__device__ __forceinline__ float softplus_f(float x) { return x > 20.f ? x : log1pf(__expf(x)); }
__device__ __forceinline__ float wave_sum(float v) {
#pragma unroll
    for (int o = 1; o < 64; o <<= 1) v += __shfl_xor(v, o);
    return v;
}
#define LDS_WAIT() asm volatile("s_waitcnt lgkmcnt(0)" ::: "memory")
typedef int modfx_t;
typedef int v4i_ __attribute__((ext_vector_type(4)));
__device__ __forceinline__ f32x4 mod4(const modfx_t* M, size_t idx) {
    const v4i_ q = *(const v4i_*)(M + idx); const float sc = 3.725290298461914e-09f;
    return (f32x4){(float)q.x * sc, (float)q.y * sc, (float)q.z * sc, (float)q.w * sc}; }
typedef int v8i __attribute__((ext_vector_type(8)));
typedef int v4i __attribute__((ext_vector_type(4)));
__device__ __forceinline__ unsigned pk4_fp8(float a, float b, float c, float d) { unsigned w = 0u; w = (unsigned)__builtin_amdgcn_cvt_pk_fp8_f32(a, b, (int)w, false); w = (unsigned)__builtin_amdgcn_cvt_pk_fp8_f32(c, d, (int)w, true); return w; }
constexpr float W8_SCALE = 64.f;

namespace pg8 {
constexpr int BM = 256, BK = 64, HALF = 128, HTB = HALF * BK * 2, STAGE_BYTES = 8 * HTB, NXCD = 8, WGM = 8;
__device__ __forceinline__ int lds_byte(int r, int c) { const int st = (r >> 4) * 2 + (c >> 5), rr = r & 15, cc = c & 31, ob = rr * 64 + cc * 2; return st * 1024 + (ob ^ (((ob >> 9) & 1) << 5)); }
__device__ __forceinline__ void stage_rc(int b, int& R, int& C) { const int st = b / 1024, sb = b % 1024, swz = sb ^ (((sb >> 9) & 1) << 5); R = (st >> 1) * 16 + swz / 64; C = (st & 1) * 32 + (swz % 64) / 2; }
__device__ __forceinline__ int perm32(int rho) { const int n = rho >> 4, i = rho & 15; return 8 * (i >> 2) + 4 * n + (i & 3); }
struct Unit { int pm, pn; const char* A; const char* B; int half; };
__device__ __forceinline__ unsigned cvt_pk_bf16(float lo, float hi) { unsigned r; asm volatile("v_cvt_pk_bf16_f32 %0, %1, %2" : "=v"(r) : "v"(lo), "v"(hi)); return r; }

struct SchedPlain {
    int nM, nN, nwg, G, c; const char* A; const char* B; size_t tA, tB; int pair; size_t hoff; int remap; int ubeg, uend;
    __device__ __forceinline__ void init(int M, int N, int G_, int c_, const void* A_, const void* B_, size_t tA_, size_t tB_, int pair_ = 0, size_t hoff_ = 0, int remap_ = 0) { nM = M / BM; nN = N / BM; nwg = nM * nN; G = G_; c = c_; A = (const char*)A_; B = (const char*)B_; tA = tA_; tB = tB_; pair = pair_; hoff = hoff_; remap = remap_; ubeg = 0; uend = nwg; }
    __device__ __forceinline__ bool next(int i, Unit& u) const {
        const int hf = pair ? (i & 1) : 1; if (pair) i >>= 1;
        const long L = (long)ubeg + (long)i * G + c; if (L >= uend) return false;
        int wgid = (int)L; { const int q = nwg / NXCD, r = nwg % NXCD, xcd = wgid % NXCD, off = wgid / NXCD; wgid = (xcd < r ? xcd * (q + 1) : r * (q + 1) + (xcd - r) * q) + off; }
        const int nig = WGM * nN, gid = wgid / nig, fm = gid * WGM, gsz = (nM - fm) < WGM ? (nM - fm) : WGM;
        u.pm = fm + ((wgid % nig) % gsz); u.pn = (wgid % nig) / gsz; u.half = hf;
        const int pnd = u.pn;
        if (remap == 1) u.pn = (u.pn < 16) ? u.pn : (u.pn < 28 ? u.pn + 4 : 52);
        else if (remap == 2) u.pn = (u.pn < 4) ? 16 + u.pn : 28 + u.pn;
        else if (remap == 3) u.pn = (u.pn < 4) ? 16 + u.pn : 32 + u.pn;
        else if (remap == 4) u.pn = 32 + u.pn;
        const size_t ho = (pair && hf) ? hoff : 0; u.A = A + (size_t)u.pm * tA + ho; u.B = B + (size_t)(remap == 3 ? pnd : u.pn) * tB + ho; return true;
    }
};
struct SchedTwo {
    SchedPlain a, b; int na, nextra, G, c;
    __device__ __forceinline__ bool next(int i, Unit& u) const {
        const long L = (long)i * G + c;
        if (L < na) { SchedPlain t = a; t.G = 1; t.c = 0; t.ubeg = (int)L; t.uend = (int)L + 1; return t.next(0, u); }
        if (L < na + nextra) { SchedPlain t = b; t.G = 1; t.c = 0; t.ubeg = (int)(L - na); t.uend = t.ubeg + 1; return t.next(0, u); }
        return false;
    }
};
struct SchedMoe {
    int G, c; const char* A; const char* B; size_t tA, tB;
    __device__ __forceinline__ bool next(int i, Unit& u) const {
        const long L = (long)i * G + c; if (L >= 1024) return false;
        const int e = (int)L >> 6, r = (int)L & 63, pn = r >> 3, q = r & 7, b = q >> 1, hf = q & 1;
        u.pm = (b * 16 + e) * 2 + hf; u.pn = pn; u.half = 1; u.A = A + (size_t)u.pm * tA; u.B = B + (size_t)(e * 8 + pn) * tB; return true;
    }
};

template <class Epi, class Sched, bool MID, bool F8 = false>
__device__ __forceinline__ void gemm_phase(LAS unsigned char* lds, const int K, const int lda, const int ldb, const Sched& S, const Epi& E) {
    int tid = threadIdx.x; asm volatile("" : "+v"(tid));
    const int wid = __builtin_amdgcn_readfirstlane(tid >> 6), lane = tid & 63, wr = wid >> 2, wc = wid & 3, fr = lane & 15, fq = lane >> 4;
    const int nt = K / BK;
    unsigned voffA[2], voffB[2];
#pragma unroll
    for (int i = 0; i < 2; ++i) { int R, C; stage_rc(tid * 16 + i * 8192, R, C); const int Rb = Epi::PERM ? ((R & ~31) + perm32(R & 31)) : R;
        voffA[i] = (unsigned)(R * lda + C) * 2u; voffB[i] = (unsigned)(Rb * ldb + C) * 2u; }
    const size_t kstep = (size_t)(BK * 2);
    const size_t hstepA = (size_t)HALF * lda * 2, hstepB = (size_t)HALF * ldb * 2;
    const unsigned ldsw = (unsigned)wid * 1024u;
    const int aoff = F8 ? lds_byte(wr * 64 + fr, 32 * (fq >> 1) + 16 * (fq & 1)) : lds_byte(wr * 64 + fr, fq * 8), boff = F8 ? lds_byte(wc * 32 + fr, 32 * (fq >> 1) + 16 * (fq & 1)) : lds_byte(wc * 32 + fr, fq * 8);
#define PG8_SA(b, h) (((b) * 2 + (h)) * HTB)
#define PG8_SB(b, h) ((4 + (b) * 2 + (h)) * HTB)
#define PG8_STAGE(bufoff, gbase, voff) do { _Pragma("unroll") for (int _i = 0; _i < 2; ++_i) \
        __builtin_amdgcn_global_load_lds((const unsigned*)((const char*)(gbase) + (voff)[_i]), (LAS unsigned*)(lds + (bufoff) + ldsw + _i * 8192), 16, 0, 0); } while (0)
#define PG8_LDA(dst, b, h) do { if constexpr (F8) { _Pragma("unroll") for (int m = 0; m < 4; ++m) { const v4i lo_ = *(const LAS v4i*)(lds + PG8_SA(b, h) + aoff + m * 2048), hi_ = *(const LAS v4i*)(lds + PG8_SA(b, h) + aoff + m * 2048 + 16); \
            dst##8[m] = __builtin_shufflevector(lo_, hi_, 0, 1, 2, 3, 4, 5, 6, 7); } } \
        else { _Pragma("unroll") for (int m = 0; m < 4; ++m) _Pragma("unroll") for (int k = 0; k < 2; ++k) dst[m][k] = *(const LAS bf16x8*)(lds + PG8_SA(b, h) + aoff + m * 2048 + k * 1024); } } while (0)
#define PG8_LDB(dst, b, h) do { if constexpr (F8) { _Pragma("unroll") for (int n = 0; n < 2; ++n) { const v4i lo_ = *(const LAS v4i*)(lds + PG8_SB(b, h) + boff + n * 2048), hi_ = *(const LAS v4i*)(lds + PG8_SB(b, h) + boff + n * 2048 + 16); \
            dst##8[n] = __builtin_shufflevector(lo_, hi_, 0, 1, 2, 3, 4, 5, 6, 7); } } \
        else { _Pragma("unroll") for (int n = 0; n < 2; ++n) _Pragma("unroll") for (int k = 0; k < 2; ++k) dst[n][k] = *(const LAS bf16x8*)(lds + PG8_SB(b, h) + boff + n * 2048 + k * 1024); } } while (0)
#define PG8_MMA(ai, bj, At, Bt) do { __builtin_amdgcn_s_setprio(1); if constexpr (F8) { _Pragma("unroll") for (int m = 0; m < 4; ++m) _Pragma("unroll") for (int n = 0; n < 2; ++n) \
        asm volatile("v_mfma_scale_f32_16x16x128_f8f6f4 %0, %1, %2, %0, %3, %3 op_sel_hi:[0,0,0]" : "+v"(acc[ai][bj][m][n]) : "v"(Bt##8[n]), "v"(At##8[m]), "v"(sc8)); } \
        else { _Pragma("unroll") for (int m = 0; m < 4; ++m) _Pragma("unroll") for (int n = 0; n < 2; ++n) _Pragma("unroll") for (int k = 0; k < 2; ++k) \
        acc[ai][bj][m][n] = __builtin_amdgcn_mfma_f32_16x16x32_bf16(Bt[n][k], At[m][k], acc[ai][bj][m][n], 0, 0, 0); } __builtin_amdgcn_s_setprio(0); } while (0)
#define PG8_WAIT_V(n) asm volatile("s_waitcnt vmcnt(" #n ")" ::: "memory")
#define PG8_WAIT_L(n) asm volatile("s_waitcnt lgkmcnt(" #n ")" ::: "memory")
#define PG8_BAR __builtin_amdgcn_s_barrier()
#define PG8_SCHED __builtin_amdgcn_sched_barrier(0)
    Unit cur, nxt; int ui = 0;
    if (!S.next(0, cur)) return;
    f32x4 acc[2][2][4][2];
#pragma unroll
    for (int a = 0; a < 2; ++a)
#pragma unroll
        for (int b = 0; b < 2; ++b)
#pragma unroll
            for (int m = 0; m < 4; ++m)
#pragma unroll
                for (int n = 0; n < 2; ++n) acc[a][b][m][n] = (f32x4){0.f, 0.f, 0.f, 0.f};
    bf16x8 At[4][2], B0[2][2], B1[2][2]; v8i At8[4], B08[2], B18[2]; const int sc8 = 0x7F7F7F7F;
    const char* cA = cur.A; const char* cB = cur.B;
    PG8_STAGE(PG8_SB(0, 0), cB, voffB); PG8_STAGE(PG8_SB(0, 1), cB + hstepB, voffB); PG8_STAGE(PG8_SA(0, 0), cA, voffA); PG8_STAGE(PG8_SA(0, 1), cA + hstepA, voffA);
    if (wr == 1) PG8_BAR;
    PG8_WAIT_V(2); PG8_BAR;
    PG8_STAGE(PG8_SB(1, 0), cB + kstep, voffB); PG8_STAGE(PG8_SA(1, 0), cA + kstep, voffA); PG8_STAGE(PG8_SB(1, 1), cB + hstepB + kstep, voffB);
    PG8_WAIT_V(6); PG8_BAR;
    for (;;) {
        const bool has_next = S.next(ui + 1, nxt);
        const char* nA = has_next ? nxt.A : cA; const char* nB = has_next ? nxt.B : cB;
#pragma unroll 1
        for (int t = 0; t < nt; t += 2) {
            const bool last = (t == nt - 2);
            const char* a1 = cA + (size_t)(t + 1) * kstep;
            const char* a2 = last ? nA : cA + (size_t)(t + 2) * kstep; const char* b2 = last ? nB : cB + (size_t)(t + 2) * kstep;
            const char* a3 = a2 + kstep; const char* b3 = b2 + kstep;
            PG8_LDB(B0, 0, 0); PG8_LDB(B1, 0, 1); PG8_SCHED; PG8_LDA(At, 0, 0); PG8_STAGE(PG8_SA(1, 1), a1 + hstepA, voffA);
            PG8_WAIT_V(8); PG8_WAIT_L(0); PG8_BAR; PG8_MMA(0, 0, At, B0); PG8_MMA(0, 1, At, B1); PG8_BAR; PG8_SCHED;
            PG8_LDA(At, 0, 1); PG8_STAGE(PG8_SB(0, 0), b2, voffB); PG8_STAGE(PG8_SB(0, 1), b2 + hstepB, voffB); PG8_STAGE(PG8_SA(0, 0), a2, voffA);
            PG8_WAIT_V(8); PG8_WAIT_L(0); PG8_BAR; PG8_MMA(1, 0, At, B0); PG8_MMA(1, 1, At, B1); PG8_BAR; PG8_SCHED;
            PG8_LDB(B0, 1, 0); PG8_LDB(B1, 1, 1); PG8_SCHED; PG8_LDA(At, 1, 0); PG8_STAGE(PG8_SA(0, 1), a2 + hstepA, voffA);
            PG8_WAIT_V(8); PG8_WAIT_L(0); PG8_BAR; PG8_MMA(0, 0, At, B0); PG8_MMA(0, 1, At, B1); PG8_BAR; PG8_SCHED;
            PG8_LDA(At, 1, 1); PG8_STAGE(PG8_SB(1, 0), b3, voffB); PG8_STAGE(PG8_SB(1, 1), b3 + hstepB, voffB); PG8_STAGE(PG8_SA(1, 0), a3, voffA);
            PG8_WAIT_V(8); PG8_WAIT_L(0); PG8_BAR; PG8_MMA(1, 0, At, B0); PG8_MMA(1, 1, At, B1); PG8_BAR; PG8_SCHED;
        }
        if (wr == 0) PG8_BAR;
        if constexpr (F8) asm volatile("s_nop 15\n\ts_nop 15" ::: "memory");
        bool fin = true;
        int fr_e = fr, fq_e = fq; asm volatile("" : "+v"(fr_e), "+v"(fq_e));
        if constexpr (MID) { fin = (cur.half != 0); if (!fin) E.mid(acc, cur, wr, wc, fr_e, fq_e); }
        if (fin) E(acc, cur, wr, wc, fr_e, fq_e);
        if (!has_next) break;
        if (fin) {
#pragma unroll
        for (int a = 0; a < 2; ++a)
#pragma unroll
            for (int b = 0; b < 2; ++b)
#pragma unroll
                for (int m = 0; m < 4; ++m)
#pragma unroll
                    for (int n = 0; n < 2; ++n) acc[a][b][m][n] = (f32x4){0.f, 0.f, 0.f, 0.f};
        }
        cur = nxt; cA = nA; cB = nB; ++ui;
        if (wr == 1) PG8_BAR;
    }
    PG8_WAIT_V(0);
    PG8_BAR;
#undef PG8_SA
#undef PG8_SB
#undef PG8_STAGE
#undef PG8_LDA
#undef PG8_LDB
#undef PG8_MMA
#undef PG8_WAIT_V
#undef PG8_WAIT_L
#undef PG8_BAR
#undef PG8_SCHED
}

struct EpiP {
    static constexpr bool PERM = true;
    bf16_t* P; float* AB; float osc;
    __device__ __forceinline__ void operator()(const f32x4 (&acc)[2][2][4][2], const Unit& u, int wr, int wc, int fr, int fq) const {
        const int row0 = u.pm * BM + wr * 64 + fr;
        if (u.pn < 52) {
            const int col0 = u.pn * BM + wc * 32 + 8 * fq;
#pragma unroll
            for (int ai = 0; ai < 2; ++ai)
#pragma unroll
                for (int m = 0; m < 4; ++m) { bf16_t* rowp = P + (size_t)(row0 + ai * HALF + m * 16) * PC + col0;
#pragma unroll
                    for (int bj = 0; bj < 2; ++bj) { const f32x4 v0 = acc[ai][bj][m][0] * osc, v1 = acc[ai][bj][m][1] * osc;
                        u32x4 w; w.x = cvt_pk_bf16(v0[0], v0[1]); w.y = cvt_pk_bf16(v0[2], v0[3]); w.z = cvt_pk_bf16(v1[0], v1[1]); w.w = cvt_pk_bf16(v1[2], v1[3]);
                        *(u32x4*)(rowp + bj * HALF) = w; } }
        } else if (wc == 0) {
#pragma unroll
            for (int ai = 0; ai < 2; ++ai)
#pragma unroll
                for (int m = 0; m < 4; ++m) { float* rp = AB + (size_t)(row0 + ai * HALF + m * 16) * 32 + 8 * fq;
                    *(f32x4*)rp = acc[ai][0][m][0]; *(f32x4*)(rp + 4) = acc[ai][0][m][1]; }
        }
    }
};
struct EpiMerge {
    static constexpr bool PERM = true;
    const bf16_t* P; bf16_t* T;
    __device__ __forceinline__ void mid(f32x4 (&acc)[2][2][4][2], const Unit& u, int wr, int wc, int fr, int fq) const {
        const bf16_t* base = P + (size_t)(u.pm * BM + wr * 64 + fr) * PC + (u.pn * BM + wc * 32 + 8 * fq);
#pragma unroll
        for (int ai = 0; ai < 2; ++ai) {
            u32x4 xa[4][2], xb[4][2];
#pragma unroll
            for (int m = 0; m < 4; ++m)
#pragma unroll
                for (int bj = 0; bj < 2; ++bj) { const bf16_t* rowp = base + (size_t)(ai * HALF + m * 16) * PC + bj * HALF; xa[m][bj] = *(const u32x4*)(rowp + C_GA); xb[m][bj] = *(const u32x4*)(rowp + C_GB); }
#pragma unroll
            for (int m = 0; m < 4; ++m)
#pragma unroll
                for (int bj = 0; bj < 2; ++bj) {
                    const unsigned wa[4] = {xa[m][bj].x, xa[m][bj].y, xa[m][bj].z, xa[m][bj].w}, wb[4] = {xb[m][bj].x, xb[m][bj].y, xb[m][bj].z, xb[m][bj].w};
#pragma unroll
                    for (int j = 0; j < 4; ++j) {
                        const float r0 = (1.f + __expf(-bflo(wb[j]))) * __builtin_amdgcn_rcpf(1.f + __expf(-bflo(wa[j]))), r1 = (1.f + __expf(-bfhi(wb[j]))) * __builtin_amdgcn_rcpf(1.f + __expf(-bfhi(wa[j])));
                        acc[ai][bj][m][j >> 1][(j & 1) * 2] *= r0; acc[ai][bj][m][j >> 1][(j & 1) * 2 + 1] *= r1; } }
            asm volatile("" ::: "memory"); }
    }
    __device__ __forceinline__ void operator()(const f32x4 (&acc)[2][2][4][2], const Unit& u, int wr, int wc, int fr, int fq) const {
        const int row0 = u.pm * BM + wr * 64 + fr, col0 = u.pn * BM + wc * 32 + 8 * fq;
#pragma unroll
        for (int ai = 0; ai < 2; ++ai) {
            u32x4 xb[4][2];
#pragma unroll
            for (int m = 0; m < 4; ++m)
#pragma unroll
                for (int bj = 0; bj < 2; ++bj) xb[m][bj] = *(const u32x4*)(P + (size_t)(row0 + ai * HALF + m * 16) * PC + col0 + C_GB + bj * HALF);
#pragma unroll
            for (int m = 0; m < 4; ++m) { const size_t row = (size_t)(row0 + ai * HALF + m * 16);
#pragma unroll
                for (int bj = 0; bj < 2; ++bj) {
                    const unsigned wb[4] = {xb[m][bj].x, xb[m][bj].y, xb[m][bj].z, xb[m][bj].w}; float g[8];
#pragma unroll
                    for (int j = 0; j < 4; ++j) { g[2 * j] = sigmoid_f(bflo(wb[j])); g[2 * j + 1] = sigmoid_f(bfhi(wb[j])); }
                    const f32x4 v0 = acc[ai][bj][m][0], v1 = acc[ai][bj][m][1];
                    u32x4 w; w.x = cvt_pk_bf16(v0[0] * g[0], v0[1] * g[1]); w.y = cvt_pk_bf16(v0[2] * g[2], v0[3] * g[3]); w.z = cvt_pk_bf16(v1[0] * g[4], v1[1] * g[5]); w.w = cvt_pk_bf16(v1[2] * g[6], v1[3] * g[7]);
                    *(u32x4*)(T + row * D + col0 + bj * HALF) = w; } }
            asm volatile("" ::: "memory"); }
    }
};
struct EpiX1 {
    static constexpr bool PERM = false;
    const float* x; const modfx_t* mod; const float* ada_b; bf16_t* X1;
    __device__ __forceinline__ void operator()(const f32x4 (&acc)[2][2][4][2], const Unit& u, int wr, int wc, int fr, int fq) const {
        const int row0 = u.pm * BM + wr * 64 + fr, col0 = u.pn * BM + wc * 32 + 4 * fq, b = u.pm >> 4;
        f32x4 mv[2][2];
#pragma unroll
        for (int bj = 0; bj < 2; ++bj)
#pragma unroll
            for (int n = 0; n < 2; ++n) { const int c = col0 + bj * HALF + n * 16; mv[bj][n] = mod4(mod, (size_t)b * 12288 + 2 * D + c) + *(const f32x4*)(ada_b + 2 * D + c); }
#pragma unroll
        for (int ai = 0; ai < 2; ++ai) {
            f32x4 xi[4][2][2];
#pragma unroll
            for (int m = 0; m < 4; ++m)
#pragma unroll
                for (int bj = 0; bj < 2; ++bj)
#pragma unroll
                    for (int n = 0; n < 2; ++n) xi[m][bj][n] = *(const f32x4*)(x + (size_t)(row0 + ai * HALF + m * 16) * D + col0 + bj * HALF + n * 16);
#pragma unroll
            for (int m = 0; m < 4; ++m) { const size_t off = (size_t)(row0 + ai * HALF + m * 16) * D + col0;
#pragma unroll
                for (int bj = 0; bj < 2; ++bj)
#pragma unroll
                    for (int n = 0; n < 2; ++n) { const f32x4 o = xi[m][bj][n] + mv[bj][n] * acc[ai][bj][m][n];
                        *(u32x2*)(X1 + off + bj * HALF + n * 16) = (u32x2){cvt_pk_bf16(o[0], o[1]), cvt_pk_bf16(o[2], o[3])}; } }
            asm volatile("" ::: "memory"); }
    }
};
struct EpiHact {
    static constexpr bool PERM = true;
    unsigned char* H;
    __device__ __forceinline__ void operator()(const f32x4 (&acc)[2][2][4][2], const Unit& u, int wr, int wc, int fr, int fq) const {
        const int row0 = u.pm * BM + wr * 64 + fr, col0 = u.pn * HALF + wc * 32 + 8 * fq;
#pragma unroll
        for (int ai = 0; ai < 2; ++ai)
#pragma unroll
            for (int m = 0; m < 4; ++m) { const f32x4 a0 = acc[ai][0][m][0] * (1.f / W8_SCALE), a1 = acc[ai][0][m][1] * (1.f / W8_SCALE), u0 = acc[ai][1][m][0] * (1.f / W8_SCALE), u1 = acc[ai][1][m][1] * (1.f / W8_SCALE);
                u32x2 w; w.x = pk4_fp8(silu_f(a0[0]) * u0[0], silu_f(a0[1]) * u0[1], silu_f(a0[2]) * u0[2], silu_f(a0[3]) * u0[3]);
                w.y = pk4_fp8(silu_f(a1[0]) * u1[0], silu_f(a1[1]) * u1[1], silu_f(a1[2]) * u1[2], silu_f(a1[3]) * u1[3]);
                *(u32x2*)(H + (size_t)(row0 + ai * HALF + m * 16) * DE + col0) = w; }
    }
};
struct EpiYE {
    static constexpr bool PERM = true;
    const float* gatev; bf16_t* Y;
    __device__ __forceinline__ void operator()(const f32x4 (&acc)[2][2][4][2], const Unit& u, int wr, int wc, int fr, int fq) const {
        const int row0 = u.pm * BM + wr * 64 + fr, col0 = u.pn * BM + wc * 32 + 8 * fq;
        float g[2][4];
#pragma unroll
        for (int ai = 0; ai < 2; ++ai)
#pragma unroll
            for (int m = 0; m < 4; ++m) g[ai][m] = gatev[row0 + ai * HALF + m * 16] * (1.f / W8_SCALE);
#pragma unroll
        for (int ai = 0; ai < 2; ++ai)
#pragma unroll
            for (int m = 0; m < 4; ++m) { const int row = row0 + ai * HALF + m * 16;
#pragma unroll
                for (int bj = 0; bj < 2; ++bj) { const f32x4 v0 = acc[ai][bj][m][0] * g[ai][m], v1 = acc[ai][bj][m][1] * g[ai][m];
                    u32x4 w; w.x = cvt_pk_bf16(v0[0], v0[1]); w.y = cvt_pk_bf16(v0[2], v0[3]); w.z = cvt_pk_bf16(v1[0], v1[1]); w.w = cvt_pk_bf16(v1[2], v1[3]);
                    *(u32x4*)(Y + (size_t)row * D + col0 + bj * HALF) = w; } }
    }
};
}

__device__ __forceinline__ void tr_item(const float* W, int ldw, int k0, int n0, bf16_t* WT, size_t dst_row, int ldk, int koff, LAS float* scr, int lane, const bool f8 = false) {
    f32x4 v[8];
#pragma unroll
    for (int i = 0; i < 8; ++i) v[i] = *(const f32x4*)(W + (size_t)(k0 + 8 * i + (lane >> 3)) * ldw + n0 + (lane & 7) * 4);
#pragma unroll
    for (int i = 0; i < 8; ++i) { LAS float* p = scr + (8 * i + (lane >> 3)) * 33 + (lane & 7) * 4; p[0] = v[i].x; p[1] = v[i].y; p[2] = v[i].z; p[3] = v[i].w; }
    LDS_WAIT(); asm volatile("" ::: "memory");
    const int c = lane & 7;
    if (!f8) {
#pragma unroll
    for (int j = 0; j < 4; ++j) { const int n = (lane >> 3) + 8 * j; const LAS float* s = scr + (8 * c) * 33 + n;
        u32x4 o; o.x = pk2(s[0 * 33], s[1 * 33]); o.y = pk2(s[2 * 33], s[3 * 33]); o.z = pk2(s[4 * 33], s[5 * 33]); o.w = pk2(s[6 * 33], s[7 * 33]);
        *(u32x4*)(WT + (dst_row + n) * (size_t)ldk + koff + k0 + 8 * c) = o; }
    } else {
#pragma unroll
    for (int j = 0; j < 4; ++j) { const int n = (lane >> 3) + 8 * j; const LAS float* s = scr + (8 * c) * 33 + n;
        u32x2 o; o.x = pk4_fp8(s[0 * 33] * W8_SCALE, s[1 * 33] * W8_SCALE, s[2 * 33] * W8_SCALE, s[3 * 33] * W8_SCALE); o.y = pk4_fp8(s[4 * 33] * W8_SCALE, s[5 * 33] * W8_SCALE, s[6 * 33] * W8_SCALE, s[7 * 33] * W8_SCALE);
        *(u32x2*)((unsigned char*)WT + (dst_row + n) * (size_t)ldk + koff + k0 + 8 * c) = o; }
    }
    LDS_WAIT(); asm volatile("" ::: "memory");
}

__device__ __forceinline__ void phase_prep(const Args& a, LAS unsigned char* lds) {
    const int tid = threadIdx.x, lane = tid & 63, wave = tid >> 6, G = gridDim.x;
    int* MOD = (int*)(a.ws + WS_MOD);
    LAS float* sc = (LAS float*)lds;
    for (int it = blockIdx.x; it < 256; it += G) {
        const int ks = it >> 3, cb = it & 7, k0 = ks * 64;
        __syncthreads();
        if (tid < 320) { const int v = tid >> 6, r = tid & 63; const float cv = (v < 4) ? a.c[v * D + k0 + r] : a.c_ctx[k0 + r]; sc[v * 64 + r] = silu_f(cv); }
        __syncthreads();
        float acc[5][3];
#pragma unroll
        for (int v = 0; v < 5; ++v)
#pragma unroll
            for (int i = 0; i < 3; ++i) acc[v][i] = 0.f;
        const float* wp = a.ada_w + (size_t)k0 * 12288 + cb * 1536 + tid;
#pragma unroll 8
        for (int r = 0; r < 64; ++r) {
            const float w0 = wp[(size_t)r * 12288], w1 = wp[(size_t)r * 12288 + 512], w2 = wp[(size_t)r * 12288 + 1024];
#pragma unroll
            for (int v = 0; v < 5; ++v) { const float s = sc[v * 64 + r]; acc[v][0] += s * w0; acc[v][1] += s * w1; acc[v][2] += s * w2; }
        }
#pragma unroll
        for (int v = 0; v < 5; ++v)
#pragma unroll
            for (int i = 0; i < 3; ++i) atomicAdd(MOD + v * 12288 + cb * 1536 + tid + 512 * i, __float2int_rn(acc[v][i] * 268435456.f));
    }
    __syncthreads();
    LAS float* scr = (LAS float*)(lds + wave * 16384);
    const int gw = blockIdx.x * NWAVES + wave, NGW = G * NWAVES;
    bf16_t* WinT = (bf16_t*)(a.ws + WS_R1 + R1_WINT); bf16_t* WabT = (bf16_t*)(a.ws + WS_WAB); bf16_t* WoutT = (bf16_t*)(a.ws + WS_WOUT);
    constexpr int I_IN = 32 * 417, I_BA = 16 * 64, I_OUT = 32 * 64;
    for (int it = gw; it < I_IN + 2 * I_BA + I_OUT; it += NGW) {
        int r = it;
        if (r < I_IN) { const int kb = r / 417, nb = r % 417, n0 = nb * 32; const size_t dr = (n0 < 9216) ? n0 : (n0 == 9216 ? 13312 : n0 - 32);
            if (dr >= 4096 && dr < 5120) tr_item(a.w_in, NIN, kb * 64, n0, (bf16_t*)(a.ws + WS_WIN8), dr - 4096, D, 0, scr, lane, true);
            else if (dr >= 9216 && dr < 13312) tr_item(a.w_in, NIN, kb * 64, n0, (bf16_t*)(a.ws + WS_WIN8), 1024 + (dr - 9216), D, 0, scr, lane, true);
            else tr_item(a.w_in, NIN, kb * 64, n0, WinT, dr, D, 0, scr, lane);
            continue; }
        r -= I_IN;
        if (r < I_BA) { tr_item(a.w_ba, D, (r >> 6) * 64, (r & 63) * 32, WabT, (r & 63) * 32, D, 0, scr, lane); continue; }
        r -= I_BA;
        if (r < I_BA) { tr_item(a.w_bb, D, (r >> 6) * 64, (r & 63) * 32, WabT, (r & 63) * 32, D, 1024, scr, lane); continue; }
        r -= I_BA;
        tr_item(a.w_out, D, (r >> 6) * 64, (r & 63) * 32, WoutT, (r & 63) * 32, D, 0, scr, lane);
    }
    { u32x4* z = (u32x4*)(WinT + (size_t)13344 * D); const int n16 = 224 * D * 2 / 16;
      for (int i = blockIdx.x * NTHR + tid; i < n16; i += G * NTHR) z[i] = (u32x4){0u, 0u, 0u, 0u}; }
}

__device__ __forceinline__ void phase_norm1(const Args& a) {
    const int tid = threadIdx.x, lane = tid & 63, wave = tid >> 6, G = gridDim.x;
    const modfx_t* MOD = (const modfx_t*)(a.ws + WS_MOD); bf16_t* H = (bf16_t*)(a.ws + WS_R1 + R1_H);
    f32x4 v[8], vn[8];
    { const int r0 = blockIdx.x * NWAVES + wave; if (r0 < MTOT) { const float* src = (r0 < MLAT) ? a.x + (size_t)r0 * D : a.ctx + (size_t)(r0 - MLAT) * D;
#pragma unroll
        for (int j = 0; j < 8; ++j) v[j] = *(const f32x4*)(src + lane * 4 + 256 * j); } }
    for (int r = blockIdx.x * NWAVES + wave; r < MTOT; r += G * NWAVES) {
        const int mv = (r < MLAT) ? (r >> 12) : 4;
        { const int rn = r + G * NWAVES; if (rn < MTOT) { const float* srcn = (rn < MLAT) ? a.x + (size_t)rn * D : a.ctx + (size_t)(rn - MLAT) * D;
#pragma unroll
            for (int j = 0; j < 8; ++j) vn[j] = *(const f32x4*)(srcn + lane * 4 + 256 * j); } }
        float ss = 0.f;
#pragma unroll
        for (int j = 0; j < 8; ++j) ss += (v[j].x * v[j].x + v[j].y * v[j].y) + (v[j].z * v[j].z + v[j].w * v[j].w);
        const float rstd = rsqrtf(wave_sum(ss) * (1.f / D) + EPS);
#pragma unroll
        for (int j = 0; j < 8; ++j) { const int c = lane * 4 + 256 * j;
            const f32x4 nm = *(const f32x4*)(a.norm_mix + c);
            const f32x4 sh = mod4(MOD, mv * 12288 + c) + *(const f32x4*)(a.ada_b + c);
            const f32x4 scl = mod4(MOD, mv * 12288 + D + c) + *(const f32x4*)(a.ada_b + D + c);
            const f32x4 h = v[j] * rstd * nm * (scl + 1.f) + sh;
            u32x2 w; w.x = pk2(h.x, h.y); w.y = pk2(h.z, h.w);
            *(u32x2*)(H + (size_t)r * D + c) = w;
            if (r < MLAT) *(unsigned*)(a.ws + WS_R2 + R2_H8 + (size_t)r * D + c) = pk4_fp8(h.x, h.y, h.z, h.w); }
#pragma unroll
        for (int j = 0; j < 8; ++j) v[j] = vn[j];
    }
}

__device__ __forceinline__ void scan_hgrn_naive(const Args& a, LAS unsigned char* lds, int b, int h, int dir) {
    const int tid = threadIdx.x, v = tid >> 2, dq = tid & 3, tok = tid >> 4, c8 = (tid & 15) * 8;
    LAS float* Lq = (LAS float*)lds; LAS float* Lk = Lq + 4096; LAS float* Lf = Lk + 4096; LAS float* Lv = Lf + 4096;
    const bf16_t* P = (const bf16_t*)(a.ws + WS_P);
    bf16_t* O = (bf16_t*)((unsigned char*)a.out + (dir ? R2_OAB : R2_OAF));
    float lo8[8];
#pragma unroll
    for (int j = 0; j < 8; ++j) { const int d = h * 128 + c8 + j; const float l0 = a.hgrn_lb[(dir * 2 + 0) * 1024 + d], l1 = a.hgrn_lb[(dir * 2 + 1) * 1024 + d]; lo8[j] = 1.f / (1.f + __expf(l1 - l0)); }
    float S[32];
#pragma unroll
    for (int i = 0; i < 32; ++i) S[i] = 0.f;
    const int cf = dir ? C_FB : C_FF;
    for (int p0 = 0; p0 < CTXL + SEQ; p0 += 32) {
        __syncthreads();
        { const int p = p0 + tok;
          const int row = (p < CTXL) ? (MLAT + b * CTXL + (dir ? CTXL - 1 - p : p)) : (b * SEQ + (dir ? SEQ - 1 - (p - CTXL) : (p - CTXL)));
          const bf16_t* pr = P + (size_t)row * PC + h * 128 + c8;
          const u32x4 rq = *(const u32x4*)(pr + C_HQ), rf = *(const u32x4*)(pr + cf), ri = *(const u32x4*)(pr + C_HI);
          const unsigned wq[4] = {rq.x, rq.y, rq.z, rq.w}, wf[4] = {rf.x, rf.y, rf.z, rf.w}, wi[4] = {ri.x, ri.y, ri.z, ri.w};
          float oq[8], ok[8], of[8], ov[8];
#pragma unroll
          for (int j = 0; j < 8; ++j) {
              const float xq = (j & 1) ? bfhi(wq[j >> 1]) : bflo(wq[j >> 1]), xf = (j & 1) ? bfhi(wf[j >> 1]) : bflo(wf[j >> 1]), xi = (j & 1) ? bfhi(wi[j >> 1]) : bflo(wi[j >> 1]);
              const float sg = sigmoid_f(xf), lo = lo8[j];
              oq[j] = silu_f(xq); of[j] = lo + (1.f - lo) * sg; ok[j] = (1.f - lo) * (1.f - sg); ov[j] = xi; }
          const int o = tok * 128 + c8;
          *(LAS f32x4*)(Lq + o) = (f32x4){oq[0], oq[1], oq[2], oq[3]}; *(LAS f32x4*)(Lq + o + 4) = (f32x4){oq[4], oq[5], oq[6], oq[7]};
          *(LAS f32x4*)(Lk + o) = (f32x4){ok[0], ok[1], ok[2], ok[3]}; *(LAS f32x4*)(Lk + o + 4) = (f32x4){ok[4], ok[5], ok[6], ok[7]};
          *(LAS f32x4*)(Lf + o) = (f32x4){of[0], of[1], of[2], of[3]}; *(LAS f32x4*)(Lf + o + 4) = (f32x4){of[4], of[5], of[6], of[7]};
          *(LAS f32x4*)(Lv + o) = (f32x4){ov[0], ov[1], ov[2], ov[3]}; *(LAS f32x4*)(Lv + o + 4) = (f32x4){ov[4], ov[5], ov[6], ov[7]};
        }
        __syncthreads();
        for (int tt = 0; tt < 32; ++tt) {
            const float vv = Lv[tt * 128 + v];
            float o = 0.f;
            const int base = tt * 128 + dq * 32;
#pragma unroll
            for (int i = 0; i < 32; i += 4) {
                const f32x4 f4 = *(const LAS f32x4*)(Lf + base + i), k4 = *(const LAS f32x4*)(Lk + base + i), q4 = *(const LAS f32x4*)(Lq + base + i);
                S[i] = f4.x * S[i] + k4.x * vv; o += q4.x * S[i];
                S[i + 1] = f4.y * S[i + 1] + k4.y * vv; o += q4.y * S[i + 1];
                S[i + 2] = f4.z * S[i + 2] + k4.z * vv; o += q4.z * S[i + 2];
                S[i + 3] = f4.w * S[i + 3] + k4.w * vv; o += q4.w * S[i + 3];
            }
            o += __shfl_xor(o, 1); o += __shfl_xor(o, 2);
            const int p = p0 + tt;
            if (p >= CTXL && dq == 0) { const int pos = dir ? SEQ - 1 - (p - CTXL) : (p - CTXL); O[(size_t)(b * SEQ + pos) * 1024 + h * 128 + v] = (bf16_t)f2bf(o); }
        }
    }
}

__device__ __forceinline__ void scan_gdn_naive(const Args& a, LAS unsigned char* lds, int b, int h, int dir) {
    const int tid = threadIdx.x, v = tid >> 2, dq = tid & 3, tok = tid >> 4, c8 = (tid & 15) * 8;
    LAS float* Lq = (LAS float*)lds; LAS float* Lk = Lq + 4096; LAS float* Lv = Lk + 4096; LAS float* Lg = Lv + 4096; LAS float* Lb = Lg + 32;
    const bf16_t* P = (const bf16_t*)(a.ws + WS_P); const float* AB = (const float*)(a.ws + WS_AB);
    bf16_t* O = (bf16_t*)((unsigned char*)a.out + (dir ? R2_OBB : R2_OBF));
    const float Acoef = -__expf(a.a_log[dir * 8 + h]), dtb = a.dt_bias[dir * 8 + h];
    float S[32];
#pragma unroll
    for (int i = 0; i < 32; ++i) S[i] = 0.f;
    for (int p0 = 0; p0 < CTXL + SEQ; p0 += 32) {
        __syncthreads();
        { const int p = p0 + tok; const bool isc = p < CTXL;
          const int L = isc ? CTXL : SEQ;
          const int sn = isc ? (dir ? CTXL - 1 - p : p) : (dir ? SEQ - 1 - (p - CTXL) : (p - CTXL));
          float aq[8], ak[8], av[8];
#pragma unroll
          for (int j = 0; j < 8; ++j) { aq[j] = 0.f; ak[j] = 0.f; av[j] = 0.f; }
          int rowc = 0;
#pragma unroll 1
          for (int tap = 0; tap < 5; ++tap) {
              const int s2 = sn + tap - 2;
              const int s2c = s2 < 0 ? 0 : (s2 >= L ? L - 1 : s2);
              const int row = isc ? (MLAT + b * CTXL + s2c) : (b * SEQ + (s2c & 63) * 64 + (s2c >> 6));
              if (tap == 2) rowc = row;
              const float ok = (s2 >= 0 && s2 < L) ? 1.f : 0.f;
              const bf16_t* pr = P + (size_t)row * PC + h * 128 + c8;
              const u32x4 rq = *(const u32x4*)(pr + C_GQ), rk = *(const u32x4*)(pr + C_GK), rv = *(const u32x4*)(pr + C_GV);
              const float* cw = a.gdn_conv + (size_t)tap * 3072 + h * 128 + c8;
              const f32x4 wq0 = *(const f32x4*)(cw), wq1 = *(const f32x4*)(cw + 4), wk0 = *(const f32x4*)(cw + 1024), wk1 = *(const f32x4*)(cw + 1028), wv0 = *(const f32x4*)(cw + 2048), wv1 = *(const f32x4*)(cw + 2052);
              const float cq[8] = {wq0.x, wq0.y, wq0.z, wq0.w, wq1.x, wq1.y, wq1.z, wq1.w}, ck[8] = {wk0.x, wk0.y, wk0.z, wk0.w, wk1.x, wk1.y, wk1.z, wk1.w}, cv[8] = {wv0.x, wv0.y, wv0.z, wv0.w, wv1.x, wv1.y, wv1.z, wv1.w};
              const unsigned uq[4] = {rq.x, rq.y, rq.z, rq.w}, uk[4] = {rk.x, rk.y, rk.z, rk.w}, uv[4] = {rv.x, rv.y, rv.z, rv.w};
#pragma unroll
              for (int j = 0; j < 8; ++j) {
                  const float xq = (j & 1) ? bfhi(uq[j >> 1]) : bflo(uq[j >> 1]), xk = (j & 1) ? bfhi(uk[j >> 1]) : bflo(uk[j >> 1]), xv = (j & 1) ? bfhi(uv[j >> 1]) : bflo(uv[j >> 1]);
                  aq[j] += ok * cq[j] * xq; ak[j] += ok * ck[j] * xk; av[j] += ok * cv[j] * xv; }
          }
          float sq = 0.f, sk = 0.f;
#pragma unroll
          for (int j = 0; j < 8; ++j) { aq[j] = silu_f(aq[j]); ak[j] = silu_f(ak[j]); av[j] = silu_f(av[j]); sq += aq[j] * aq[j]; sk += ak[j] * ak[j]; }
#pragma unroll
          for (int o = 1; o < 16; o <<= 1) { sq += __shfl_xor(sq, o); sk += __shfl_xor(sk, o); }
          const float rq_ = rsqrtf(sq + EPS) * 0.08838834764831845f, rk_ = rsqrtf(sk + EPS);
          const int o = tok * 128 + c8;
          *(LAS f32x4*)(Lq + o) = (f32x4){aq[0] * rq_, aq[1] * rq_, aq[2] * rq_, aq[3] * rq_}; *(LAS f32x4*)(Lq + o + 4) = (f32x4){aq[4] * rq_, aq[5] * rq_, aq[6] * rq_, aq[7] * rq_};
          *(LAS f32x4*)(Lk + o) = (f32x4){ak[0] * rk_, ak[1] * rk_, ak[2] * rk_, ak[3] * rk_}; *(LAS f32x4*)(Lk + o + 4) = (f32x4){ak[4] * rk_, ak[5] * rk_, ak[6] * rk_, ak[7] * rk_};
          *(LAS f32x4*)(Lv + o) = (f32x4){av[0], av[1], av[2], av[3]}; *(LAS f32x4*)(Lv + o + 4) = (f32x4){av[4], av[5], av[6], av[7]};
          if ((tid & 15) == 0) { const float al = AB[(size_t)rowc * 32 + dir * 8 + h], bl = AB[(size_t)rowc * 32 + 16 + dir * 8 + h];
              Lg[tok] = __expf(Acoef * softplus_f(al + dtb)); Lb[tok] = sigmoid_f(bl); }
        }
        __syncthreads();
        for (int tt = 0; tt < 32; ++tt) {
            const float vv = Lv[tt * 128 + v], eg = Lg[tt], be = Lb[tt];
            const int base = tt * 128 + dq * 32;
            float ks = 0.f;
#pragma unroll
            for (int i = 0; i < 32; i += 4) { const f32x4 k4 = *(const LAS f32x4*)(Lk + base + i);
                S[i] *= eg; S[i + 1] *= eg; S[i + 2] *= eg; S[i + 3] *= eg;
                ks += k4.x * S[i] + k4.y * S[i + 1] + k4.z * S[i + 2] + k4.w * S[i + 3]; }
            ks += __shfl_xor(ks, 1); ks += __shfl_xor(ks, 2);
            const float err = be * (vv - ks);
            float o = 0.f;
#pragma unroll
            for (int i = 0; i < 32; i += 4) { const f32x4 k4 = *(const LAS f32x4*)(Lk + base + i), q4 = *(const LAS f32x4*)(Lq + base + i);
                S[i] += k4.x * err; S[i + 1] += k4.y * err; S[i + 2] += k4.z * err; S[i + 3] += k4.w * err;
                o += q4.x * S[i] + q4.y * S[i + 1] + q4.z * S[i + 2] + q4.w * S[i + 3]; }
            o += __shfl_xor(o, 1); o += __shfl_xor(o, 2);
            const int p = p0 + tt;
            if (p >= CTXL && dq == 0) { const int sn = dir ? SEQ - 1 - (p - CTXL) : (p - CTXL); const int pos = (sn & 63) * 64 + (sn >> 6);
                O[(size_t)(b * SEQ + pos) * 1024 + h * 128 + v] = (bf16_t)f2bf(o); }
        }
    }
}


__device__ __forceinline__ int gdn_row(int b, bool isc, int n) { return isc ? (MLAT + b * CTXL + n) : (b * SEQ + (n & 63) * 64 + (n >> 6)); }
__device__ __forceinline__ void gdnprep_halo(const Args& a) {
    const int tid = threadIdx.x;
    const bf16_t* P = (const bf16_t*)(a.ws + WS_P); bf16_t* HALO = (bf16_t*)(a.ws + WS_HALO);
    for (int t = blockIdx.x; t < NB * 8 * 68; t += gridDim.x) {
        const int cc = t % 68, bh = t / 68, b = bh >> 3, h = bh & 7; const bool isc = cc < 4; const int L = isc ? CTXL : SEQ, n0 = 64 * (isc ? cc : cc - 4);
        if (tid < 192) { const int hr = tid / 48, c16 = tid % 48; const int n = (hr < 2) ? n0 - 2 + hr : n0 + 62 + hr;
            u32x4 v = (u32x4){0u, 0u, 0u, 0u};
            if (n >= 0 && n < L) v = *(const u32x4*)(P + (size_t)gdn_row(b, isc, n) * PC + C_GQ + (c16 >> 4) * 1024 + h * 128 + (c16 & 15) * 8);
            *(u32x4*)(HALO + ((size_t)t * 4 + hr) * 384 + c16 * 8) = v; }
    }
}
__device__ __forceinline__ void gdnprep_conv(const Args& a, LAS unsigned char* lds) {
    const int tid = threadIdx.x;
    constexpr int RAW = 0, PRAW = 784, CW = 53312;
    bf16_t* P = (bf16_t*)(a.ws + WS_P); const bf16_t* HALO = (const bf16_t*)(a.ws + WS_HALO);
    constexpr int NT = NB * 8 * 68;
    u32x4 rr[7]; float cwr[4];
#define GP_LOAD(t_) do { const int cc_ = (t_) % 68, bh_ = (t_) / 68, b_ = bh_ >> 3, h_ = bh_ & 7; const bool isc_ = cc_ < 4; const int n0_ = 64 * (isc_ ? cc_ : cc_ - 4); \
        _Pragma("unroll") for (int k = 0; k < 7; ++k) { int piece = tid + NTHR * k; piece = piece < 68 * 48 ? piece : 68 * 48 - 1; const int wr_ = piece / 48, c16 = piece % 48; \
            const bf16_t* src = (wr_ >= 2 && wr_ < 66) ? (P + (size_t)gdn_row(b_, isc_, n0_ + wr_ - 2) * PC + C_GQ + (c16 >> 4) * 1024 + h_ * 128 + (c16 & 15) * 8) \
                                                      : (HALO + ((size_t)(t_) * 4 + (wr_ < 2 ? wr_ : wr_ - 64)) * 384 + c16 * 8); \
            rr[k] = *(const u32x4*)src; } \
        _Pragma("unroll") for (int k = 0; k < 4; ++k) { int i = tid + NTHR * k; i = i < 1920 ? i : 1919; const int tap = i / 384, c3 = i % 384; cwr[k] = a.gdn_conv[(size_t)tap * 3072 + (c3 >> 7) * 1024 + h_ * 128 + (c3 & 127)]; } } while (0)
    if ((int)blockIdx.x < NT) GP_LOAD((int)blockIdx.x);
    for (int t = blockIdx.x; t < NT; t += gridDim.x) {
        const int cc = t % 68, bh = t / 68, b = bh >> 3, h = bh & 7; const bool isc = cc < 4; const int n0 = 64 * (isc ? cc : cc - 4);
        __syncthreads();
#pragma unroll
        for (int k = 0; k < 4; ++k) { const int i = tid + NTHR * k; if (i < 1920) ((LAS float*)(lds + CW))[i] = cwr[k]; }
#pragma unroll
        for (int k = 0; k < 7; ++k) { const int piece = tid + NTHR * k; if (piece < 68 * 48) { const int wr_ = piece / 48, c16 = piece % 48; *(LAS u32x4*)(lds + RAW + wr_ * PRAW + c16 * 16) = rr[k]; } }
        if (t + (int)gridDim.x < NT) GP_LOAD(t + (int)gridDim.x);
        if (tid < 128) {
            const int dirg = tid >> 6, nl = tid & 63; float* ABw = (float*)(a.ws + WS_AB);
            const size_t row = (size_t)gdn_row(b, isc, n0 + nl);
            const float al = ABw[row * 32 + dirg * 8 + h], bl = ABw[row * 32 + 16 + dirg * 8 + h];
            const float g = -__expf(a.a_log[dirg * 8 + h]) * softplus_f(al + a.dt_bias[dirg * 8 + h]);
            float Gc = g;
#pragma unroll
            for (int o = 1; o < 64; o <<= 1) { const float t = dirg ? __shfl_down(Gc, o) : __shfl_up(Gc, o); if (dirg ? (nl + o < 64) : (nl >= o)) Gc += t; }
            ABw[row * 32 + dirg * 8 + h] = Gc; ABw[row * 32 + 16 + dirg * 8 + h] = sigmoid_f(bl);
        }
        __syncthreads();
        {
            const int cg = tid & 31, tg = tid >> 5, nb = 4 * tg;
#pragma unroll 1
            for (int ten = 0; ten < 3; ++ten) {
                f32x4 wt[5];
#pragma unroll
                for (int tap = 0; tap < 5; ++tap) wt[tap] = *(const LAS f32x4*)((const LAS float*)(lds + CW) + tap * 384 + ten * 128 + 4 * cg);
                f32x4 acc[4];
#pragma unroll
                for (int u = 0; u < 4; ++u) acc[u] = (f32x4){0.f, 0.f, 0.f, 0.f};
#pragma unroll
                for (int rw_ = 0; rw_ < 8; ++rw_) { const u32x2 x = *(const LAS u32x2*)(lds + RAW + (nb + rw_) * PRAW + (ten * 128 + 4 * cg) * 2);
                    const f32x4 xv = (f32x4){bflo(x.x), bfhi(x.x), bflo(x.y), bfhi(x.y)};
#pragma unroll
                    for (int u = 0; u < 4; ++u) { const int tap = rw_ - u; if (tap >= 0 && tap < 5) acc[u] += wt[tap] * xv; } }
                float ss[4];
#pragma unroll
                for (int u = 0; u < 4; ++u) { acc[u].x = silu_f(acc[u].x); acc[u].y = silu_f(acc[u].y); acc[u].z = silu_f(acc[u].z); acc[u].w = silu_f(acc[u].w);
                    ss[u] = (acc[u].x * acc[u].x + acc[u].y * acc[u].y) + (acc[u].z * acc[u].z + acc[u].w * acc[u].w); }
                if (ten < 2) {
#pragma unroll
                    for (int o = 1; o < 32; o <<= 1) {
#pragma unroll
                        for (int u = 0; u < 4; ++u) ss[u] += __shfl_xor(ss[u], o); }
#pragma unroll
                    for (int u = 0; u < 4; ++u) { const float sc = rsqrtf(ss[u] + EPS) * (ten == 0 ? 0.08838834764831845f : 1.f); acc[u] = acc[u] * sc; }
                }
#pragma unroll
                for (int u = 0; u < 4; ++u) *(u32x2*)(P + (size_t)gdn_row(b, isc, n0 + nb + u) * PC + C_GQ + ten * 1024 + h * 128 + 4 * cg) = (u32x2){pk2(acc[u].x, acc[u].y), pk2(acc[u].z, acc[u].w)};
            }
        }
    }
}

#undef GP_LOAD

typedef short bf16x4 __attribute__((ext_vector_type(4)));
__device__ __forceinline__ unsigned cvtpk(float lo, float hi) { return pk2(lo, hi); }
__device__ __forceinline__ bf16x8 pack_tiles(const f32x4 t0, const f32x4 t1) {
    u32x4 r; r.x = cvtpk(t0[0], t0[1]); r.y = cvtpk(t0[2], t0[3]); r.z = cvtpk(t1[0], t1[1]); r.w = cvtpk(t1[2], t1[3]); return __builtin_bit_cast(bf16x8, r); }
__device__ __forceinline__ bf16x4 pack_tile(const f32x4 t) { u32x2 r; r.x = cvtpk(t[0], t[1]); r.y = cvtpk(t[2], t[3]); return __builtin_bit_cast(bf16x4, r); }
__device__ __forceinline__ bf16x8 lds_a_perm(const LAS unsigned char* p, int fq) {
    const u32x2 lo = *(const LAS u32x2*)(p + 8 * fq), hi = *(const LAS u32x2*)(p + 32 + 8 * fq);
    u32x4 r; r.x = lo.x; r.y = lo.y; r.z = hi.x; r.w = hi.y; return __builtin_bit_cast(bf16x8, r); }
#define MFMA32(A, B, C) __builtin_amdgcn_mfma_f32_16x16x32_bf16((A), (B), (C), 0, 0, 0)
#define MFMA16(A, B, C) __builtin_amdgcn_mfma_f32_16x16x16bf16_1k((A), (B), (C), 0, 0, 0)

__device__ __forceinline__ void scan_hgrn_mfma(const Args& a, LAS unsigned char* lds, const int b, const int h, const int dir) {
    int tid0 = threadIdx.x; asm volatile("" : "+v"(tid0)); const int w = __builtin_amdgcn_readfirstlane(tid0 >> 6);
    const int d = tid0 & 127, tq = tid0 >> 7;
    constexpr int QM = 0, KM = 17408, QT = 34816, KHT = 52224, VT = 70656, AM = 89088, AV = 98304, SEG = 98816;
    constexpr int PQ = 272, PT = 144;
    const bf16_t* P = (const bf16_t*)(a.ws + WS_P);
    bf16_t* O = (bf16_t*)((unsigned char*)a.out + (dir ? R2_OAB : R2_OAF));
    float lo;
    { const int ch = h * 128 + d; const float l0 = a.hgrn_lb[(dir * 2 + 0) * 1024 + ch], l1 = a.hgrn_lb[(dir * 2 + 1) * 1024 + ch]; lo = 1.f / (1.f + __expf(l1 - l0)); }
    const int cf = dir ? C_FB : C_FF;
    f32x4 S[8];
#pragma unroll
    for (int i = 0; i < 8; ++i) S[i] = (f32x4){0.f, 0.f, 0.f, 0.f};
    u32x4 rr[6];
#define HG_LOAD(cc) do { const int i_ = tid >> 3, part_ = tid & 7; const int p = 64 * (cc) + i_; \
        const int row = (p < CTXL) ? (MLAT + b * CTXL + (dir ? CTXL - 1 - p : p)) : (b * SEQ + (dir ? SEQ - 1 - (p - CTXL) : (p - CTXL))); \
        const bf16_t* pr = P + (size_t)row * PC + h * 128 + part_ * 16; \
        rr[0] = *(const u32x4*)(pr + C_HQ); rr[1] = *(const u32x4*)(pr + C_HQ + 8); rr[2] = *(const u32x4*)(pr + cf); rr[3] = *(const u32x4*)(pr + cf + 8); \
        rr[4] = *(const u32x4*)(pr + C_HI); rr[5] = *(const u32x4*)(pr + C_HI + 8); } while (0)
    { const int tid = tid0; HG_LOAD(0); }
    for (int c = 0; c < 68; ++c) {
        int tid = tid0; asm volatile("" : "+v"(tid)); const int lane = tid & 63, fr = lane & 15, fq = lane >> 4;
        __syncthreads();
        { const int i_ = tid >> 3, part_ = tid & 7;
          *(LAS u32x4*)(lds + QM + i_ * PQ + part_ * 32) = rr[0]; *(LAS u32x4*)(lds + QM + i_ * PQ + part_ * 32 + 16) = rr[1];
          *(LAS u32x4*)(lds + KM + i_ * PQ + part_ * 32) = rr[2]; *(LAS u32x4*)(lds + KM + i_ * PQ + part_ * 32 + 16) = rr[3];
          *(LAS u32x4*)(lds + QT + i_ * PQ + part_ * 32) = rr[4]; *(LAS u32x4*)(lds + QT + i_ * PQ + part_ * 32 + 16) = rr[5]; }
        if (c + 1 < 68) HG_LOAD(c + 1);
        __syncthreads();
        unsigned short ri[16];
        float fv[16], kk[16], qs[16]; float pl = 1.f;
#pragma unroll
        for (int t = 0; t < 16; ++t) { const int i_ = tq * 16 + t;
            const float xq = bf2f(*(const LAS unsigned short*)(lds + QM + i_ * PQ + d * 2)), xf = bf2f(*(const LAS unsigned short*)(lds + KM + i_ * PQ + d * 2)); ri[t] = *(const LAS unsigned short*)(lds + QT + i_ * PQ + d * 2);
            const float sg = sigmoid_f(xf); const float f = lo + (1.f - lo) * sg; kk[t] = (1.f - lo) * (1.f - sg); pl *= f; fv[t] = pl; qs[t] = silu_f(xq); }
        ((LAS float*)(lds + SEG))[tq * 128 + d] = pl;
        { u32x4 v0, v1; v0.x = ri[0] | ((unsigned)ri[1] << 16); v0.y = ri[2] | ((unsigned)ri[3] << 16); v0.z = ri[4] | ((unsigned)ri[5] << 16); v0.w = ri[6] | ((unsigned)ri[7] << 16);
          v1.x = ri[8] | ((unsigned)ri[9] << 16); v1.y = ri[10] | ((unsigned)ri[11] << 16); v1.z = ri[12] | ((unsigned)ri[13] << 16); v1.w = ri[14] | ((unsigned)ri[15] << 16);
          *(LAS u32x4*)(lds + VT + d * PT + tq * 32) = v0; *(LAS u32x4*)(lds + VT + d * PT + tq * 32 + 16) = v1; }
        __syncthreads();
        {
            const LAS float* sg = (const LAS float*)(lds + SEG);
            const float s0 = sg[d], s1 = sg[128 + d], s2 = sg[256 + d], s3 = sg[384 + d];
            const float pre = (tq == 0) ? 1.f : (tq == 1 ? s0 : (tq == 2 ? s0 * s1 : s0 * s1 * s2));
            const float pmid = s0 * s1, plast = pmid * s2 * s3, rmid = rcp_f(pmid), c1 = plast * rmid;
            unsigned kh[8];
#pragma unroll
            for (int t = 0; t < 16; ++t) {
                const float Pt = pre * fv[t], e1 = Pt * rmid, r1 = rcp_f(e1);
                const int i = tq * 16 + t;
                *(LAS unsigned short*)(lds + QM + i * PQ + d * 2) = (unsigned short)f2bf(qs[t] * e1);
                *(LAS unsigned short*)(lds + KM + i * PQ + d * 2) = (unsigned short)f2bf(kk[t] * r1);
                *(LAS unsigned short*)(lds + QT + i * PQ + d * 2) = (unsigned short)f2bf(qs[t] * Pt);
                const unsigned kb = f2bf(kk[t] * r1 * c1);
                if (t & 1) kh[t >> 1] |= kb << 16; else kh[t >> 1] = kb;
            }
            *(LAS u32x4*)(lds + KHT + d * PT + tq * 32) = (u32x4){kh[0], kh[1], kh[2], kh[3]}; *(LAS u32x4*)(lds + KHT + d * PT + tq * 32 + 16) = (u32x4){kh[4], kh[5], kh[6], kh[7]};
            if (tq == 0) ((LAS float*)(lds + AV))[d] = plast;
        }
        __syncthreads();
        {
            const int mt = w >> 1;
#pragma unroll
            for (int nn = 0; nn < 2; ++nn) { const int nt = (w & 1) * 2 + nn;
                f32x4 acc = (f32x4){0.f, 0.f, 0.f, 0.f};
                if (nt <= mt) {
#pragma unroll
                    for (int s = 0; s < 4; ++s) { const bf16x8 A = *(const LAS bf16x8*)(lds + QM + (16 * mt + fr) * PQ + (32 * s + 8 * fq) * 2), B = *(const LAS bf16x8*)(lds + KM + (16 * nt + fr) * PQ + (32 * s + 8 * fq) * 2);
                        acc = MFMA32(A, B, acc); } }
#pragma unroll
                for (int r = 0; r < 4; ++r) { const int i = 16 * mt + 4 * fq + r, j = 16 * nt + fr; *(LAS unsigned short*)(lds + AM + i * PT + j * 2) = (unsigned short)f2bf(j <= i ? acc[r] : 0.f); }
            }
        }
        __syncthreads();
        {
            bf16x8 vb[2];
#pragma unroll
            for (int s2 = 0; s2 < 2; ++s2) vb[s2] = *(const LAS bf16x8*)(lds + VT + (16 * w + fr) * PT + (32 * s2 + 8 * fq) * 2);
            if (c >= 4) {
                bf16x8 sb[4];
#pragma unroll
                for (int s = 0; s < 4; ++s) sb[s] = pack_tiles(S[2 * s], S[2 * s + 1]);
                f32x4 o[4];
#pragma unroll
                for (int mt = 0; mt < 4; ++mt) { o[mt] = (f32x4){0.f, 0.f, 0.f, 0.f};
#pragma unroll
                    for (int s = 0; s < 4; ++s) o[mt] = MFMA32(lds_a_perm(lds + QT + (16 * mt + fr) * PQ + 64 * s, fq), sb[s], o[mt]);
#pragma unroll
                    for (int s2 = 0; s2 < 2; ++s2) if (2 * s2 <= mt) o[mt] = MFMA32(*(const LAS bf16x8*)(lds + AM + (16 * mt + fr) * PT + (32 * s2 + 8 * fq) * 2), vb[s2], o[mt]);
                }
#pragma unroll
                for (int mt = 0; mt < 4; ++mt)
#pragma unroll
                    for (int r = 0; r < 4; ++r) { const int i = 16 * mt + 4 * fq + r, sidx = 64 * (c - 4) + i, pos = dir ? SEQ - 1 - sidx : sidx;
                        O[(size_t)(b * SEQ + pos) * 1024 + h * 128 + 16 * w + fr] = (bf16_t)f2bf(o[mt][r]); }
            }
#pragma unroll
            for (int dt = 0; dt < 8; ++dt) { const f32x4 a4 = *(const LAS f32x4*)(lds + AV + (16 * dt + 4 * fq) * 4); S[dt] = S[dt] * a4;
#pragma unroll
                for (int s2 = 0; s2 < 2; ++s2) S[dt] = MFMA32(*(const LAS bf16x8*)(lds + KHT + (16 * dt + fr) * PT + (32 * s2 + 8 * fq) * 2), vb[s2], S[dt]); }
        }
    }
#undef HG_LOAD
}

__device__ __forceinline__ void scan_gdn_mfma(const Args& a, LAS unsigned char* lds, const int b, const int h, const int dir) {
    int tid0 = threadIdx.x; asm volatile("" : "+v"(tid0)); const int w = __builtin_amdgcn_readfirstlane(tid0 >> 6);
    constexpr int RAW = 0, PRAW = 784;
    constexpr int LT = 0, AQK = 9216, LD = 18432, PT = 144;
    constexpr int QN = 53312, KN = 70720, PQ = 272;
    constexpr int KNT = 88128;
    constexpr int VB = 106560;
    constexpr int GT = 123968;
    constexpr int CW = 125008;
    const bf16_t* P = (const bf16_t*)(a.ws + WS_P); const float* AB = (const float*)(a.ws + WS_AB);
    bf16_t* O = (bf16_t*)((unsigned char*)a.out + (dir ? R2_OBB : R2_OBF));
    __syncthreads();
    for (int i = tid0; i < 64 * 72 / 2; i += NTHR) ((LAS unsigned*)(lds + AQK))[i] = 0u;
    f32x4 S[8];
#pragma unroll
    for (int i = 0; i < 8; ++i) S[i] = (f32x4){0.f, 0.f, 0.f, 0.f};
    u32x4 rr[6]; float g_nx = 0.f, b_nx = 0.f;
#define GD_GEOM(c_, isc_, L_, n0_) const bool isc_ = (c_) < 4; const int L_ = isc_ ? CTXL : SEQ; const int n0_ = 64 * (isc_ ? (dir ? 3 - (c_) : (c_)) : (dir ? 63 - ((c_) - 4) : ((c_) - 4)));
#define GD_LOAD(c_) do { GD_GEOM(c_, isc, L, n0) (void)L; { const int i_ = tid >> 3, part_ = tid & 7; const int n = n0 + (dir ? 63 - i_ : i_); \
        const bf16_t* pr = P + (size_t)gdn_row(b, isc, n) * PC + C_GQ + h * 128 + part_ * 16; \
        rr[0] = *(const u32x4*)(pr); rr[1] = *(const u32x4*)(pr + 8); rr[2] = *(const u32x4*)(pr + 1024); rr[3] = *(const u32x4*)(pr + 1032); rr[4] = *(const u32x4*)(pr + 2048); rr[5] = *(const u32x4*)(pr + 2056); } \
        if (w == 0) { const int ln = tid & 63; const int n = n0 + (dir ? 63 - ln : ln); const size_t row = (size_t)gdn_row(b, isc, n); g_nx = AB[row * 32 + dir * 8 + h]; b_nx = AB[row * 32 + 16 + dir * 8 + h]; } } while (0)
    { const int tid = tid0; GD_LOAD(0); }
    for (int c = 0; c < 68; ++c) {
        GD_GEOM(c, isc, L, n0) (void)L; (void)isc;
        int tid = tid0; asm volatile("" : "+v"(tid));
        int lane = tid & 63, fr = lane & 15, fq = lane >> 4;
        __syncthreads();
        {
            const int i_ = tid >> 3, part_ = tid & 7;
            *(LAS u32x4*)(lds + QN + i_ * PQ + part_ * 32) = rr[0]; *(LAS u32x4*)(lds + QN + i_ * PQ + part_ * 32 + 16) = rr[1];
            *(LAS u32x4*)(lds + KN + i_ * PQ + part_ * 32) = rr[2]; *(LAS u32x4*)(lds + KN + i_ * PQ + part_ * 32 + 16) = rr[3];
            *(LAS u32x4*)(lds + VB + i_ * PQ + part_ * 32) = rr[4]; *(LAS u32x4*)(lds + VB + i_ * PQ + part_ * 32 + 16) = rr[5];
            const unsigned kw[8] = {rr[2].x, rr[2].y, rr[2].z, rr[2].w, rr[3].x, rr[3].y, rr[3].z, rr[3].w};
#pragma unroll
            for (int j = 0; j < 8; ++j) { *(LAS unsigned short*)(lds + KNT + (part_ * 16 + 2 * j) * PT + i_ * 2) = (unsigned short)(kw[j] & 0xffffu);
                *(LAS unsigned short*)(lds + KNT + (part_ * 16 + 2 * j + 1) * PT + i_ * 2) = (unsigned short)(kw[j] >> 16); }
        }
        const float g_in = g_nx, b_in = b_nx;
        if (c + 1 < 68) GD_LOAD(c + 1);
        if (w == 0) {
            const float G = g_in;
            const float Glast = __shfl(G, 63);
            LAS float* gt = (LAS float*)(lds + GT);
            gt[lane] = __expf(G); gt[64 + lane] = __expf(Glast - G); gt[128 + lane] = b_in; gt[192 + lane] = G;
            if (lane == 0) gt[256] = __expf(Glast);
        }
        __syncthreads();
        tid = tid0; asm volatile("" : "+v"(tid)); lane = tid & 63; fr = lane & 15; fq = lane >> 4;
        {
            const LAS float* gt = (const LAS float*)(lds + GT);
#pragma unroll
            for (int nn = 0; nn < 2; ++nn) {
                int mt, nt;
                if (w < 4) { mt = w; nt = w; if (nn == 1) break; }
                else { const int id = (w - 4) * 2 + nn; if (id >= 6) break;
                    mt = (id == 0) ? 1 : (id <= 2 ? 2 : 3); nt = (id == 0 || id == 1 || id == 3) ? 0 : ((id == 2 || id == 4) ? 1 : 2); }
                f32x4 akk = (f32x4){0.f, 0.f, 0.f, 0.f}, aqk = (f32x4){0.f, 0.f, 0.f, 0.f};
#pragma unroll
                for (int s = 0; s < 4; ++s) { const bf16x8 Bk = *(const LAS bf16x8*)(lds + KN + (16 * nt + fr) * PQ + (32 * s + 8 * fq) * 2);
                    akk = MFMA32(*(const LAS bf16x8*)(lds + KN + (16 * mt + fr) * PQ + (32 * s + 8 * fq) * 2), Bk, akk);
                    aqk = MFMA32(*(const LAS bf16x8*)(lds + QN + (16 * mt + fr) * PQ + (32 * s + 8 * fq) * 2), Bk, aqk); }
                const int j = 16 * nt + fr; const float Gj = gt[192 + j];
                const f32x4 Gi4 = *(const LAS f32x4*)(gt + 192 + 16 * mt + 4 * fq), bi4 = *(const LAS f32x4*)(gt + 128 + 16 * mt + 4 * fq);
#pragma unroll
                for (int r = 0; r < 4; ++r) { const int i = 16 * mt + 4 * fq + r; const float Gi = Gi4[r], bi = bi4[r];
                    const float gam = (j <= i) ? __expf(Gi - Gj) : 0.f;
                    *(LAS unsigned short*)(lds + AQK + i * PT + j * 2) = (unsigned short)f2bf(aqk[r] * gam);
                    const float Lij = (j < i) ? bi * akk[r] * gam : 0.f;
                    if (w < 4) *(LAS unsigned short*)(lds + LD + (mt * 16 + (4 * fq + r)) * 40 + fr * 2) = (unsigned short)f2bf(-Lij);
                    else *(LAS unsigned short*)(lds + LT + i * PT + j * 2) = (unsigned short)f2bf(-Lij); }
            }
            if (w < 4) {
                asm volatile("s_waitcnt lgkmcnt(0)" ::: "memory"); __builtin_amdgcn_wave_barrier();
                const bf16x4 nl = *(const LAS bf16x4*)(lds + LD + (w * 16 + fr) * 40 + (4 * fq) * 2);
                f32x4 eye; eye[0] = (4 * fq + 0 == fr) ? 1.f : 0.f; eye[1] = (4 * fq + 1 == fr) ? 1.f : 0.f; eye[2] = (4 * fq + 2 == fr) ? 1.f : 0.f; eye[3] = (4 * fq + 3 == fr) ? 1.f : 0.f;
                f32x4 X = eye;
#pragma unroll
                for (int it = 0; it < 15; ++it) X = MFMA16(nl, pack_tile(X), eye);
#pragma unroll
                for (int r = 0; r < 4; ++r) *(LAS unsigned short*)(lds + LT + (16 * w + 4 * fq + r) * PT + (16 * w + fr) * 2) = (unsigned short)f2bf(X[r]);
            }
        }
        __syncthreads();
        tid = tid0; asm volatile("" : "+v"(tid)); lane = tid & 63; fr = lane & 15; fq = lane >> 4;
        {
            const LAS float* gt = (const LAS float*)(lds + GT);
            bf16x8 sb[4];
#pragma unroll
            for (int s = 0; s < 4; ++s) sb[s] = pack_tiles(S[2 * s], S[2 * s + 1]);
            f32x4 R[4];
#pragma unroll
            for (int mt = 0; mt < 4; ++mt) { f32x4 X = (f32x4){0.f, 0.f, 0.f, 0.f};
#pragma unroll
                for (int s = 0; s < 4; ++s) X = MFMA32(lds_a_perm(lds + KN + (16 * mt + fr) * PQ + 64 * s, fq), sb[s], X);
                const f32x4 be4 = *(const LAS f32x4*)(gt + 128 + 16 * mt + 4 * fq), eg4 = *(const LAS f32x4*)(gt + 16 * mt + 4 * fq);
#pragma unroll
                for (int r = 0; r < 4; ++r) { const int i = 16 * mt + 4 * fq + r; const float vv = bf2f(*(const LAS unsigned short*)(lds + VB + i * PQ + (16 * w + fr) * 2));
                    R[mt][r] = be4[r] * (vv - eg4[r] * X[r]); } }
            f32x4 vt[4];
#pragma unroll
            for (int ab = 0; ab < 4; ++ab) { f32x4 acc = R[ab];
#pragma unroll
                for (int bb = 0; bb < ab; ++bb) acc = MFMA16(*(const LAS bf16x4*)(lds + LT + (16 * ab + fr) * PT + (16 * bb + 4 * fq) * 2), pack_tile(vt[bb]), acc);
                const f32x4 z4 = {0.f, 0.f, 0.f, 0.f}; vt[ab] = MFMA16(*(const LAS bf16x4*)(lds + LT + (16 * ab + fr) * PT + (16 * ab + 4 * fq) * 2), pack_tile(acc), z4); }
            if (c >= 4) {
                const bf16x8 vnb0 = pack_tiles(vt[0], vt[1]), vnb1 = pack_tiles(vt[2], vt[3]);
                const int ccn = n0 >> 6;
#pragma unroll
                for (int mt = 0; mt < 4; ++mt) { f32x4 o = (f32x4){0.f, 0.f, 0.f, 0.f};
#pragma unroll
                    for (int s = 0; s < 4; ++s) o = MFMA32(lds_a_perm(lds + QN + (16 * mt + fr) * PQ + 64 * s, fq), sb[s], o);
                    o = o * *(const LAS f32x4*)(gt + 16 * mt + 4 * fq);
                    o = MFMA32(lds_a_perm(lds + AQK + (16 * mt + fr) * PT, fq), vnb0, o);
                    if (mt >= 2) o = MFMA32(lds_a_perm(lds + AQK + (16 * mt + fr) * PT + 64, fq), vnb1, o);
#pragma unroll
                    for (int r = 0; r < 4; ++r) { const int i = 16 * mt + 4 * fq + r, nloc = dir ? 63 - i : i;
                        O[(size_t)(b * SEQ + nloc * 64 + ccn) * 1024 + h * 128 + 16 * w + fr] = (bf16_t)f2bf(o[r]); } }
            }
#pragma unroll
            for (int mt = 0; mt < 4; ++mt) vt[mt] = vt[mt] * *(const LAS f32x4*)(gt + 64 + 16 * mt + 4 * fq);
            const bf16x8 vsb0 = pack_tiles(vt[0], vt[1]), vsb1 = pack_tiles(vt[2], vt[3]);
            const float egl = gt[256];
#pragma unroll
            for (int dt = 0; dt < 8; ++dt) { S[dt] = S[dt] * egl;
                S[dt] = MFMA32(lds_a_perm(lds + KNT + (16 * dt + fr) * PT, fq), vsb0, S[dt]);
                S[dt] = MFMA32(lds_a_perm(lds + KNT + (16 * dt + fr) * PT + 64, fq), vsb1, S[dt]); }
        }
    }
#undef GD_LOAD
#undef GD_GEOM
}

#ifndef SCAN_MODE
#define SCAN_MODE 3
#endif
__device__ __forceinline__ void phase_scan(const Args& a, LAS unsigned char* lds) {
    for (int it = blockIdx.x; it < 128; it += gridDim.x) {
        const int ch = it & 63, b = ch >> 4, h = (ch >> 1) & 7, dir = ch & 1;
        if (it < 64) { if (SCAN_MODE & 1) scan_hgrn_mfma(a, lds, b, h, dir); else scan_hgrn_naive(a, lds, b, h, dir);
 }
        else { if (SCAN_MODE & 2) scan_gdn_mfma(a, lds, b, h, dir); else scan_gdn_naive(a, lds, b, h, dir);
 }
        __syncthreads();
    }
}

__device__ __forceinline__ void phase_mergeprep(const Args& a) {
    const int tid = threadIdx.x, lane = tid & 63, wave = tid >> 6, G = gridDim.x;
    const bf16_t* P = (const bf16_t*)(a.ws + WS_P);
    const bf16_t* OAF = (const bf16_t*)((const unsigned char*)a.out + R2_OAF); const bf16_t* OAB = (const bf16_t*)((const unsigned char*)a.out + R2_OAB);
    const bf16_t* OBF = (const bf16_t*)((const unsigned char*)a.out + R2_OBF); const bf16_t* OBB = (const bf16_t*)((const unsigned char*)a.out + R2_OBB);
    bf16_t* YAB = (bf16_t*)(a.ws + WS_R1 + R1_YAB);
    const int c0 = lane * 16;
    u32x4 L[2][6], Ln[2][6];
#define MP_LOAD(dst, r_) do { _Pragma("unroll") for (int br = 0; br < 2; ++br) { const bf16_t* o1 = (br ? OBF : OAF) + (size_t)(r_) * 1024 + c0; const bf16_t* o2 = (br ? OBB : OAB) + (size_t)(r_) * 1024 + c0; \
        const bf16_t* gp = P + (size_t)(r_) * PC + (br ? C_Z : C_OG) + c0; \
        dst[br][0] = *(const u32x4*)o1; dst[br][1] = *(const u32x4*)(o1 + 8); dst[br][2] = *(const u32x4*)o2; dst[br][3] = *(const u32x4*)(o2 + 8); dst[br][4] = *(const u32x4*)gp; dst[br][5] = *(const u32x4*)(gp + 8); } } while (0)
    { const int r0 = blockIdx.x * NWAVES + wave; if (r0 < MLAT) MP_LOAD(L, r0); }
    for (int r = blockIdx.x * NWAVES + wave; r < MLAT; r += G * NWAVES) {
        { const int rn = r + G * NWAVES; if (rn < MLAT) MP_LOAD(Ln, rn); }
#pragma unroll
        for (int br = 0; br < 2; ++br) {
            const float* gain = (br ? a.gdn_norm : a.hgrn_norm) + c0;
            float val[16], gt[16]; float ss = 0.f;
#pragma unroll
            for (int hx = 0; hx < 2; ++hx) {
                const u32x4 w1 = L[br][hx], w2 = L[br][2 + hx], wg = L[br][4 + hx];
                const unsigned u1[4] = {w1.x, w1.y, w1.z, w1.w}, u2[4] = {w2.x, w2.y, w2.z, w2.w}, ug[4] = {wg.x, wg.y, wg.z, wg.w};
#pragma unroll
                for (int j = 0; j < 4; ++j) {
                    float s0 = bflo(u1[j]) + bflo(u2[j]), s1 = bfhi(u1[j]) + bfhi(u2[j]); const float g0 = bflo(ug[j]), g1 = bfhi(ug[j]);
                    if (br == 0) { s0 *= sigmoid_f(g0); s1 *= sigmoid_f(g1); gt[8 * hx + 2 * j] = 1.f; gt[8 * hx + 2 * j + 1] = 1.f; }
                    else { gt[8 * hx + 2 * j] = silu_f(g0); gt[8 * hx + 2 * j + 1] = silu_f(g1); }
                    val[8 * hx + 2 * j] = s0; val[8 * hx + 2 * j + 1] = s1; ss += s0 * s0 + s1 * s1; }
            }
            ss += __shfl_xor(ss, 1); ss += __shfl_xor(ss, 2); ss += __shfl_xor(ss, 4);
            const float rstd = rsqrtf(ss * (1.f / 128.f) + EPS);
            unsigned ow[8];
#pragma unroll
            for (int j = 0; j < 8; ++j) { const f32x2 gn = *(const f32x2*)(gain + 2 * j);
                ow[j] = pk2(val[2 * j] * rstd * gn.x * gt[2 * j], val[2 * j + 1] * rstd * gn.y * gt[2 * j + 1]); }
            bf16_t* dst = YAB + (size_t)r * D + br * 1024 + c0;
            *(u32x4*)dst = (u32x4){ow[0], ow[1], ow[2], ow[3]}; *(u32x4*)(dst + 8) = (u32x4){ow[4], ow[5], ow[6], ow[7]};
        }
#pragma unroll
        for (int br = 0; br < 2; ++br)
#pragma unroll
            for (int k = 0; k < 6; ++k) L[br][k] = Ln[br][k];
    }
#undef MP_LOAD
}

__device__ __forceinline__ float reduce16(const float (&p)[16], const int lane) {
    float q8[8], q4[4], q2[2];
#pragma unroll
    for (int i = 0; i < 8; ++i) { const bool hi = (lane & 32) != 0; const float snd = hi ? p[i] : p[i + 8], kp = hi ? p[i + 8] : p[i]; q8[i] = kp + __shfl_xor(snd, 32); }
#pragma unroll
    for (int i = 0; i < 4; ++i) { const bool hi = (lane & 16) != 0; const float snd = hi ? q8[i] : q8[i + 4], kp = hi ? q8[i + 4] : q8[i]; q4[i] = kp + __shfl_xor(snd, 16); }
#pragma unroll
    for (int i = 0; i < 2; ++i) { const bool hi = (lane & 8) != 0; const float snd = hi ? q4[i] : q4[i + 2], kp = hi ? q4[i + 2] : q4[i]; q2[i] = kp + __shfl_xor(snd, 8); }
    float q1; { const bool hi = (lane & 4) != 0; const float snd = hi ? q2[0] : q2[1], kp = hi ? q2[1] : q2[0]; q1 = kp + __shfl_xor(snd, 4); }
    q1 += __shfl_xor(q1, 2); q1 += __shfl_xor(q1, 1);
    return q1;
}
__device__ __forceinline__ void phase_norm2(const Args& a, LAS unsigned char* lds) {
    const int tid = threadIdx.x, lane0 = tid & 63, wave = tid >> 6, G = gridDim.x;
    const modfx_t* MOD = (const modfx_t*)(a.ws + WS_MOD); const bf16_t* X1 = (const bf16_t*)(a.ws + WS_P + P_X1);
    bf16_t* H2 = (bf16_t*)(a.ws + WS_R1 + R1_H2); float* AFF = (float*)(a.ws + WS_AFF);
    LAS float* rw = (LAS float*)lds;
    for (int i = tid; i < D * NE; i += NTHR) { const int c = i >> 4, e = i & 15; rw[e * 2052 + c] = a.router_w[i]; }
    __syncthreads();
    for (int r = blockIdx.x * NWAVES + wave; r < MLAT; r += G * NWAVES) {
        int lane_o = lane0; asm volatile("" : "+v"(lane_o));
        const int lane = lane_o;
        const int b = r >> 12, n = r & 4095;
        f32x4 v[8]; float ss = 0.f;
#pragma unroll
        for (int j = 0; j < 8; ++j) { const u32x2 xw = *(const u32x2*)(X1 + (size_t)r * D + lane * 4 + 256 * j); v[j] = (f32x4){bflo(xw.x), bfhi(xw.x), bflo(xw.y), bfhi(xw.y)}; ss += (v[j].x * v[j].x + v[j].y * v[j].y) + (v[j].z * v[j].z + v[j].w * v[j].w); }
        const float rstd = rsqrtf(wave_sum(ss) * (1.f / D) + EPS);
#pragma unroll
        for (int j = 0; j < 8; ++j) { const int c = lane * 4 + 256 * j;
            const f32x4 nf = *(const f32x4*)(a.norm_ffn + c);
            const f32x4 sh = mod4(MOD, b * 12288 + 3 * D + c) + *(const f32x4*)(a.ada_b + 3 * D + c);
            const f32x4 scl = mod4(MOD, b * 12288 + 4 * D + c) + *(const f32x4*)(a.ada_b + 4 * D + c);
            v[j] = v[j] * rstd * nf * (scl + 1.f) + sh;
            *(unsigned*)((unsigned char*)H2 + (size_t)r * D + c) = pk4_fp8(v[j].x, v[j].y, v[j].z, v[j].w); }
        float p[16];
#pragma unroll
        for (int e = 0; e < 16; ++e) { float s = 0.f;
#pragma unroll
            for (int j = 0; j < 8; ++j) { const f32x4 w4 = *(const LAS f32x4*)(rw + e * 2052 + lane * 4 + 256 * j); s += (v[j].x * w4.x + v[j].y * w4.y) + (v[j].z * w4.z + v[j].w * w4.w); }
            p[e] = s; asm volatile("" ::: "memory"); }
        const float lg = reduce16(p, lane);
        float mx = lg;
#pragma unroll
        for (int o = 4; o < 64; o <<= 1) mx = fmaxf(mx, __shfl_xor(mx, o));
        const float ex = __expf(lg - mx); float den = ex;
#pragma unroll
        for (int o = 4; o < 64; o <<= 1) den += __shfl_xor(den, o);
        if ((lane & 3) == 0) AFF[(size_t)(b * NE + ((lane >> 2) & 15)) * SEQ + n] = ex / den;
    }
}

__device__ __forceinline__ void phase_topk(const Args& a, LAS unsigned char* lds) {
    const int tid = threadIdx.x, lane = tid & 63, wave = tid >> 6;
    const float* AFF = (const float*)(a.ws + WS_AFF); int* IDX = (int*)(a.ws + WS_IDX); float* GATEV = (float*)(a.ws + WS_GATEV); int* INV = (int*)(a.ws + WS_INV);
    LAS unsigned* wc = (LAS unsigned*)lds;
    LAS int* sel = (LAS int*)(lds + 256);
    const unsigned char* H2q = (const unsigned char*)(a.ws + WS_R1 + R1_H2); unsigned char* XS = (unsigned char*)a.out;
    const int nq = (gridDim.x >= 256) ? 4 : 1;
    for (int item = blockIdx.x; item < NB * NE * nq; item += gridDim.x) {
        const int be = item / nq, qtr = item % nq, b = be >> 4, e = be & 15;
        unsigned key[8];
        { const u32x4 k0 = *(const u32x4*)(AFF + (size_t)be * SEQ + tid * 8), k1 = *(const u32x4*)(AFF + (size_t)be * SEQ + tid * 8 + 4);
          key[0] = k0.x; key[1] = k0.y; key[2] = k0.z; key[3] = k0.w; key[4] = k1.x; key[5] = k1.y; key[6] = k1.z; key[7] = k1.w; }
        unsigned prefix = 0u;
        __syncthreads();
        for (int bit = 31; bit >= 0; --bit) {
            const unsigned cand = prefix | (1u << bit);
            unsigned cnt = 0;
#pragma unroll
            for (int i = 0; i < 8; ++i) cnt += (unsigned)__popcll(__ballot(key[i] >= cand));
            if (lane == 0) wc[(bit & 1) * 8 + wave] = cnt;
            __syncthreads();
            unsigned tot = 0;
#pragma unroll
            for (int w = 0; w < 8; ++w) tot += wc[(bit & 1) * 8 + w];
            if (tot >= (unsigned)CAP) prefix = cand;
        }
        const unsigned T = prefix;
        int cgt = 0, ceq = 0;
#pragma unroll
        for (int i = 0; i < 8; ++i) { cgt += key[i] > T; ceq += key[i] == T; }
        int val = cgt | (ceq << 16), inc = val;
#pragma unroll
        for (int o = 1; o < 64; o <<= 1) { const int t = __shfl_up(inc, o); if (lane >= o) inc += t; }
        __syncthreads();
        if (lane == 63) wc[16 + wave] = (unsigned)inc;
        __syncthreads();
        int base = 0, total = 0;
#pragma unroll
        for (int w = 0; w < 8; ++w) { const int t = (int)wc[16 + w]; total += t; if (w < wave) base += t; }
        const int excl = base + inc - val;
        int gt_before = excl & 0xffff, eq_before = excl >> 16;
        const int need = CAP - (total & 0xffff);
#pragma unroll
        for (int i = 0; i < 8; ++i) {
            const int n = tid * 8 + i; int slot = -1;
            if (key[i] > T) { slot = gt_before + (eq_before < need ? eq_before : need); ++gt_before; }
            else if (key[i] == T) { if (eq_before < need) slot = gt_before + eq_before; ++eq_before; }
            if (slot >= 0) { sel[slot] = n; if (qtr == 0) { IDX[be * CAP + slot] = n; GATEV[be * CAP + slot] = __uint_as_float(key[i]); } }
            if (qtr == 0) INV[(size_t)(b * SEQ + n) * NE + e] = slot;
        }
        __syncthreads();
        for (int sl = qtr * (CAP / nq) + wave; sl < (qtr + 1) * (CAP / nq); sl += NWAVES) { const int n = sel[sl];
            const u32x4* src = (const u32x4*)(H2q + (size_t)(b * SEQ + n) * D); u32x4* dst = (u32x4*)(XS + (size_t)(be * CAP + sl) * D);
#pragma unroll
            for (int j = 0; j < 2; ++j) dst[lane + 64 * j] = src[lane + 64 * j]; }
        __syncthreads();
    }
}

__device__ __forceinline__ void phase_gather(const Args& a) {
    const int tid = threadIdx.x, lane = tid & 63, wave = tid >> 6, G = gridDim.x;
    const bf16_t* H2 = (const bf16_t*)(a.ws + WS_R1 + R1_H2); const int* IDX = (const int*)(a.ws + WS_IDX); bf16_t* XS = (bf16_t*)a.out;
    for (int r = blockIdx.x * NWAVES + wave; r < NB * NE * CAP; r += G * NWAVES) {
        const int b = r >> 13; const int n = IDX[r];
        const u32x4* src = (const u32x4*)((const unsigned char*)H2 + (size_t)(b * SEQ + n) * D); u32x4* dst = (u32x4*)((unsigned char*)XS + (size_t)r * D);
#pragma unroll
        for (int j = 0; j < 2; ++j) dst[lane + 64 * j] = src[lane + 64 * j];
    }
}

__device__ __forceinline__ void phase_final(const Args& a) {
    const int tid = threadIdx.x, lane = tid & 63, wave = tid >> 6, G = gridDim.x;
    const modfx_t* MOD = (const modfx_t*)(a.ws + WS_MOD); const bf16_t* X1 = (const bf16_t*)(a.ws + WS_P + P_X1);
    const bf16_t* YE = (const bf16_t*)(a.ws + WS_P + P_WGU); const int* INV = (const int*)(a.ws + WS_INV);
    for (int r = blockIdx.x * NWAVES + wave; r < MLAT; r += G * NWAVES) {
        const int b = r >> 12;
        const int myslot = (lane < 16) ? INV[(size_t)r * NE + lane] : -1;
        u32x2 xw[8];
#pragma unroll
        for (int j = 0; j < 8; ++j) xw[j] = *(const u32x2*)(X1 + (size_t)r * D + lane * 4 + 256 * j);
        f32x4 f[8];
#pragma unroll
        for (int j = 0; j < 8; ++j) f[j] = (f32x4){0.f, 0.f, 0.f, 0.f};
        unsigned long long mask = __ballot(myslot >= 0);
        while (mask) {
            const int e0 = __builtin_ctzll(mask); mask &= mask - 1;
            const int e1 = mask ? __builtin_ctzll(mask) : -1; if (mask) mask &= mask - 1;
            const int s0 = __shfl(myslot, e0), s1 = (e1 >= 0) ? __shfl(myslot, e1) : 0;
            const bf16_t* y0 = YE + ((size_t)(b * NE + e0) * CAP + s0) * D; const bf16_t* y1 = YE + ((size_t)(b * NE + (e1 >= 0 ? e1 : e0)) * CAP + s1) * D;
            u32x2 w0[8], w1[8];
#pragma unroll
            for (int j = 0; j < 8; ++j) { w0[j] = *(const u32x2*)(y0 + lane * 4 + 256 * j); w1[j] = *(const u32x2*)(y1 + lane * 4 + 256 * j); }
            const float k1 = (e1 >= 0) ? 1.f : 0.f;
#pragma unroll
            for (int j = 0; j < 8; ++j) { f[j].x += bflo(w0[j].x) + k1 * bflo(w1[j].x); f[j].y += bfhi(w0[j].x) + k1 * bfhi(w1[j].x); f[j].z += bflo(w0[j].y) + k1 * bflo(w1[j].y); f[j].w += bfhi(w0[j].y) + k1 * bfhi(w1[j].y); }
        }
        float ss = 0.f;
#pragma unroll
        for (int j = 0; j < 8; ++j) { const int c = lane * 4 + 256 * j;
            const f32x4 m5 = mod4(MOD, b * 12288 + 5 * D + c) + *(const f32x4*)(a.ada_b + 5 * D + c);
            f[j] = (f32x4){bflo(xw[j].x), bfhi(xw[j].x), bflo(xw[j].y), bfhi(xw[j].y)} + m5 * f[j];
            ss += (f[j].x * f[j].x + f[j].y * f[j].y) + (f[j].z * f[j].z + f[j].w * f[j].w); }
        const float rstd = rsqrtf(wave_sum(ss) * (1.f / D) + EPS);
#pragma unroll
        for (int j = 0; j < 8; ++j) { const int c = lane * 4 + 256 * j; *(f32x4*)(a.out + (size_t)r * D + c) = f[j] * rstd * *(const f32x4*)(a.final_norm + c); }
    }
}

#define XB_TMO      128
#define XB_XCNT(j)  (256  + 64 * (j))
#define XB_XSUB(j)  (1280 + 64 * (j))
#define XB_XGEN(j)  (2304 + 64 * (j))
#define XB_TOP      3328
#define XB_TOPGEN   3392
#define XCD_BAR_WORDS 3456
#define XB_SPIN_CAP (1u << 18)
__device__ __forceinline__ unsigned xb_ld(unsigned* p)              { return __hip_atomic_load(p, __ATOMIC_RELAXED, __HIP_MEMORY_SCOPE_AGENT); }
__device__ __forceinline__ unsigned xb_add(unsigned* p, unsigned v) { return __hip_atomic_fetch_add(p, v, __ATOMIC_RELAXED, __HIP_MEMORY_SCOPE_AGENT); }
__device__ __forceinline__ unsigned xb_xcc_id() { return (unsigned)__builtin_amdgcn_s_getreg((3 << 11) | 20) & 0xFu; }
#define XB_SPIN(cond, bar) do { unsigned _sp = 0; while (cond) { __builtin_amdgcn_s_sleep(1); \
    if ((++_sp & 255u) == 0u) { if (xb_ld(&(bar)[XB_TMO])) break; if (_sp > XB_SPIN_CAP) { atomicAdd(&(bar)[XB_TMO], 1u); break; } } } } while (0)
struct XcdBarrier { unsigned* bar; unsigned x; volatile LAS unsigned* st; };
__device__ __forceinline__ XcdBarrier xcd_barrier_post(unsigned* bar, volatile LAS unsigned* st) {
    XcdBarrier b; b.bar = bar; b.x = xb_xcc_id(); b.st = st;
    if (threadIdx.x == 0) (void)xb_add(&bar[XB_XCNT(b.x)], 1u);
    return b;
}
__device__ __forceinline__ void xcd_barrier_complete(unsigned* bar, unsigned x, unsigned& nloc, unsigned& nx) {
    const unsigned G = gridDim.x * gridDim.y * gridDim.z;
    unsigned sum, cnt, mine, sp = 0u;
    for (;;) {
        sum = 0u; cnt = 0u; mine = 0u;
#pragma unroll
        for (unsigned j = 0; j < 16; ++j) { const unsigned c = xb_ld(&bar[XB_XCNT(j)]); sum += c; cnt += (c > 0u) ? 1u : 0u; mine = (j == x) ? c : mine; }
        if (sum == G) break;
        __builtin_amdgcn_s_sleep(1);
        if ((++sp & 255u) == 0u) { if (xb_ld(&bar[XB_TMO])) break; if (sp > XB_SPIN_CAP) { atomicAdd(&bar[XB_TMO], 1u); break; } }
    }
    nloc = mine > 0u ? mine : 1u; nx = cnt > 0u ? cnt : 1u;
}
__device__ __forceinline__ void xcd_barrier_at(unsigned* bar_, const XcdBarrier& b) {
    asm volatile("s_waitcnt vmcnt(0)" ::: "memory");
    __syncthreads();
    if (threadIdx.x == 0) {
        unsigned* bar = bar_;
        const unsigned bx = (unsigned)__builtin_amdgcn_readfirstlane((int)xb_xcc_id());
        __builtin_amdgcn_s_waitcnt(0);
        unsigned nloc = b.st[0], nx = b.st[1];
        if (nloc == 0u) { xcd_barrier_complete(bar, bx, nloc, nx); b.st[0] = nloc; b.st[1] = nx; }
        const unsigned old = xb_add(&bar[XB_XSUB(bx)], 1u);
        const unsigned gen = old / nloc;
        if (old + 1u == (gen + 1u) * nloc) {
            __builtin_amdgcn_fence(__ATOMIC_RELEASE, "agent");
            asm volatile("s_waitcnt vmcnt(0)" ::: "memory");
            const unsigned og = xb_add(&bar[XB_TOP], 1u);
            const unsigned tg = og / nx;
            if (og + 1u == (tg + 1u) * nx) xb_add(&bar[XB_TOPGEN], 1u);
            else XB_SPIN(xb_ld(&bar[XB_TOPGEN]) == tg, bar);
            __builtin_amdgcn_fence(__ATOMIC_ACQUIRE, "agent");
            xb_add(&bar[XB_XGEN(bx)], 1u);
            asm volatile("s_waitcnt vmcnt(0)" ::: "memory");
        } else {
            XB_SPIN(xb_ld(&bar[XB_XGEN(bx)]) == gen, bar);
            __builtin_amdgcn_fence(__ATOMIC_ACQUIRE, "agent");
            asm volatile("s_waitcnt vmcnt(0)" ::: "memory");
        }
    }
    __syncthreads();
}

constexpr int NPHASE = 13;
constexpr int ZFILL = 76;
__global__ void __launch_bounds__(NTHR, 2) fwd(Args a) {
    extern __shared__ __attribute__((aligned(16))) unsigned char lds_raw[];
    LAS unsigned char* lds = (LAS unsigned char*)lds_raw;
#if ONE_LAUNCH
    constexpr int lo = 0, hi = NPHASE;
#else
    const int lo = a.ph_lo, hi = a.ph_hi;
#endif
    const int G = gridDim.x, cidx = blockIdx.x;
    unsigned char* ws = a.ws;
    volatile LAS unsigned* bst = (volatile LAS unsigned*)(lds + LDS_BYTES - 16);
    if (threadIdx.x < 4) bst[threadIdx.x] = 0u;
    __syncthreads();
    XcdBarrier xbar = xcd_barrier_post((unsigned*)(ws + WS_BAR), bst);
#ifndef PHASE_MASK
#define PHASE_MASK 0xFFFF
#endif
#define IN(k) (((PHASE_MASK >> (k)) & 1) && lo <= (k) && (k) < hi)
#ifndef REPEAT_MASK
#define REPEAT_MASK 0
#endif
#define REP(k) (1 + ((REPEAT_MASK >> (k)) & 1))
#define SEAM(k) do { if (IN(k) && IN((k) + 1)) { if (gridDim.x > 1024u) cg::this_grid().sync(); else xcd_barrier_at((unsigned*)(a.ws + WS_BAR), xbar); } } while (0)
    if (IN(0)) for (int rep_ = 0; rep_ < REP(0); ++rep_) { if (rep_) cg::this_grid().sync(); phase_prep(a, lds); } SEAM(0);
    if (IN(1)) for (int rep_ = 0; rep_ < REP(1); ++rep_) { if (rep_) cg::this_grid().sync(); phase_norm1(a); } SEAM(1);
    if (IN(2)) for (int rep_ = 0; rep_ < REP(2); ++rep_) { if (rep_) cg::this_grid().sync();
        pg8::SchedTwo S; S.G = G; S.c = cidx;
        S.a.init(MTOT, 29 * 256, 1, 0, ws + WS_R1 + R1_H, ws + WS_R1 + R1_WINT, (size_t)256 * D * 2, (size_t)256 * D * 2, 0, 0, 1); S.na = S.a.nwg;
        S.b.init(MLAT, 4 * 256, 1, 0, ws + WS_R1 + R1_H, ws + WS_R1 + R1_WINT, (size_t)256 * D * 2, (size_t)256 * D * 2, 0, 0, 4);
        S.nextra = (G >= 256) ? ZFILL : 0;
        pg8::EpiP E{(bf16_t*)(ws + WS_P), (float*)(ws + WS_AB), 1.f};
        pg8::gemm_phase<pg8::EpiP, pg8::SchedTwo, false>(lds, D, D, D, S, E);
    } SEAM(2);
    if (IN(3)) for (int rep_ = 0; rep_ < REP(3); ++rep_) { if (rep_) cg::this_grid().sync();
        gdnprep_halo(a); xcd_barrier_at((unsigned*)(a.ws + WS_BAR), xbar); gdnprep_conv(a, lds); xcd_barrier_at((unsigned*)(a.ws + WS_BAR), xbar);
        if (G < 256 || cidx < 128) phase_scan(a, lds);
        if (G >= 256 && cidx < 256 - ZFILL - 128) {
            pg8::SchedPlain S; S.init(MLAT, 4 * 256, 1, 0, ws + WS_R1 + R1_H, ws + WS_R1 + R1_WINT, (size_t)256 * D * 2, (size_t)256 * D * 2, 0, 0, 4);
            S.ubeg = ZFILL + 128 + cidx; S.uend = S.ubeg + 1;
            pg8::EpiP E{(bf16_t*)(ws + WS_P), (float*)(ws + WS_AB), 1.f};
            pg8::gemm_phase<pg8::EpiP, pg8::SchedPlain, false>(lds, D, D, D, S, E);
        }
        if (G < 256 || cidx >= 128) {
            const int Gg = (G < 256) ? G : 128, cg_ = (G < 256) ? cidx : cidx - 128;
            {
                pg8::SchedPlain S; S.init(MLAT, 20 * 256, Gg, cg_, ws + WS_R2 + R2_H8, ws + WS_WIN8, (size_t)256 * D, (size_t)256 * D, 0, 0, 3);
                pg8::EpiP E{(bf16_t*)(ws + WS_P), (float*)(ws + WS_AB), 1.f / W8_SCALE};
                pg8::gemm_phase<pg8::EpiP, pg8::SchedPlain, false, true>(lds, D / 2, D / 2, D / 2, S, E);
            }
            {
                pg8::SchedPlain S; S.init(MLAT, 4 * 256, Gg, cg_, ws + WS_R1 + R1_H, ws + WS_R1 + R1_WINT, (size_t)256 * D * 2, (size_t)256 * D * 2, 0, 0, 4);
                if (G >= 256) { S.ubeg = ZFILL; S.uend = ZFILL + 128; }
                pg8::EpiP E{(bf16_t*)(ws + WS_P), (float*)(ws + WS_AB), 1.f};
                pg8::gemm_phase<pg8::EpiP, pg8::SchedPlain, false>(lds, D, D, D, S, E);
            }
            {
                const int lane = threadIdx.x & 63, wave = threadIdx.x >> 6; LAS float* scr = (LAS float*)(lds + wave * 16384);
                bf16_t* WguT = (bf16_t*)(ws + WS_R2); bf16_t* WdT = (bf16_t*)(ws + WS_R2 + 67108864);
                for (int cv = cg_ * NWAVES + wave; cv < 3 * 16384; cv += Gg * NWAVES) {
                    const int which = cv >> 14, r = cv & 16383, e = r >> 10, q = r & 1023;
                    if (which < 2) { const int kb = q >> 5, nb = q & 31, n0 = nb * 32; const size_t dr = (size_t)e * 2048 + (n0 >> 7) * 256 + (n0 & 127) + which * 128;
                        tr_item((which ? a.w_up : a.w_gate) + (size_t)e * D * DE, DE, kb * 64, n0, WguT, dr, D, 0, scr, lane, true); }
                    else { const int kb = q >> 6, nb = q & 63, n0 = nb * 32;
                        tr_item(a.w_down + (size_t)e * DE * D, D, kb * 64, n0, WdT, (size_t)e * 2048 + n0, DE, 0, scr, lane, true); } }
            }
        }
    } SEAM(3);
    if (IN(4)) for (int rep_ = 0; rep_ < REP(4); ++rep_) { if (rep_) cg::this_grid().sync(); phase_mergeprep(a); } SEAM(4);
    if (IN(5)) for (int rep_ = 0; rep_ < REP(5); ++rep_) { if (rep_) cg::this_grid().sync();
        pg8::SchedPlain S; S.init(MLAT, D, G, cidx, ws + WS_R1 + R1_YAB, ws + WS_WAB, (size_t)256 * D * 2, (size_t)256 * D * 2, 1, (size_t)1024 * 2);
        pg8::EpiMerge E{(const bf16_t*)(ws + WS_P), (bf16_t*)a.out};
        pg8::gemm_phase<pg8::EpiMerge, pg8::SchedPlain, true>(lds, 1024, D, D, S, E);
    } SEAM(5);
    if (IN(6)) for (int rep_ = 0; rep_ < REP(6); ++rep_) { if (rep_) cg::this_grid().sync();
        pg8::SchedPlain S; S.init(MLAT, D, G, cidx, (const void*)a.out, ws + WS_WOUT, (size_t)256 * D * 2, (size_t)256 * D * 2);
        pg8::EpiX1 E{a.x, (const modfx_t*)(ws + WS_MOD), a.ada_b, (bf16_t*)(ws + WS_P + P_X1)};
        pg8::gemm_phase<pg8::EpiX1, pg8::SchedPlain, false>(lds, D, D, D, S, E);
    } SEAM(6);
    if (IN(7)) for (int rep_ = 0; rep_ < REP(7); ++rep_) { if (rep_) cg::this_grid().sync(); phase_norm2(a, lds); } SEAM(7);
    if (IN(8)) for (int rep_ = 0; rep_ < REP(8); ++rep_) { if (rep_) cg::this_grid().sync(); phase_topk(a, lds); } SEAM(8);
    if (IN(9)) for (int rep_ = 0; rep_ < REP(9); ++rep_) { (void)rep_; }
    if (IN(10)) for (int rep_ = 0; rep_ < REP(10); ++rep_) { if (rep_) cg::this_grid().sync();
        pg8::SchedMoe S{G, cidx, (const char*)a.out, (const char*)(ws + WS_R2), (size_t)256 * D, (size_t)256 * D};
        pg8::EpiHact E{(unsigned char*)(ws + WS_P + P_HACT)};
        pg8::gemm_phase<pg8::EpiHact, pg8::SchedMoe, false, true>(lds, D / 2, D / 2, D / 2, S, E);
    } SEAM(10);
    if (IN(11)) for (int rep_ = 0; rep_ < REP(11); ++rep_) { if (rep_) cg::this_grid().sync();
        pg8::SchedMoe S{G, cidx, (const char*)(ws + WS_P + P_HACT), (const char*)(ws + WS_R2 + 67108864), (size_t)256 * DE, (size_t)256 * DE};
        pg8::EpiYE E{(const float*)(ws + WS_GATEV), (bf16_t*)(ws + WS_P + P_WGU)};
        pg8::gemm_phase<pg8::EpiYE, pg8::SchedMoe, false, true>(lds, DE / 2, DE / 2, DE / 2, S, E);
    } SEAM(11);
    if (IN(12)) for (int rep_ = 0; rep_ < REP(12); ++rep_) { if (rep_) cg::this_grid().sync(); phase_final(a); }
#undef IN
#undef SEAM
}

extern "C" void kernel_launch(void* const* d_in, const int* in_sizes, int n_in, void* d_out, int out_size, void* d_ws, size_t ws_size, hipStream_t stream) {
    static int grid = 0;
    if (grid == 0) {
        if (n_in != 23 || out_size != MLAT * D || ws_size < WS_END) { fprintf(stderr, "kernel_launch: unexpected shapes: n_in %d out %d ws %zu (need %zu)\n", n_in, out_size, ws_size, (size_t)WS_END); grid = -1; return; }
        int dev = 0, cus = 0, per_cu = 0;
        if (hipGetDevice(&dev) != hipSuccess || hipDeviceGetAttribute(&cus, hipDeviceAttributeMultiprocessorCount, dev) != hipSuccess) { grid = -1; return; }
        if (hipFuncSetAttribute((const void*)fwd, hipFuncAttributeMaxDynamicSharedMemorySize, LDS_BYTES) != hipSuccess) { fprintf(stderr, "kernel_launch: hipFuncSetAttribute failed\n"); grid = -1; return; }
        if (hipOccupancyMaxActiveBlocksPerMultiprocessor(&per_cu, (const void*)fwd, NTHR, LDS_BYTES) != hipSuccess || per_cu < 1) { fprintf(stderr, "kernel_launch: occupancy query says %d\n", per_cu); per_cu = 1; }
        (void)hipGetLastError();
        grid = cus;
    }
    if (grid < 0) return;
    Args a{};
    a.x = (const float*)d_in[0]; a.c = (const float*)d_in[1]; a.ctx = (const float*)d_in[2]; a.c_ctx = (const float*)d_in[3]; a.ada_w = (const float*)d_in[4]; a.ada_b = (const float*)d_in[5];
    a.norm_mix = (const float*)d_in[6]; a.norm_ffn = (const float*)d_in[7]; a.w_in = (const float*)d_in[8]; a.gdn_conv = (const float*)d_in[9]; a.a_log = (const float*)d_in[10]; a.dt_bias = (const float*)d_in[11];
    a.hgrn_lb = (const float*)d_in[12]; a.hgrn_norm = (const float*)d_in[13]; a.gdn_norm = (const float*)d_in[14]; a.w_ba = (const float*)d_in[15]; a.w_bb = (const float*)d_in[16]; a.w_out = (const float*)d_in[17];
    a.router_w = (const float*)d_in[18]; a.w_gate = (const float*)d_in[19]; a.w_up = (const float*)d_in[20]; a.w_down = (const float*)d_in[21]; a.final_norm = (const float*)d_in[22];
    a.out = (float*)d_out; a.ws = (unsigned char*)d_ws;
    (void)hipMemsetAsync((char*)d_ws + WS_BAR, 0, 16384 + 245760, stream);
#if ONE_LAUNCH
    a.ph_lo = 0; a.ph_hi = NPHASE;
    void* args[] = {&a};
    hipError_t e = hipLaunchCooperativeKernel((const void*)fwd, dim3(grid), dim3(NTHR), args, LDS_BYTES, stream);
    if (e != hipSuccess) fprintf(stderr, "kernel_launch: cooperative launch failed: %s (grid %d)\n", hipGetErrorString(e), grid);
#else
    for (int p = 0; p < NPHASE; ++p) { a.ph_lo = p; a.ph_hi = p + 1; hipLaunchKernelGGL(fwd, dim3(grid), dim3(NTHR), LDS_BYTES, stream, a); }
#endif
}
```

```cpp
#include <hip/hip_runtime.h>
#include <hip/hip_cooperative_groups.h>
#include <cstdio>
#include <cstdint>
namespace cg = cooperative_groups;

#ifndef ONE_LAUNCH
#define ONE_LAUNCH 1
#endif

#define LAS __attribute__((address_space(3)))
typedef unsigned short bf16_t;
typedef short bf16x8 __attribute__((ext_vector_type(8)));
typedef float f32x4 __attribute__((ext_vector_type(4)));
typedef float f32x2 __attribute__((ext_vector_type(2)));
typedef unsigned u32x4 __attribute__((ext_vector_type(4)));
typedef unsigned u32x2 __attribute__((ext_vector_type(2)));

constexpr int D = 2048, NB = 4, SEQ = 4096, CTXL = 256;
constexpr int MLAT = NB * SEQ, MCTX = NB * CTXL, MTOT = MLAT + MCTX;
constexpr int NIN = 13344, NPW = 13568, PC = 13312;
constexpr int C_HQ = 0, C_FF = 1024, C_FB = 2048, C_HI = 3072, C_OG = 4096, C_GQ = 5120, C_GK = 6144, C_GV = 7168, C_Z = 8192, C_GA = 9216, C_GB = 11264;
constexpr int NE = 16, CAP = 512, DE = 1024;
constexpr float EPS = 1e-6f;
constexpr int NTHR = 512, NWAVES = 8;
constexpr int LDS_BYTES = 147456;

constexpr size_t WS_BAR = 0;
constexpr size_t WS_MOD = 16384;
constexpr size_t WS_AFF = WS_MOD + 245760;
constexpr size_t WS_IDX = WS_AFF + 1048576;
constexpr size_t WS_GATEV = WS_IDX + 131072;
constexpr size_t WS_INV = WS_GATEV + 131072;
constexpr size_t WS_AB = WS_INV + 1048576;
constexpr size_t WS_WAB = WS_AB + 2228224;
constexpr size_t WS_WOUT = WS_WAB + 8388608;
constexpr size_t WS_R1 = WS_WOUT + 8388608;
constexpr size_t WS_R2 = WS_R1 + 126877696;
constexpr size_t WS_P = WS_R2 + 134217728;
constexpr size_t WS_HALO = WS_P + 463470592;
constexpr size_t WS_WIN8 = WS_HALO + 6684672;
constexpr size_t WS_END = WS_WIN8 + 10485760;
constexpr size_t R2_H8 = 100663296;
constexpr size_t R1_WINT = 0, R1_H = 55574528, R1_YAB = 0, R1_H2 = 0;
constexpr size_t R2_OAF = 0, R2_OAB = 33554432, R2_OBF = 67108864, R2_OBB = 100663296, R2_T = 0, R2_XS = 0, R2_YE = 0;
constexpr size_t P_X1 = 0, P_WGU = 134217728, P_WD = 268435456, P_HACT = 335544320;

struct Args {
    const float *x, *c, *ctx, *c_ctx, *ada_w, *ada_b, *norm_mix, *norm_ffn, *w_in, *gdn_conv, *a_log, *dt_bias, *hgrn_lb, *hgrn_norm, *gdn_norm,
        *w_ba, *w_bb, *w_out, *router_w, *w_gate, *w_up, *w_down, *final_norm;
    float* out; unsigned char* ws; int ph_lo, ph_hi;
};

__device__ __forceinline__ float bf2f(unsigned short b) { return __uint_as_float(((unsigned)b) << 16); }
__device__ __forceinline__ float bflo(unsigned w) { return __uint_as_float(w << 16); }
__device__ __forceinline__ float bfhi(unsigned w) { return __uint_as_float(w & 0xffff0000u); }
typedef __bf16 bf16x2v __attribute__((ext_vector_type(2)));
__device__ __forceinline__ unsigned pk2(float lo, float hi) { const f32x2 v = {lo, hi}; const bf16x2v b = __builtin_convertvector(v, bf16x2v); return __builtin_bit_cast(unsigned, b); }
__device__ __forceinline__ unsigned f2bf(float f) { return pk2(f, f) & 0xffffu; }
__device__ __forceinline__ float rcp_f(float x) { return __builtin_amdgcn_rcpf(x); }
__device__ __forceinline__ float sigmoid_f(float x) { return __builtin_amdgcn_rcpf(1.f + __builtin_amdgcn_exp2f(-1.4426950408889634f * x)); }
__device__ __forceinline__ float silu_f(float x) { return x * sigmoid_f(x); }
__device__ __forceinline__ float softplus_f(float x) { return x > 20.f ? x : log1pf(__expf(x)); }
__device__ __forceinline__ float wave_sum(float v) {
#pragma unroll
    for (int o = 1; o < 64; o <<= 1) v += __shfl_xor(v, o);
    return v;
}
#define LDS_WAIT() asm volatile("s_waitcnt lgkmcnt(0)" ::: "memory")
typedef int modfx_t;
typedef int v4i_ __attribute__((ext_vector_type(4)));
__device__ __forceinline__ f32x4 mod4(const modfx_t* M, size_t idx) {
    const v4i_ q = *(const v4i_*)(M + idx); const float sc = 3.725290298461914e-09f;
    return (f32x4){(float)q.x * sc, (float)q.y * sc, (float)q.z * sc, (float)q.w * sc}; }
typedef int v8i __attribute__((ext_vector_type(8)));
typedef int v4i __attribute__((ext_vector_type(4)));
__device__ __forceinline__ unsigned pk4_fp8(float a, float b, float c, float d) { unsigned w = 0u; w = (unsigned)__builtin_amdgcn_cvt_pk_fp8_f32(a, b, (int)w, false); w = (unsigned)__builtin_amdgcn_cvt_pk_fp8_f32(c, d, (int)w, true); return w; }
constexpr float W8_SCALE = 64.f;

namespace pg8 {
constexpr int BM = 256, BK = 64, HALF = 128, HTB = HALF * BK * 2, STAGE_BYTES = 8 * HTB, NXCD = 8, WGM = 8;
__device__ __forceinline__ int lds_byte(int r, int c) { const int st = (r >> 4) * 2 + (c >> 5), rr = r & 15, cc = c & 31, ob = rr * 64 + cc * 2; return st * 1024 + (ob ^ (((ob >> 9) & 1) << 5)); }
__device__ __forceinline__ void stage_rc(int b, int& R, int& C) { const int st = b / 1024, sb = b % 1024, swz = sb ^ (((sb >> 9) & 1) << 5); R = (st >> 1) * 16 + swz / 64; C = (st & 1) * 32 + (swz % 64) / 2; }
__device__ __forceinline__ int perm32(int rho) { const int n = rho >> 4, i = rho & 15; return 8 * (i >> 2) + 4 * n + (i & 3); }
struct Unit { int pm, pn; const char* A; const char* B; int half; };
__device__ __forceinline__ unsigned cvt_pk_bf16(float lo, float hi) { unsigned r; asm volatile("v_cvt_pk_bf16_f32 %0, %1, %2" : "=v"(r) : "v"(lo), "v"(hi)); return r; }

struct SchedPlain {
    int nM, nN, nwg, G, c; const char* A; const char* B; size_t tA, tB; int pair; size_t hoff; int remap; int ubeg, uend;
    __device__ __forceinline__ void init(int M, int N, int G_, int c_, const void* A_, const void* B_, size_t tA_, size_t tB_, int pair_ = 0, size_t hoff_ = 0, int remap_ = 0) { nM = M / BM; nN = N / BM; nwg = nM * nN; G = G_; c = c_; A = (const char*)A_; B = (const char*)B_; tA = tA_; tB = tB_; pair = pair_; hoff = hoff_; remap = remap_; ubeg = 0; uend = nwg; }
    __device__ __forceinline__ bool next(int i, Unit& u) const {
        const int hf = pair ? (i & 1) : 1; if (pair) i >>= 1;
        const long L = (long)ubeg + (long)i * G + c; if (L >= uend) return false;
        int wgid = (int)L; { const int q = nwg / NXCD, r = nwg % NXCD, xcd = wgid % NXCD, off = wgid / NXCD; wgid = (xcd < r ? xcd * (q + 1) : r * (q + 1) + (xcd - r) * q) + off; }
        const int nig = WGM * nN, gid = wgid / nig, fm = gid * WGM, gsz = (nM - fm) < WGM ? (nM - fm) : WGM;
        u.pm = fm + ((wgid % nig) % gsz); u.pn = (wgid % nig) / gsz; u.half = hf;
        const int pnd = u.pn;
        if (remap == 1) u.pn = (u.pn < 16) ? u.pn : (u.pn < 28 ? u.pn + 4 : 52);
        else if (remap == 2) u.pn = (u.pn < 4) ? 16 + u.pn : 28 + u.pn;
        else if (remap == 3) u.pn = (u.pn < 4) ? 16 + u.pn : 32 + u.pn;
        else if (remap == 4) u.pn = 32 + u.pn;
        const size_t ho = (pair && hf) ? hoff : 0; u.A = A + (size_t)u.pm * tA + ho; u.B = B + (size_t)(remap == 3 ? pnd : u.pn) * tB + ho; return true;
    }
};
struct SchedTwo {
    SchedPlain a, b; int na, nextra, G, c;
    __device__ __forceinline__ bool next(int i, Unit& u) const {
        const long L = (long)i * G + c;
        if (L < na) { SchedPlain t = a; t.G = 1; t.c = 0; t.ubeg = (int)L; t.uend = (int)L + 1; return t.next(0, u); }
        if (L < na + nextra) { SchedPlain t = b; t.G = 1; t.c = 0; t.ubeg = (int)(L - na); t.uend = t.ubeg + 1; return t.next(0, u); }
        return false;
    }
};
struct SchedMoe {
    int G, c; const char* A; const char* B; size_t tA, tB;
    __device__ __forceinline__ bool next(int i, Unit& u) const {
        const long L = (long)i * G + c; if (L >= 1024) return false;
        const int e = (int)L >> 6, r = (int)L & 63, pn = r >> 3, q = r & 7, b = q >> 1, hf = q & 1;
        u.pm = (b * 16 + e) * 2 + hf; u.pn = pn; u.half = 1; u.A = A + (size_t)u.pm * tA; u.B = B + (size_t)(e * 8 + pn) * tB; return true;
    }
};

template <class Epi, class Sched, bool MID, bool F8 = false>
__device__ __forceinline__ void gemm_phase(LAS unsigned char* lds, const int K, const int lda, const int ldb, const Sched& S, const Epi& E) {
    int tid = threadIdx.x; asm volatile("" : "+v"(tid));
    const int wid = __builtin_amdgcn_readfirstlane(tid >> 6), lane = tid & 63, wr = wid >> 2, wc = wid & 3, fr = lane & 15, fq = lane >> 4;
    const int nt = K / BK;
    unsigned voffA[2], voffB[2];
#pragma unroll
    for (int i = 0; i < 2; ++i) { int R, C; stage_rc(tid * 16 + i * 8192, R, C); const int Rb = Epi::PERM ? ((R & ~31) + perm32(R & 31)) : R;
        voffA[i] = (unsigned)(R * lda + C) * 2u; voffB[i] = (unsigned)(Rb * ldb + C) * 2u; }
    const size_t kstep = (size_t)(BK * 2);
    const size_t hstepA = (size_t)HALF * lda * 2, hstepB = (size_t)HALF * ldb * 2;
    const unsigned ldsw = (unsigned)wid * 1024u;
    const int aoff = F8 ? lds_byte(wr * 64 + fr, 32 * (fq >> 1) + 16 * (fq & 1)) : lds_byte(wr * 64 + fr, fq * 8), boff = F8 ? lds_byte(wc * 32 + fr, 32 * (fq >> 1) + 16 * (fq & 1)) : lds_byte(wc * 32 + fr, fq * 8);
#define PG8_SA(b, h) (((b) * 2 + (h)) * HTB)
#define PG8_SB(b, h) ((4 + (b) * 2 + (h)) * HTB)
#define PG8_STAGE(bufoff, gbase, voff) do { _Pragma("unroll") for (int _i = 0; _i < 2; ++_i) \
        __builtin_amdgcn_global_load_lds((const unsigned*)((const char*)(gbase) + (voff)[_i]), (LAS unsigned*)(lds + (bufoff) + ldsw + _i * 8192), 16, 0, 0); } while (0)
#define PG8_LDA(dst, b, h) do { if constexpr (F8) { _Pragma("unroll") for (int m = 0; m < 4; ++m) { const v4i lo_ = *(const LAS v4i*)(lds + PG8_SA(b, h) + aoff + m * 2048), hi_ = *(const LAS v4i*)(lds + PG8_SA(b, h) + aoff + m * 2048 + 16); \
            dst##8[m] = __builtin_shufflevector(lo_, hi_, 0, 1, 2, 3, 4, 5, 6, 7); } } \
        else { _Pragma("unroll") for (int m = 0; m < 4; ++m) _Pragma("unroll") for (int k = 0; k < 2; ++k) dst[m][k] = *(const LAS bf16x8*)(lds + PG8_SA(b, h) + aoff + m * 2048 + k * 1024); } } while (0)
#define PG8_LDB(dst, b, h) do { if constexpr (F8) { _Pragma("unroll") for (int n = 0; n < 2; ++n) { const v4i lo_ = *(const LAS v4i*)(lds + PG8_SB(b, h) + boff + n * 2048), hi_ = *(const LAS v4i*)(lds + PG8_SB(b, h) + boff + n * 2048 + 16); \
            dst##8[n] = __builtin_shufflevector(lo_, hi_, 0, 1, 2, 3, 4, 5, 6, 7); } } \
        else { _Pragma("unroll") for (int n = 0; n < 2; ++n) _Pragma("unroll") for (int k = 0; k < 2; ++k) dst[n][k] = *(const LAS bf16x8*)(lds + PG8_SB(b, h) + boff + n * 2048 + k * 1024); } } while (0)
#define PG8_MMA(ai, bj, At, Bt) do { __builtin_amdgcn_s_setprio(1); if constexpr (F8) { _Pragma("unroll") for (int m = 0; m < 4; ++m) _Pragma("unroll") for (int n = 0; n < 2; ++n) \
        asm volatile("v_mfma_scale_f32_16x16x128_f8f6f4 %0, %1, %2, %0, %3, %3 op_sel_hi:[0,0,0]" : "+v"(acc[ai][bj][m][n]) : "v"(Bt##8[n]), "v"(At##8[m]), "v"(sc8)); } \
        else { _Pragma("unroll") for (int m = 0; m < 4; ++m) _Pragma("unroll") for (int n = 0; n < 2; ++n) _Pragma("unroll") for (int k = 0; k < 2; ++k) \
        acc[ai][bj][m][n] = __builtin_amdgcn_mfma_f32_16x16x32_bf16(Bt[n][k], At[m][k], acc[ai][bj][m][n], 0, 0, 0); } __builtin_amdgcn_s_setprio(0); } while (0)
#define PG8_WAIT_V(n) asm volatile("s_waitcnt vmcnt(" #n ")" ::: "memory")
#define PG8_WAIT_L(n) asm volatile("s_waitcnt lgkmcnt(" #n ")" ::: "memory")
#define PG8_BAR __builtin_amdgcn_s_barrier()
#define PG8_SCHED __builtin_amdgcn_sched_barrier(0)
    Unit cur, nxt; int ui = 0;
    if (!S.next(0, cur)) return;
    f32x4 acc[2][2][4][2];
#pragma unroll
    for (int a = 0; a < 2; ++a)
#pragma unroll
        for (int b = 0; b < 2; ++b)
#pragma unroll
            for (int m = 0; m < 4; ++m)
#pragma unroll
                for (int n = 0; n < 2; ++n) acc[a][b][m][n] = (f32x4){0.f, 0.f, 0.f, 0.f};
    bf16x8 At[4][2], B0[2][2], B1[2][2]; v8i At8[4], B08[2], B18[2]; const int sc8 = 0x7F7F7F7F;
    const char* cA = cur.A; const char* cB = cur.B;
    PG8_STAGE(PG8_SB(0, 0), cB, voffB); PG8_STAGE(PG8_SB(0, 1), cB + hstepB, voffB); PG8_STAGE(PG8_SA(0, 0), cA, voffA); PG8_STAGE(PG8_SA(0, 1), cA + hstepA, voffA);
    if (wr == 1) PG8_BAR;
    PG8_WAIT_V(2); PG8_BAR;
    PG8_STAGE(PG8_SB(1, 0), cB + kstep, voffB); PG8_STAGE(PG8_SA(1, 0), cA + kstep, voffA); PG8_STAGE(PG8_SB(1, 1), cB + hstepB + kstep, voffB);
    PG8_WAIT_V(6); PG8_BAR;
    for (;;) {
        const bool has_next = S.next(ui + 1, nxt);
        const char* nA = has_next ? nxt.A : cA; const char* nB = has_next ? nxt.B : cB;
#pragma unroll 1
        for (int t = 0; t < nt; t += 2) {
            const bool last = (t == nt - 2);
            const char* a1 = cA + (size_t)(t + 1) * kstep;
            const char* a2 = last ? nA : cA + (size_t)(t + 2) * kstep; const char* b2 = last ? nB : cB + (size_t)(t + 2) * kstep;
            const char* a3 = a2 + kstep; const char* b3 = b2 + kstep;
            PG8_LDB(B0, 0, 0); PG8_LDB(B1, 0, 1); PG8_SCHED; PG8_LDA(At, 0, 0); PG8_STAGE(PG8_SA(1, 1), a1 + hstepA, voffA);
            PG8_WAIT_V(8); PG8_WAIT_L(0); PG8_BAR; PG8_MMA(0, 0, At, B0); PG8_MMA(0, 1, At, B1); PG8_BAR; PG8_SCHED;
            PG8_LDA(At, 0, 1); PG8_STAGE(PG8_SB(0, 0), b2, voffB); PG8_STAGE(PG8_SB(0, 1), b2 + hstepB, voffB); PG8_STAGE(PG8_SA(0, 0), a2, voffA);
            PG8_WAIT_V(8); PG8_WAIT_L(0); PG8_BAR; PG8_MMA(1, 0, At, B0); PG8_MMA(1, 1, At, B1); PG8_BAR; PG8_SCHED;
            PG8_LDB(B0, 1, 0); PG8_LDB(B1, 1, 1); PG8_SCHED; PG8_LDA(At, 1, 0); PG8_STAGE(PG8_SA(0, 1), a2 + hstepA, voffA);
            PG8_WAIT_V(8); PG8_WAIT_L(0); PG8_BAR; PG8_MMA(0, 0, At, B0); PG8_MMA(0, 1, At, B1); PG8_BAR; PG8_SCHED;
            PG8_LDA(At, 1, 1); PG8_STAGE(PG8_SB(1, 0), b3, voffB); PG8_STAGE(PG8_SB(1, 1), b3 + hstepB, voffB); PG8_STAGE(PG8_SA(1, 0), a3, voffA);
            PG8_WAIT_V(8); PG8_WAIT_L(0); PG8_BAR; PG8_MMA(1, 0, At, B0); PG8_MMA(1, 1, At, B1); PG8_BAR; PG8_SCHED;
        }
        if (wr == 0) PG8_BAR;
        if constexpr (F8) asm volatile("s_nop 15\n\ts_nop 15" ::: "memory");
        bool fin = true;
        int fr_e = fr, fq_e = fq; asm volatile("" : "+v"(fr_e), "+v"(fq_e));
        if constexpr (MID) { fin = (cur.half != 0); if (!fin) E.mid(acc, cur, wr, wc, fr_e, fq_e); }
        if (fin) E(acc, cur, wr, wc, fr_e, fq_e);
        if (!has_next) break;
        if (fin) {
#pragma unroll
        for (int a = 0; a < 2; ++a)
#pragma unroll
            for (int b = 0; b < 2; ++b)
#pragma unroll
                for (int m = 0; m < 4; ++m)
#pragma unroll
                    for (int n = 0; n < 2; ++n) acc[a][b][m][n] = (f32x4){0.f, 0.f, 0.f, 0.f};
        }
        cur = nxt; cA = nA; cB = nB; ++ui;
        if (wr == 1) PG8_BAR;
    }
    PG8_WAIT_V(0);
    PG8_BAR;
#undef PG8_SA
#undef PG8_SB
#undef PG8_STAGE
#undef PG8_LDA
#undef PG8_LDB
#undef PG8_MMA
#undef PG8_WAIT_V
#undef PG8_WAIT_L
#undef PG8_BAR
#undef PG8_SCHED
}

struct EpiP {
    static constexpr bool PERM = true;
    bf16_t* P; float* AB; float osc;
    __device__ __forceinline__ void operator()(const f32x4 (&acc)[2][2][4][2], const Unit& u, int wr, int wc, int fr, int fq) const {
        const int row0 = u.pm * BM + wr * 64 + fr;
        if (u.pn < 52) {
            const int col0 = u.pn * BM + wc * 32 + 8 * fq;
#pragma unroll
            for (int ai = 0; ai < 2; ++ai)
#pragma unroll
                for (int m = 0; m < 4; ++m) { bf16_t* rowp = P + (size_t)(row0 + ai * HALF + m * 16) * PC + col0;
#pragma unroll
                    for (int bj = 0; bj < 2; ++bj) { const f32x4 v0 = acc[ai][bj][m][0] * osc, v1 = acc[ai][bj][m][1] * osc;
                        u32x4 w; w.x = cvt_pk_bf16(v0[0], v0[1]); w.y = cvt_pk_bf16(v0[2], v0[3]); w.z = cvt_pk_bf16(v1[0], v1[1]); w.w = cvt_pk_bf16(v1[2], v1[3]);
                        *(u32x4*)(rowp + bj * HALF) = w; } }
        } else if (wc == 0) {
#pragma unroll
            for (int ai = 0; ai < 2; ++ai)
#pragma unroll
                for (int m = 0; m < 4; ++m) { float* rp = AB + (size_t)(row0 + ai * HALF + m * 16) * 32 + 8 * fq;
                    *(f32x4*)rp = acc[ai][0][m][0]; *(f32x4*)(rp + 4) = acc[ai][0][m][1]; }
        }
    }
};
struct EpiMerge {
    static constexpr bool PERM = true;
    const bf16_t* P; bf16_t* T;
    __device__ __forceinline__ void mid(f32x4 (&acc)[2][2][4][2], const Unit& u, int wr, int wc, int fr, int fq) const {
        const bf16_t* base = P + (size_t)(u.pm * BM + wr * 64 + fr) * PC + (u.pn * BM + wc * 32 + 8 * fq);
#pragma unroll
        for (int ai = 0; ai < 2; ++ai) {
            u32x4 xa[4][2], xb[4][2];
#pragma unroll
            for (int m = 0; m < 4; ++m)
#pragma unroll
                for (int bj = 0; bj < 2; ++bj) { const bf16_t* rowp = base + (size_t)(ai * HALF + m * 16) * PC + bj * HALF; xa[m][bj] = *(const u32x4*)(rowp + C_GA); xb[m][bj] = *(const u32x4*)(rowp + C_GB); }
#pragma unroll
            for (int m = 0; m < 4; ++m)
#pragma unroll
                for (int bj = 0; bj < 2; ++bj) {
                    const unsigned wa[4] = {xa[m][bj].x, xa[m][bj].y, xa[m][bj].z, xa[m][bj].w}, wb[4] = {xb[m][bj].x, xb[m][bj].y, xb[m][bj].z, xb[m][bj].w};
#pragma unroll
                    for (int j = 0; j < 4; ++j) {
                        const float r0 = (1.f + __expf(-bflo(wb[j]))) * __builtin_amdgcn_rcpf(1.f + __expf(-bflo(wa[j]))), r1 = (1.f + __expf(-bfhi(wb[j]))) * __builtin_amdgcn_rcpf(1.f + __expf(-bfhi(wa[j])));
                        acc[ai][bj][m][j >> 1][(j & 1) * 2] *= r0; acc[ai][bj][m][j >> 1][(j & 1) * 2 + 1] *= r1; } }
            asm volatile("" ::: "memory"); }
    }
    __device__ __forceinline__ void operator()(const f32x4 (&acc)[2][2][4][2], const Unit& u, int wr, int wc, int fr, int fq) const {
        const int row0 = u.pm * BM + wr * 64 + fr, col0 = u.pn * BM + wc * 32 + 8 * fq;
#pragma unroll
        for (int ai = 0; ai < 2; ++ai) {
            u32x4 xb[4][2];
#pragma unroll
            for (int m = 0; m < 4; ++m)
#pragma unroll
                for (int bj = 0; bj < 2; ++bj) xb[m][bj] = *(const u32x4*)(P + (size_t)(row0 + ai * HALF + m * 16) * PC + col0 + C_GB + bj * HALF);
#pragma unroll
            for (int m = 0; m < 4; ++m) { const size_t row = (size_t)(row0 + ai * HALF + m * 16);
#pragma unroll
                for (int bj = 0; bj < 2; ++bj) {
                    const unsigned wb[4] = {xb[m][bj].x, xb[m][bj].y, xb[m][bj].z, xb[m][bj].w}; float g[8];
#pragma unroll
                    for (int j = 0; j < 4; ++j) { g[2 * j] = sigmoid_f(bflo(wb[j])); g[2 * j + 1] = sigmoid_f(bfhi(wb[j])); }
                    const f32x4 v0 = acc[ai][bj][m][0], v1 = acc[ai][bj][m][1];
                    u32x4 w; w.x = cvt_pk_bf16(v0[0] * g[0], v0[1] * g[1]); w.y = cvt_pk_bf16(v0[2] * g[2], v0[3] * g[3]); w.z = cvt_pk_bf16(v1[0] * g[4], v1[1] * g[5]); w.w = cvt_pk_bf16(v1[2] * g[6], v1[3] * g[7]);
                    *(u32x4*)(T + row * D + col0 + bj * HALF) = w; } }
            asm volatile("" ::: "memory"); }
    }
};
struct EpiX1 {
    static constexpr bool PERM = false;
    const float* x; const modfx_t* mod; const float* ada_b; bf16_t* X1;
    __device__ __forceinline__ void operator()(const f32x4 (&acc)[2][2][4][2], const Unit& u, int wr, int wc, int fr, int fq) const {
        const int row0 = u.pm * BM + wr * 64 + fr, col0 = u.pn * BM + wc * 32 + 4 * fq, b = u.pm >> 4;
        f32x4 mv[2][2];
#pragma unroll
        for (int bj = 0; bj < 2; ++bj)
#pragma unroll
            for (int n = 0; n < 2; ++n) { const int c = col0 + bj * HALF + n * 16; mv[bj][n] = mod4(mod, (size_t)b * 12288 + 2 * D + c) + *(const f32x4*)(ada_b + 2 * D + c); }
#pragma unroll
        for (int ai = 0; ai < 2; ++ai) {
            f32x4 xi[4][2][2];
#pragma unroll
            for (int m = 0; m < 4; ++m)
#pragma unroll
                for (int bj = 0; bj < 2; ++bj)
#pragma unroll
                    for (int n = 0; n < 2; ++n) xi[m][bj][n] = *(const f32x4*)(x + (size_t)(row0 + ai * HALF + m * 16) * D + col0 + bj * HALF + n * 16);
#pragma unroll
            for (int m = 0; m < 4; ++m) { const size_t off = (size_t)(row0 + ai * HALF + m * 16) * D + col0;
#pragma unroll
                for (int bj = 0; bj < 2; ++bj)
#pragma unroll
                    for (int n = 0; n < 2; ++n) { const f32x4 o = xi[m][bj][n] + mv[bj][n] * acc[ai][bj][m][n];
                        *(u32x2*)(X1 + off + bj * HALF + n * 16) = (u32x2){cvt_pk_bf16(o[0], o[1]), cvt_pk_bf16(o[2], o[3])}; } }
            asm volatile("" ::: "memory"); }
    }
};
struct EpiHact {
    static constexpr bool PERM = true;
    unsigned char* H;
    __device__ __forceinline__ void operator()(const f32x4 (&acc)[2][2][4][2], const Unit& u, int wr, int wc, int fr, int fq) const {
        const int row0 = u.pm * BM + wr * 64 + fr, col0 = u.pn * HALF + wc * 32 + 8 * fq;
#pragma unroll
        for (int ai = 0; ai < 2; ++ai)
#pragma unroll
            for (int m = 0; m < 4; ++m) { const f32x4 a0 = acc[ai][0][m][0] * (1.f / W8_SCALE), a1 = acc[ai][0][m][1] * (1.f / W8_SCALE), u0 = acc[ai][1][m][0] * (1.f / W8_SCALE), u1 = acc[ai][1][m][1] * (1.f / W8_SCALE);
                u32x2 w; w.x = pk4_fp8(silu_f(a0[0]) * u0[0], silu_f(a0[1]) * u0[1], silu_f(a0[2]) * u0[2], silu_f(a0[3]) * u0[3]);
                w.y = pk4_fp8(silu_f(a1[0]) * u1[0], silu_f(a1[1]) * u1[1], silu_f(a1[2]) * u1[2], silu_f(a1[3]) * u1[3]);
                *(u32x2*)(H + (size_t)(row0 + ai * HALF + m * 16) * DE + col0) = w; }
    }
};
struct EpiYE {
    static constexpr bool PERM = true;
    const float* gatev; bf16_t* Y;
    __device__ __forceinline__ void operator()(const f32x4 (&acc)[2][2][4][2], const Unit& u, int wr, int wc, int fr, int fq) const {
        const int row0 = u.pm * BM + wr * 64 + fr, col0 = u.pn * BM + wc * 32 + 8 * fq;
        float g[2][4];
#pragma unroll
        for (int ai = 0; ai < 2; ++ai)
#pragma unroll
            for (int m = 0; m < 4; ++m) g[ai][m] = gatev[row0 + ai * HALF + m * 16] * (1.f / W8_SCALE);
#pragma unroll
        for (int ai = 0; ai < 2; ++ai)
#pragma unroll
            for (int m = 0; m < 4; ++m) { const int row = row0 + ai * HALF + m * 16;
#pragma unroll
                for (int bj = 0; bj < 2; ++bj) { const f32x4 v0 = acc[ai][bj][m][0] * g[ai][m], v1 = acc[ai][bj][m][1] * g[ai][m];
                    u32x4 w; w.x = cvt_pk_bf16(v0[0], v0[1]); w.y = cvt_pk_bf16(v0[2], v0[3]); w.z = cvt_pk_bf16(v1[0], v1[1]); w.w = cvt_pk_bf16(v1[2], v1[3]);
                    *(u32x4*)(Y + (size_t)row * D + col0 + bj * HALF) = w; } }
    }
};
}

__device__ __forceinline__ void tr_item(const float* W, int ldw, int k0, int n0, bf16_t* WT, size_t dst_row, int ldk, int koff, LAS float* scr, int lane, const bool f8 = false) {
    f32x4 v[8];
#pragma unroll
    for (int i = 0; i < 8; ++i) v[i] = *(const f32x4*)(W + (size_t)(k0 + 8 * i + (lane >> 3)) * ldw + n0 + (lane & 7) * 4);
#pragma unroll
    for (int i = 0; i < 8; ++i) { LAS float* p = scr + (8 * i + (lane >> 3)) * 33 + (lane & 7) * 4; p[0] = v[i].x; p[1] = v[i].y; p[2] = v[i].z; p[3] = v[i].w; }
    LDS_WAIT(); asm volatile("" ::: "memory");
    const int c = lane & 7;
    if (!f8) {
#pragma unroll
    for (int j = 0; j < 4; ++j) { const int n = (lane >> 3) + 8 * j; const LAS float* s = scr + (8 * c) * 33 + n;
        u32x4 o; o.x = pk2(s[0 * 33], s[1 * 33]); o.y = pk2(s[2 * 33], s[3 * 33]); o.z = pk2(s[4 * 33], s[5 * 33]); o.w = pk2(s[6 * 33], s[7 * 33]);
        *(u32x4*)(WT + (dst_row + n) * (size_t)ldk + koff + k0 + 8 * c) = o; }
    } else {
#pragma unroll
    for (int j = 0; j < 4; ++j) { const int n = (lane >> 3) + 8 * j; const LAS float* s = scr + (8 * c) * 33 + n;
        u32x2 o; o.x = pk4_fp8(s[0 * 33] * W8_SCALE, s[1 * 33] * W8_SCALE, s[2 * 33] * W8_SCALE, s[3 * 33] * W8_SCALE); o.y = pk4_fp8(s[4 * 33] * W8_SCALE, s[5 * 33] * W8_SCALE, s[6 * 33] * W8_SCALE, s[7 * 33] * W8_SCALE);
        *(u32x2*)((unsigned char*)WT + (dst_row + n) * (size_t)ldk + koff + k0 + 8 * c) = o; }
    }
    LDS_WAIT(); asm volatile("" ::: "memory");
}

__device__ __forceinline__ void phase_prep(const Args& a, LAS unsigned char* lds) {
    const int tid = threadIdx.x, lane = tid & 63, wave = tid >> 6, G = gridDim.x;
    int* MOD = (int*)(a.ws + WS_MOD);
    LAS float* sc = (LAS float*)lds;
    for (int it = blockIdx.x; it < 256; it += G) {
        const int ks = it >> 3, cb = it & 7, k0 = ks * 64;
        __syncthreads();
        if (tid < 320) { const int v = tid >> 6, r = tid & 63; const float cv = (v < 4) ? a.c[v * D + k0 + r] : a.c_ctx[k0 + r]; sc[v * 64 + r] = silu_f(cv); }
        __syncthreads();
        float acc[5][3];
#pragma unroll
        for (int v = 0; v < 5; ++v)
#pragma unroll
            for (int i = 0; i < 3; ++i) acc[v][i] = 0.f;
        const float* wp = a.ada_w + (size_t)k0 * 12288 + cb * 1536 + tid;
#pragma unroll 8
        for (int r = 0; r < 64; ++r) {
            const float w0 = wp[(size_t)r * 12288], w1 = wp[(size_t)r * 12288 + 512], w2 = wp[(size_t)r * 12288 + 1024];
#pragma unroll
            for (int v = 0; v < 5; ++v) { const float s = sc[v * 64 + r]; acc[v][0] += s * w0; acc[v][1] += s * w1; acc[v][2] += s * w2; }
        }
#pragma unroll
        for (int v = 0; v < 5; ++v)
#pragma unroll
            for (int i = 0; i < 3; ++i) atomicAdd(MOD + v * 12288 + cb * 1536 + tid + 512 * i, __float2int_rn(acc[v][i] * 268435456.f));
    }
    __syncthreads();
    LAS float* scr = (LAS float*)(lds + wave * 16384);
    const int gw = blockIdx.x * NWAVES + wave, NGW = G * NWAVES;
    bf16_t* WinT = (bf16_t*)(a.ws + WS_R1 + R1_WINT); bf16_t* WabT = (bf16_t*)(a.ws + WS_WAB); bf16_t* WoutT = (bf16_t*)(a.ws + WS_WOUT);
    constexpr int I_IN = 32 * 417, I_BA = 16 * 64, I_OUT = 32 * 64;
    for (int it = gw; it < I_IN + 2 * I_BA + I_OUT; it += NGW) {
        int r = it;
        if (r < I_IN) { const int kb = r / 417, nb = r % 417, n0 = nb * 32; const size_t dr = (n0 < 9216) ? n0 : (n0 == 9216 ? 13312 : n0 - 32);
            if (dr >= 4096 && dr < 5120) tr_item(a.w_in, NIN, kb * 64, n0, (bf16_t*)(a.ws + WS_WIN8), dr - 4096, D, 0, scr, lane, true);
            else if (dr >= 9216 && dr < 13312) tr_item(a.w_in, NIN, kb * 64, n0, (bf16_t*)(a.ws + WS_WIN8), 1024 + (dr - 9216), D, 0, scr, lane, true);
            else tr_item(a.w_in, NIN, kb * 64, n0, WinT, dr, D, 0, scr, lane);
            continue; }
        r -= I_IN;
        if (r < I_BA) { tr_item(a.w_ba, D, (r >> 6) * 64, (r & 63) * 32, WabT, (r & 63) * 32, D, 0, scr, lane); continue; }
        r -= I_BA;
        if (r < I_BA) { tr_item(a.w_bb, D, (r >> 6) * 64, (r & 63) * 32, WabT, (r & 63) * 32, D, 1024, scr, lane); continue; }
        r -= I_BA;
        tr_item(a.w_out, D, (r >> 6) * 64, (r & 63) * 32, WoutT, (r & 63) * 32, D, 0, scr, lane);
    }
    { u32x4* z = (u32x4*)(WinT + (size_t)13344 * D); const int n16 = 224 * D * 2 / 16;
      for (int i = blockIdx.x * NTHR + tid; i < n16; i += G * NTHR) z[i] = (u32x4){0u, 0u, 0u, 0u}; }
}

__device__ __forceinline__ void phase_norm1(const Args& a) {
    const int tid = threadIdx.x, lane = tid & 63, wave = tid >> 6, G = gridDim.x;
    const modfx_t* MOD = (const modfx_t*)(a.ws + WS_MOD); bf16_t* H = (bf16_t*)(a.ws + WS_R1 + R1_H);
    f32x4 v[8], vn[8];
    { const int r0 = blockIdx.x * NWAVES + wave; if (r0 < MTOT) { const float* src = (r0 < MLAT) ? a.x + (size_t)r0 * D : a.ctx + (size_t)(r0 - MLAT) * D;
#pragma unroll
        for (int j = 0; j < 8; ++j) v[j] = *(const f32x4*)(src + lane * 4 + 256 * j); } }
    for (int r = blockIdx.x * NWAVES + wave; r < MTOT; r += G * NWAVES) {
        const int mv = (r < MLAT) ? (r >> 12) : 4;
        { const int rn = r + G * NWAVES; if (rn < MTOT) { const float* srcn = (rn < MLAT) ? a.x + (size_t)rn * D : a.ctx + (size_t)(rn - MLAT) * D;
#pragma unroll
            for (int j = 0; j < 8; ++j) vn[j] = *(const f32x4*)(srcn + lane * 4 + 256 * j); } }
        float ss = 0.f;
#pragma unroll
        for (int j = 0; j < 8; ++j) ss += (v[j].x * v[j].x + v[j].y * v[j].y) + (v[j].z * v[j].z + v[j].w * v[j].w);
        const float rstd = rsqrtf(wave_sum(ss) * (1.f / D) + EPS);
#pragma unroll
        for (int j = 0; j < 8; ++j) { const int c = lane * 4 + 256 * j;
            const f32x4 nm = *(const f32x4*)(a.norm_mix + c);
            const f32x4 sh = mod4(MOD, mv * 12288 + c) + *(const f32x4*)(a.ada_b + c);
            const f32x4 scl = mod4(MOD, mv * 12288 + D + c) + *(const f32x4*)(a.ada_b + D + c);
            const f32x4 h = v[j] * rstd * nm * (scl + 1.f) + sh;
            u32x2 w; w.x = pk2(h.x, h.y); w.y = pk2(h.z, h.w);
            *(u32x2*)(H + (size_t)r * D + c) = w;
            if (r < MLAT) *(unsigned*)(a.ws + WS_R2 + R2_H8 + (size_t)r * D + c) = pk4_fp8(h.x, h.y, h.z, h.w); }
#pragma unroll
        for (int j = 0; j < 8; ++j) v[j] = vn[j];
    }
}

__device__ __forceinline__ void scan_hgrn_naive(const Args& a, LAS unsigned char* lds, int b, int h, int dir) {
    const int tid = threadIdx.x, v = tid >> 2, dq = tid & 3, tok = tid >> 4, c8 = (tid & 15) * 8;
    LAS float* Lq = (LAS float*)lds; LAS float* Lk = Lq + 4096; LAS float* Lf = Lk + 4096; LAS float* Lv = Lf + 4096;
    const bf16_t* P = (const bf16_t*)(a.ws + WS_P);
    bf16_t* O = (bf16_t*)((unsigned char*)a.out + (dir ? R2_OAB : R2_OAF));
    float lo8[8];
#pragma unroll
    for (int j = 0; j < 8; ++j) { const int d = h * 128 + c8 + j; const float l0 = a.hgrn_lb[(dir * 2 + 0) * 1024 + d], l1 = a.hgrn_lb[(dir * 2 + 1) * 1024 + d]; lo8[j] = 1.f / (1.f + __expf(l1 - l0)); }
    float S[32];
#pragma unroll
    for (int i = 0; i < 32; ++i) S[i] = 0.f;
    const int cf = dir ? C_FB : C_FF;
    for (int p0 = 0; p0 < CTXL + SEQ; p0 += 32) {
        __syncthreads();
        { const int p = p0 + tok;
          const int row = (p < CTXL) ? (MLAT + b * CTXL + (dir ? CTXL - 1 - p : p)) : (b * SEQ + (dir ? SEQ - 1 - (p - CTXL) : (p - CTXL)));
          const bf16_t* pr = P + (size_t)row * PC + h * 128 + c8;
          const u32x4 rq = *(const u32x4*)(pr + C_HQ), rf = *(const u32x4*)(pr + cf), ri = *(const u32x4*)(pr + C_HI);
          const unsigned wq[4] = {rq.x, rq.y, rq.z, rq.w}, wf[4] = {rf.x, rf.y, rf.z, rf.w}, wi[4] = {ri.x, ri.y, ri.z, ri.w};
          float oq[8], ok[8], of[8], ov[8];
#pragma unroll
          for (int j = 0; j < 8; ++j) {
              const float xq = (j & 1) ? bfhi(wq[j >> 1]) : bflo(wq[j >> 1]), xf = (j & 1) ? bfhi(wf[j >> 1]) : bflo(wf[j >> 1]), xi = (j & 1) ? bfhi(wi[j >> 1]) : bflo(wi[j >> 1]);
              const float sg = sigmoid_f(xf), lo = lo8[j];
              oq[j] = silu_f(xq); of[j] = lo + (1.f - lo) * sg; ok[j] = (1.f - lo) * (1.f - sg); ov[j] = xi; }
          const int o = tok * 128 + c8;
          *(LAS f32x4*)(Lq + o) = (f32x4){oq[0], oq[1], oq[2], oq[3]}; *(LAS f32x4*)(Lq + o + 4) = (f32x4){oq[4], oq[5], oq[6], oq[7]};
          *(LAS f32x4*)(Lk + o) = (f32x4){ok[0], ok[1], ok[2], ok[3]}; *(LAS f32x4*)(Lk + o + 4) = (f32x4){ok[4], ok[5], ok[6], ok[7]};
          *(LAS f32x4*)(Lf + o) = (f32x4){of[0], of[1], of[2], of[3]}; *(LAS f32x4*)(Lf + o + 4) = (f32x4){of[4], of[5], of[6], of[7]};
          *(LAS f32x4*)(Lv + o) = (f32x4){ov[0], ov[1], ov[2], ov[3]}; *(LAS f32x4*)(Lv + o + 4) = (f32x4){ov[4], ov[5], ov[6], ov[7]};
        }
        __syncthreads();
        for (int tt = 0; tt < 32; ++tt) {
            const float vv = Lv[tt * 128 + v];
            float o = 0.f;
            const int base = tt * 128 + dq * 32;
#pragma unroll
            for (int i = 0; i < 32; i += 4) {
                const f32x4 f4 = *(const LAS f32x4*)(Lf + base + i), k4 = *(const LAS f32x4*)(Lk + base + i), q4 = *(const LAS f32x4*)(Lq + base + i);
                S[i] = f4.x * S[i] + k4.x * vv; o += q4.x * S[i];
                S[i + 1] = f4.y * S[i + 1] + k4.y * vv; o += q4.y * S[i + 1];
                S[i + 2] = f4.z * S[i + 2] + k4.z * vv; o += q4.z * S[i + 2];
                S[i + 3] = f4.w * S[i + 3] + k4.w * vv; o += q4.w * S[i + 3];
            }
            o += __shfl_xor(o, 1); o += __shfl_xor(o, 2);
            const int p = p0 + tt;
            if (p >= CTXL && dq == 0) { const int pos = dir ? SEQ - 1 - (p - CTXL) : (p - CTXL); O[(size_t)(b * SEQ + pos) * 1024 + h * 128 + v] = (bf16_t)f2bf(o); }
        }
    }
}

__device__ __forceinline__ void scan_gdn_naive(const Args& a, LAS unsigned char* lds, int b, int h, int dir) {
    const int tid = threadIdx.x, v = tid >> 2, dq = tid & 3, tok = tid >> 4, c8 = (tid & 15) * 8;
    LAS float* Lq = (LAS float*)lds; LAS float* Lk = Lq + 4096; LAS float* Lv = Lk + 4096; LAS float* Lg = Lv + 4096; LAS float* Lb = Lg + 32;
    const bf16_t* P = (const bf16_t*)(a.ws + WS_P); const float* AB = (const float*)(a.ws + WS_AB);
    bf16_t* O = (bf16_t*)((unsigned char*)a.out + (dir ? R2_OBB : R2_OBF));
    const float Acoef = -__expf(a.a_log[dir * 8 + h]), dtb = a.dt_bias[dir * 8 + h];
    float S[32];
#pragma unroll
    for (int i = 0; i < 32; ++i) S[i] = 0.f;
    for (int p0 = 0; p0 < CTXL + SEQ; p0 += 32) {
        __syncthreads();
        { const int p = p0 + tok; const bool isc = p < CTXL;
          const int L = isc ? CTXL : SEQ;
          const int sn = isc ? (dir ? CTXL - 1 - p : p) : (dir ? SEQ - 1 - (p - CTXL) : (p - CTXL));
          float aq[8], ak[8], av[8];
#pragma unroll
          for (int j = 0; j < 8; ++j) { aq[j] = 0.f; ak[j] = 0.f; av[j] = 0.f; }
          int rowc = 0;
#pragma unroll 1
          for (int tap = 0; tap < 5; ++tap) {
              const int s2 = sn + tap - 2;
              const int s2c = s2 < 0 ? 0 : (s2 >= L ? L - 1 : s2);
              const int row = isc ? (MLAT + b * CTXL + s2c) : (b * SEQ + (s2c & 63) * 64 + (s2c >> 6));
              if (tap == 2) rowc = row;
              const float ok = (s2 >= 0 && s2 < L) ? 1.f : 0.f;
              const bf16_t* pr = P + (size_t)row * PC + h * 128 + c8;
              const u32x4 rq = *(const u32x4*)(pr + C_GQ), rk = *(const u32x4*)(pr + C_GK), rv = *(const u32x4*)(pr + C_GV);
              const float* cw = a.gdn_conv + (size_t)tap * 3072 + h * 128 + c8;
              const f32x4 wq0 = *(const f32x4*)(cw), wq1 = *(const f32x4*)(cw + 4), wk0 = *(const f32x4*)(cw + 1024), wk1 = *(const f32x4*)(cw + 1028), wv0 = *(const f32x4*)(cw + 2048), wv1 = *(const f32x4*)(cw + 2052);
              const float cq[8] = {wq0.x, wq0.y, wq0.z, wq0.w, wq1.x, wq1.y, wq1.z, wq1.w}, ck[8] = {wk0.x, wk0.y, wk0.z, wk0.w, wk1.x, wk1.y, wk1.z, wk1.w}, cv[8] = {wv0.x, wv0.y, wv0.z, wv0.w, wv1.x, wv1.y, wv1.z, wv1.w};
              const unsigned uq[4] = {rq.x, rq.y, rq.z, rq.w}, uk[4] = {rk.x, rk.y, rk.z, rk.w}, uv[4] = {rv.x, rv.y, rv.z, rv.w};
#pragma unroll
              for (int j = 0; j < 8; ++j) {
                  const float xq = (j & 1) ? bfhi(uq[j >> 1]) : bflo(uq[j >> 1]), xk = (j & 1) ? bfhi(uk[j >> 1]) : bflo(uk[j >> 1]), xv = (j & 1) ? bfhi(uv[j >> 1]) : bflo(uv[j >> 1]);
                  aq[j] += ok * cq[j] * xq; ak[j] += ok * ck[j] * xk; av[j] += ok * cv[j] * xv; }
          }
          float sq = 0.f, sk = 0.f;
#pragma unroll
          for (int j = 0; j < 8; ++j) { aq[j] = silu_f(aq[j]); ak[j] = silu_f(ak[j]); av[j] = silu_f(av[j]); sq += aq[j] * aq[j]; sk += ak[j] * ak[j]; }
#pragma unroll
          for (int o = 1; o < 16; o <<= 1) { sq += __shfl_xor(sq, o); sk += __shfl_xor(sk, o); }
          const float rq_ = rsqrtf(sq + EPS) * 0.08838834764831845f, rk_ = rsqrtf(sk + EPS);
          const int o = tok * 128 + c8;
          *(LAS f32x4*)(Lq + o) = (f32x4){aq[0] * rq_, aq[1] * rq_, aq[2] * rq_, aq[3] * rq_}; *(LAS f32x4*)(Lq + o + 4) = (f32x4){aq[4] * rq_, aq[5] * rq_, aq[6] * rq_, aq[7] * rq_};
          *(LAS f32x4*)(Lk + o) = (f32x4){ak[0] * rk_, ak[1] * rk_, ak[2] * rk_, ak[3] * rk_}; *(LAS f32x4*)(Lk + o + 4) = (f32x4){ak[4] * rk_, ak[5] * rk_, ak[6] * rk_, ak[7] * rk_};
          *(LAS f32x4*)(Lv + o) = (f32x4){av[0], av[1], av[2], av[3]}; *(LAS f32x4*)(Lv + o + 4) = (f32x4){av[4], av[5], av[6], av[7]};
          if ((tid & 15) == 0) { const float al = AB[(size_t)rowc * 32 + dir * 8 + h], bl = AB[(size_t)rowc * 32 + 16 + dir * 8 + h];
              Lg[tok] = __expf(Acoef * softplus_f(al + dtb)); Lb[tok] = sigmoid_f(bl); }
        }
        __syncthreads();
        for (int tt = 0; tt < 32; ++tt) {
            const float vv = Lv[tt * 128 + v], eg = Lg[tt], be = Lb[tt];
            const int base = tt * 128 + dq * 32;
            float ks = 0.f;
#pragma unroll
            for (int i = 0; i < 32; i += 4) { const f32x4 k4 = *(const LAS f32x4*)(Lk + base + i);
                S[i] *= eg; S[i + 1] *= eg; S[i + 2] *= eg; S[i + 3] *= eg;
                ks += k4.x * S[i] + k4.y * S[i + 1] + k4.z * S[i + 2] + k4.w * S[i + 3]; }
            ks += __shfl_xor(ks, 1); ks += __shfl_xor(ks, 2);
            const float err = be * (vv - ks);
            float o = 0.f;
#pragma unroll
            for (int i = 0; i < 32; i += 4) { const f32x4 k4 = *(const LAS f32x4*)(Lk + base + i), q4 = *(const LAS f32x4*)(Lq + base + i);
                S[i] += k4.x * err; S[i + 1] += k4.y * err; S[i + 2] += k4.z * err; S[i + 3] += k4.w * err;
                o += q4.x * S[i] + q4.y * S[i + 1] + q4.z * S[i + 2] + q4.w * S[i + 3]; }
            o += __shfl_xor(o, 1); o += __shfl_xor(o, 2);
            const int p = p0 + tt;
            if (p >= CTXL && dq == 0) { const int sn = dir ? SEQ - 1 - (p - CTXL) : (p - CTXL); const int pos = (sn & 63) * 64 + (sn >> 6);
                O[(size_t)(b * SEQ + pos) * 1024 + h * 128 + v] = (bf16_t)f2bf(o); }
        }
    }
}


__device__ __forceinline__ int gdn_row(int b, bool isc, int n) { return isc ? (MLAT + b * CTXL + n) : (b * SEQ + (n & 63) * 64 + (n >> 6)); }
__device__ __forceinline__ void gdnprep_halo(const Args& a) {
    const int tid = threadIdx.x;
    const bf16_t* P = (const bf16_t*)(a.ws + WS_P); bf16_t* HALO = (bf16_t*)(a.ws + WS_HALO);
    for (int t = blockIdx.x; t < NB * 8 * 68; t += gridDim.x) {
        const int cc = t % 68, bh = t / 68, b = bh >> 3, h = bh & 7; const bool isc = cc < 4; const int L = isc ? CTXL : SEQ, n0 = 64 * (isc ? cc : cc - 4);
        if (tid < 192) { const int hr = tid / 48, c16 = tid % 48; const int n = (hr < 2) ? n0 - 2 + hr : n0 + 62 + hr;
            u32x4 v = (u32x4){0u, 0u, 0u, 0u};
            if (n >= 0 && n < L) v = *(const u32x4*)(P + (size_t)gdn_row(b, isc, n) * PC + C_GQ + (c16 >> 4) * 1024 + h * 128 + (c16 & 15) * 8);
            *(u32x4*)(HALO + ((size_t)t * 4 + hr) * 384 + c16 * 8) = v; }
    }
}
__device__ __forceinline__ void gdnprep_conv(const Args& a, LAS unsigned char* lds) {
    const int tid = threadIdx.x;
    constexpr int RAW = 0, PRAW = 784, CW = 53312;
    bf16_t* P = (bf16_t*)(a.ws + WS_P); const bf16_t* HALO = (const bf16_t*)(a.ws + WS_HALO);
    constexpr int NT = NB * 8 * 68;
    u32x4 rr[7]; float cwr[4];
#define GP_LOAD(t_) do { const int cc_ = (t_) % 68, bh_ = (t_) / 68, b_ = bh_ >> 3, h_ = bh_ & 7; const bool isc_ = cc_ < 4; const int n0_ = 64 * (isc_ ? cc_ : cc_ - 4); \
        _Pragma("unroll") for (int k = 0; k < 7; ++k) { int piece = tid + NTHR * k; piece = piece < 68 * 48 ? piece : 68 * 48 - 1; const int wr_ = piece / 48, c16 = piece % 48; \
            const bf16_t* src = (wr_ >= 2 && wr_ < 66) ? (P + (size_t)gdn_row(b_, isc_, n0_ + wr_ - 2) * PC + C_GQ + (c16 >> 4) * 1024 + h_ * 128 + (c16 & 15) * 8) \
                                                      : (HALO + ((size_t)(t_) * 4 + (wr_ < 2 ? wr_ : wr_ - 64)) * 384 + c16 * 8); \
            rr[k] = *(const u32x4*)src; } \
        _Pragma("unroll") for (int k = 0; k < 4; ++k) { int i = tid + NTHR * k; i = i < 1920 ? i : 1919; const int tap = i / 384, c3 = i % 384; cwr[k] = a.gdn_conv[(size_t)tap * 3072 + (c3 >> 7) * 1024 + h_ * 128 + (c3 & 127)]; } } while (0)
    if ((int)blockIdx.x < NT) GP_LOAD((int)blockIdx.x);
    for (int t = blockIdx.x; t < NT; t += gridDim.x) {
        const int cc = t % 68, bh = t / 68, b = bh >> 3, h = bh & 7; const bool isc = cc < 4; const int n0 = 64 * (isc ? cc : cc - 4);
        __syncthreads();
#pragma unroll
        for (int k = 0; k < 4; ++k) { const int i = tid + NTHR * k; if (i < 1920) ((LAS float*)(lds + CW))[i] = cwr[k]; }
#pragma unroll
        for (int k = 0; k < 7; ++k) { const int piece = tid + NTHR * k; if (piece < 68 * 48) { const int wr_ = piece / 48, c16 = piece % 48; *(LAS u32x4*)(lds + RAW + wr_ * PRAW + c16 * 16) = rr[k]; } }
        if (t + (int)gridDim.x < NT) GP_LOAD(t + (int)gridDim.x);
        if (tid < 128) {
            const int dirg = tid >> 6, nl = tid & 63; float* ABw = (float*)(a.ws + WS_AB);
            const size_t row = (size_t)gdn_row(b, isc, n0 + nl);
            const float al = ABw[row * 32 + dirg * 8 + h], bl = ABw[row * 32 + 16 + dirg * 8 + h];
            const float g = -__expf(a.a_log[dirg * 8 + h]) * softplus_f(al + a.dt_bias[dirg * 8 + h]);
            float Gc = g;
#pragma unroll
            for (int o = 1; o < 64; o <<= 1) { const float t = dirg ? __shfl_down(Gc, o) : __shfl_up(Gc, o); if (dirg ? (nl + o < 64) : (nl >= o)) Gc += t; }
            ABw[row * 32 + dirg * 8 + h] = Gc; ABw[row * 32 + 16 + dirg * 8 + h] = sigmoid_f(bl);
        }
        __syncthreads();
        {
            const int cg = tid & 31, tg = tid >> 5, nb = 4 * tg;
#pragma unroll 1
            for (int ten = 0; ten < 3; ++ten) {
                f32x4 wt[5];
#pragma unroll
                for (int tap = 0; tap < 5; ++tap) wt[tap] = *(const LAS f32x4*)((const LAS float*)(lds + CW) + tap * 384 + ten * 128 + 4 * cg);
                f32x4 acc[4];
#pragma unroll
                for (int u = 0; u < 4; ++u) acc[u] = (f32x4){0.f, 0.f, 0.f, 0.f};
#pragma unroll
                for (int rw_ = 0; rw_ < 8; ++rw_) { const u32x2 x = *(const LAS u32x2*)(lds + RAW + (nb + rw_) * PRAW + (ten * 128 + 4 * cg) * 2);
                    const f32x4 xv = (f32x4){bflo(x.x), bfhi(x.x), bflo(x.y), bfhi(x.y)};
#pragma unroll
                    for (int u = 0; u < 4; ++u) { const int tap = rw_ - u; if (tap >= 0 && tap < 5) acc[u] += wt[tap] * xv; } }
                float ss[4];
#pragma unroll
                for (int u = 0; u < 4; ++u) { acc[u].x = silu_f(acc[u].x); acc[u].y = silu_f(acc[u].y); acc[u].z = silu_f(acc[u].z); acc[u].w = silu_f(acc[u].w);
                    ss[u] = (acc[u].x * acc[u].x + acc[u].y * acc[u].y) + (acc[u].z * acc[u].z + acc[u].w * acc[u].w); }
                if (ten < 2) {
#pragma unroll
                    for (int o = 1; o < 32; o <<= 1) {
#pragma unroll
                        for (int u = 0; u < 4; ++u) ss[u] += __shfl_xor(ss[u], o); }
#pragma unroll
                    for (int u = 0; u < 4; ++u) { const float sc = rsqrtf(ss[u] + EPS) * (ten == 0 ? 0.08838834764831845f : 1.f); acc[u] = acc[u] * sc; }
                }
#pragma unroll
                for (int u = 0; u < 4; ++u) *(u32x2*)(P + (size_t)gdn_row(b, isc, n0 + nb + u) * PC + C_GQ + ten * 1024 + h * 128 + 4 * cg) = (u32x2){pk2(acc[u].x, acc[u].y), pk2(acc[u].z, acc[u].w)};
            }
        }
    }
}

#undef GP_LOAD

typedef short bf16x4 __attribute__((ext_vector_type(4)));
__device__ __forceinline__ unsigned cvtpk(float lo, float hi) { return pk2(lo, hi); }
__device__ __forceinline__ bf16x8 pack_tiles(const f32x4 t0, const f32x4 t1) {
    u32x4 r; r.x = cvtpk(t0[0], t0[1]); r.y = cvtpk(t0[2], t0[3]); r.z = cvtpk(t1[0], t1[1]); r.w = cvtpk(t1[2], t1[3]); return __builtin_bit_cast(bf16x8, r); }
__device__ __forceinline__ bf16x4 pack_tile(const f32x4 t) { u32x2 r; r.x = cvtpk(t[0], t[1]); r.y = cvtpk(t[2], t[3]); return __builtin_bit_cast(bf16x4, r); }
__device__ __forceinline__ bf16x8 lds_a_perm(const LAS unsigned char* p, int fq) {
    const u32x2 lo = *(const LAS u32x2*)(p + 8 * fq), hi = *(const LAS u32x2*)(p + 32 + 8 * fq);
    u32x4 r; r.x = lo.x; r.y = lo.y; r.z = hi.x; r.w = hi.y; return __builtin_bit_cast(bf16x8, r); }
#define MFMA32(A, B, C) __builtin_amdgcn_mfma_f32_16x16x32_bf16((A), (B), (C), 0, 0, 0)
#define MFMA16(A, B, C) __builtin_amdgcn_mfma_f32_16x16x16bf16_1k((A), (B), (C), 0, 0, 0)

__device__ __forceinline__ void scan_hgrn_mfma(const Args& a, LAS unsigned char* lds, const int b, const int h, const int dir) {
    int tid0 = threadIdx.x; asm volatile("" : "+v"(tid0)); const int w = __builtin_amdgcn_readfirstlane(tid0 >> 6);
    const int d = tid0 & 127, tq = tid0 >> 7;
    constexpr int QM = 0, KM = 17408, QT = 34816, KHT = 52224, VT = 70656, AM = 89088, AV = 98304, SEG = 98816;
    constexpr int PQ = 272, PT = 144;
    const bf16_t* P = (const bf16_t*)(a.ws + WS_P);
    bf16_t* O = (bf16_t*)((unsigned char*)a.out + (dir ? R2_OAB : R2_OAF));
    float lo;
    { const int ch = h * 128 + d; const float l0 = a.hgrn_lb[(dir * 2 + 0) * 1024 + ch], l1 = a.hgrn_lb[(dir * 2 + 1) * 1024 + ch]; lo = 1.f / (1.f + __expf(l1 - l0)); }
    const int cf = dir ? C_FB : C_FF;
    f32x4 S[8];
#pragma unroll
    for (int i = 0; i < 8; ++i) S[i] = (f32x4){0.f, 0.f, 0.f, 0.f};
    u32x4 rr[6];
#define HG_LOAD(cc) do { const int i_ = tid >> 3, part_ = tid & 7; const int p = 64 * (cc) + i_; \
        const int row = (p < CTXL) ? (MLAT + b * CTXL + (dir ? CTXL - 1 - p : p)) : (b * SEQ + (dir ? SEQ - 1 - (p - CTXL) : (p - CTXL))); \
        const bf16_t* pr = P + (size_t)row * PC + h * 128 + part_ * 16; \
        rr[0] = *(const u32x4*)(pr + C_HQ); rr[1] = *(const u32x4*)(pr + C_HQ + 8); rr[2] = *(const u32x4*)(pr + cf); rr[3] = *(const u32x4*)(pr + cf + 8); \
        rr[4] = *(const u32x4*)(pr + C_HI); rr[5] = *(const u32x4*)(pr + C_HI + 8); } while (0)
    { const int tid = tid0; HG_LOAD(0); }
    for (int c = 0; c < 68; ++c) {
        int tid = tid0; asm volatile("" : "+v"(tid)); const int lane = tid & 63, fr = lane & 15, fq = lane >> 4;
        __syncthreads();
        { const int i_ = tid >> 3, part_ = tid & 7;
          *(LAS u32x4*)(lds + QM + i_ * PQ + part_ * 32) = rr[0]; *(LAS u32x4*)(lds + QM + i_ * PQ + part_ * 32 + 16) = rr[1];
          *(LAS u32x4*)(lds + KM + i_ * PQ + part_ * 32) = rr[2]; *(LAS u32x4*)(lds + KM + i_ * PQ + part_ * 32 + 16) = rr[3];
          *(LAS u32x4*)(lds + QT + i_ * PQ + part_ * 32) = rr[4]; *(LAS u32x4*)(lds + QT + i_ * PQ + part_ * 32 + 16) = rr[5]; }
        if (c + 1 < 68) HG_LOAD(c + 1);
        __syncthreads();
        unsigned short ri[16];
        float fv[16], kk[16], qs[16]; float pl = 1.f;
#pragma unroll
        for (int t = 0; t < 16; ++t) { const int i_ = tq * 16 + t;
            const float xq = bf2f(*(const LAS unsigned short*)(lds + QM + i_ * PQ + d * 2)), xf = bf2f(*(const LAS unsigned short*)(lds + KM + i_ * PQ + d * 2)); ri[t] = *(const LAS unsigned short*)(lds + QT + i_ * PQ + d * 2);
            const float sg = sigmoid_f(xf); const float f = lo + (1.f - lo) * sg; kk[t] = (1.f - lo) * (1.f - sg); pl *= f; fv[t] = pl; qs[t] = silu_f(xq); }
        ((LAS float*)(lds + SEG))[tq * 128 + d] = pl;
        { u32x4 v0, v1; v0.x = ri[0] | ((unsigned)ri[1] << 16); v0.y = ri[2] | ((unsigned)ri[3] << 16); v0.z = ri[4] | ((unsigned)ri[5] << 16); v0.w = ri[6] | ((unsigned)ri[7] << 16);
          v1.x = ri[8] | ((unsigned)ri[9] << 16); v1.y = ri[10] | ((unsigned)ri[11] << 16); v1.z = ri[12] | ((unsigned)ri[13] << 16); v1.w = ri[14] | ((unsigned)ri[15] << 16);
          *(LAS u32x4*)(lds + VT + d * PT + tq * 32) = v0; *(LAS u32x4*)(lds + VT + d * PT + tq * 32 + 16) = v1; }
        __syncthreads();
        {
            const LAS float* sg = (const LAS float*)(lds + SEG);
            const float s0 = sg[d], s1 = sg[128 + d], s2 = sg[256 + d], s3 = sg[384 + d];
            const float pre = (tq == 0) ? 1.f : (tq == 1 ? s0 : (tq == 2 ? s0 * s1 : s0 * s1 * s2));
            const float pmid = s0 * s1, plast = pmid * s2 * s3, rmid = rcp_f(pmid), c1 = plast * rmid;
            unsigned kh[8];
#pragma unroll
            for (int t = 0; t < 16; ++t) {
                const float Pt = pre * fv[t], e1 = Pt * rmid, r1 = rcp_f(e1);
                const int i = tq * 16 + t;
                *(LAS unsigned short*)(lds + QM + i * PQ + d * 2) = (unsigned short)f2bf(qs[t] * e1);
                *(LAS unsigned short*)(lds + KM + i * PQ + d * 2) = (unsigned short)f2bf(kk[t] * r1);
                *(LAS unsigned short*)(lds + QT + i * PQ + d * 2) = (unsigned short)f2bf(qs[t] * Pt);
                const unsigned kb = f2bf(kk[t] * r1 * c1);
                if (t & 1) kh[t >> 1] |= kb << 16; else kh[t >> 1] = kb;
            }
            *(LAS u32x4*)(lds + KHT + d * PT + tq * 32) = (u32x4){kh[0], kh[1], kh[2], kh[3]}; *(LAS u32x4*)(lds + KHT + d * PT + tq * 32 + 16) = (u32x4){kh[4], kh[5], kh[6], kh[7]};
            if (tq == 0) ((LAS float*)(lds + AV))[d] = plast;
        }
        __syncthreads();
        {
            const int mt = w >> 1;
#pragma unroll
            for (int nn = 0; nn < 2; ++nn) { const int nt = (w & 1) * 2 + nn;
                f32x4 acc = (f32x4){0.f, 0.f, 0.f, 0.f};
                if (nt <= mt) {
#pragma unroll
                    for (int s = 0; s < 4; ++s) { const bf16x8 A = *(const LAS bf16x8*)(lds + QM + (16 * mt + fr) * PQ + (32 * s + 8 * fq) * 2), B = *(const LAS bf16x8*)(lds + KM + (16 * nt + fr) * PQ + (32 * s + 8 * fq) * 2);
                        acc = MFMA32(A, B, acc); } }
#pragma unroll
                for (int r = 0; r < 4; ++r) { const int i = 16 * mt + 4 * fq + r, j = 16 * nt + fr; *(LAS unsigned short*)(lds + AM + i * PT + j * 2) = (unsigned short)f2bf(j <= i ? acc[r] : 0.f); }
            }
        }
        __syncthreads();
        {
            bf16x8 vb[2];
#pragma unroll
            for (int s2 = 0; s2 < 2; ++s2) vb[s2] = *(const LAS bf16x8*)(lds + VT + (16 * w + fr) * PT + (32 * s2 + 8 * fq) * 2);
            if (c >= 4) {
                bf16x8 sb[4];
#pragma unroll
                for (int s = 0; s < 4; ++s) sb[s] = pack_tiles(S[2 * s], S[2 * s + 1]);
                f32x4 o[4];
#pragma unroll
                for (int mt = 0; mt < 4; ++mt) { o[mt] = (f32x4){0.f, 0.f, 0.f, 0.f};
#pragma unroll
                    for (int s = 0; s < 4; ++s) o[mt] = MFMA32(lds_a_perm(lds + QT + (16 * mt + fr) * PQ + 64 * s, fq), sb[s], o[mt]);
#pragma unroll
                    for (int s2 = 0; s2 < 2; ++s2) if (2 * s2 <= mt) o[mt] = MFMA32(*(const LAS bf16x8*)(lds + AM + (16 * mt + fr) * PT + (32 * s2 + 8 * fq) * 2), vb[s2], o[mt]);
                }
#pragma unroll
                for (int mt = 0; mt < 4; ++mt)
#pragma unroll
                    for (int r = 0; r < 4; ++r) { const int i = 16 * mt + 4 * fq + r, sidx = 64 * (c - 4) + i, pos = dir ? SEQ - 1 - sidx : sidx;
                        O[(size_t)(b * SEQ + pos) * 1024 + h * 128 + 16 * w + fr] = (bf16_t)f2bf(o[mt][r]); }
            }
#pragma unroll
            for (int dt = 0; dt < 8; ++dt) { const f32x4 a4 = *(const LAS f32x4*)(lds + AV + (16 * dt + 4 * fq) * 4); S[dt] = S[dt] * a4;
#pragma unroll
                for (int s2 = 0; s2 < 2; ++s2) S[dt] = MFMA32(*(const LAS bf16x8*)(lds + KHT + (16 * dt + fr) * PT + (32 * s2 + 8 * fq) * 2), vb[s2], S[dt]); }
        }
    }
#undef HG_LOAD
}

__device__ __forceinline__ void scan_gdn_mfma(const Args& a, LAS unsigned char* lds, const int b, const int h, const int dir) {
    int tid0 = threadIdx.x; asm volatile("" : "+v"(tid0)); const int w = __builtin_amdgcn_readfirstlane(tid0 >> 6);
    constexpr int RAW = 0, PRAW = 784;
    constexpr int LT = 0, AQK = 9216, LD = 18432, PT = 144;
    constexpr int QN = 53312, KN = 70720, PQ = 272;
    constexpr int KNT = 88128;
    constexpr int VB = 106560;
    constexpr int GT = 123968;
    constexpr int CW = 125008;
    const bf16_t* P = (const bf16_t*)(a.ws + WS_P); const float* AB = (const float*)(a.ws + WS_AB);
    bf16_t* O = (bf16_t*)((unsigned char*)a.out + (dir ? R2_OBB : R2_OBF));
    __syncthreads();
    for (int i = tid0; i < 64 * 72 / 2; i += NTHR) ((LAS unsigned*)(lds + AQK))[i] = 0u;
    f32x4 S[8];
#pragma unroll
    for (int i = 0; i < 8; ++i) S[i] = (f32x4){0.f, 0.f, 0.f, 0.f};
    u32x4 rr[6]; float g_nx = 0.f, b_nx = 0.f;
#define GD_GEOM(c_, isc_, L_, n0_) const bool isc_ = (c_) < 4; const int L_ = isc_ ? CTXL : SEQ; const int n0_ = 64 * (isc_ ? (dir ? 3 - (c_) : (c_)) : (dir ? 63 - ((c_) - 4) : ((c_) - 4)));
#define GD_LOAD(c_) do { GD_GEOM(c_, isc, L, n0) (void)L; { const int i_ = tid >> 3, part_ = tid & 7; const int n = n0 + (dir ? 63 - i_ : i_); \
        const bf16_t* pr = P + (size_t)gdn_row(b, isc, n) * PC + C_GQ + h * 128 + part_ * 16; \
        rr[0] = *(const u32x4*)(pr); rr[1] = *(const u32x4*)(pr + 8); rr[2] = *(const u32x4*)(pr + 1024); rr[3] = *(const u32x4*)(pr + 1032); rr[4] = *(const u32x4*)(pr + 2048); rr[5] = *(const u32x4*)(pr + 2056); } \
        if (w == 0) { const int ln = tid & 63; const int n = n0 + (dir ? 63 - ln : ln); const size_t row = (size_t)gdn_row(b, isc, n); g_nx = AB[row * 32 + dir * 8 + h]; b_nx = AB[row * 32 + 16 + dir * 8 + h]; } } while (0)
    { const int tid = tid0; GD_LOAD(0); }
    for (int c = 0; c < 68; ++c) {
        GD_GEOM(c, isc, L, n0) (void)L; (void)isc;
        int tid = tid0; asm volatile("" : "+v"(tid));
        int lane = tid & 63, fr = lane & 15, fq = lane >> 4;
        __syncthreads();
        {
            const int i_ = tid >> 3, part_ = tid & 7;
            *(LAS u32x4*)(lds + QN + i_ * PQ + part_ * 32) = rr[0]; *(LAS u32x4*)(lds + QN + i_ * PQ + part_ * 32 + 16) = rr[1];
            *(LAS u32x4*)(lds + KN + i_ * PQ + part_ * 32) = rr[2]; *(LAS u32x4*)(lds + KN + i_ * PQ + part_ * 32 + 16) = rr[3];
            *(LAS u32x4*)(lds + VB + i_ * PQ + part_ * 32) = rr[4]; *(LAS u32x4*)(lds + VB + i_ * PQ + part_ * 32 + 16) = rr[5];
            const unsigned kw[8] = {rr[2].x, rr[2].y, rr[2].z, rr[2].w, rr[3].x, rr[3].y, rr[3].z, rr[3].w};
#pragma unroll
            for (int j = 0; j < 8; ++j) { *(LAS unsigned short*)(lds + KNT + (part_ * 16 + 2 * j) * PT + i_ * 2) = (unsigned short)(kw[j] & 0xffffu);
                *(LAS unsigned short*)(lds + KNT + (part_ * 16 + 2 * j + 1) * PT + i_ * 2) = (unsigned short)(kw[j] >> 16); }
        }
        const float g_in = g_nx, b_in = b_nx;
        if (c + 1 < 68) GD_LOAD(c + 1);
        if (w == 0) {
            const float G = g_in;
            const float Glast = __shfl(G, 63);
            LAS float* gt = (LAS float*)(lds + GT);
            gt[lane] = __expf(G); gt[64 + lane] = __expf(Glast - G); gt[128 + lane] = b_in; gt[192 + lane] = G;
            if (lane == 0) gt[256] = __expf(Glast);
        }
        __syncthreads();
        tid = tid0; asm volatile("" : "+v"(tid)); lane = tid & 63; fr = lane & 15; fq = lane >> 4;
        {
            const LAS float* gt = (const LAS float*)(lds + GT);
#pragma unroll
            for (int nn = 0; nn < 2; ++nn) {
                int mt, nt;
                if (w < 4) { mt = w; nt = w; if (nn == 1) break; }
                else { const int id = (w - 4) * 2 + nn; if (id >= 6) break;
                    mt = (id == 0) ? 1 : (id <= 2 ? 2 : 3); nt = (id == 0 || id == 1 || id == 3) ? 0 : ((id == 2 || id == 4) ? 1 : 2); }
                f32x4 akk = (f32x4){0.f, 0.f, 0.f, 0.f}, aqk = (f32x4){0.f, 0.f, 0.f, 0.f};
#pragma unroll
                for (int s = 0; s < 4; ++s) { const bf16x8 Bk = *(const LAS bf16x8*)(lds + KN + (16 * nt + fr) * PQ + (32 * s + 8 * fq) * 2);
                    akk = MFMA32(*(const LAS bf16x8*)(lds + KN + (16 * mt + fr) * PQ + (32 * s + 8 * fq) * 2), Bk, akk);
                    aqk = MFMA32(*(const LAS bf16x8*)(lds + QN + (16 * mt + fr) * PQ + (32 * s + 8 * fq) * 2), Bk, aqk); }
                const int j = 16 * nt + fr; const float Gj = gt[192 + j];
                const f32x4 Gi4 = *(const LAS f32x4*)(gt + 192 + 16 * mt + 4 * fq), bi4 = *(const LAS f32x4*)(gt + 128 + 16 * mt + 4 * fq);
#pragma unroll
                for (int r = 0; r < 4; ++r) { const int i = 16 * mt + 4 * fq + r; const float Gi = Gi4[r], bi = bi4[r];
                    const float gam = (j <= i) ? __expf(Gi - Gj) : 0.f;
                    *(LAS unsigned short*)(lds + AQK + i * PT + j * 2) = (unsigned short)f2bf(aqk[r] * gam);
                    const float Lij = (j < i) ? bi * akk[r] * gam : 0.f;
                    if (w < 4) *(LAS unsigned short*)(lds + LD + (mt * 16 + (4 * fq + r)) * 40 + fr * 2) = (unsigned short)f2bf(-Lij);
                    else *(LAS unsigned short*)(lds + LT + i * PT + j * 2) = (unsigned short)f2bf(-Lij); }
            }
            if (w < 4) {
                asm volatile("s_waitcnt lgkmcnt(0)" ::: "memory"); __builtin_amdgcn_wave_barrier();
                const bf16x4 nl = *(const LAS bf16x4*)(lds + LD + (w * 16 + fr) * 40 + (4 * fq) * 2);
                f32x4 eye; eye[0] = (4 * fq + 0 == fr) ? 1.f : 0.f; eye[1] = (4 * fq + 1 == fr) ? 1.f : 0.f; eye[2] = (4 * fq + 2 == fr) ? 1.f : 0.f; eye[3] = (4 * fq + 3 == fr) ? 1.f : 0.f;
                f32x4 X = eye;
#pragma unroll
                for (int it = 0; it < 15; ++it) X = MFMA16(nl, pack_tile(X), eye);
#pragma unroll
                for (int r = 0; r < 4; ++r) *(LAS unsigned short*)(lds + LT + (16 * w + 4 * fq + r) * PT + (16 * w + fr) * 2) = (unsigned short)f2bf(X[r]);
            }
        }
        __syncthreads();
        tid = tid0; asm volatile("" : "+v"(tid)); lane = tid & 63; fr = lane & 15; fq = lane >> 4;
        {
            const LAS float* gt = (const LAS float*)(lds + GT);
            bf16x8 sb[4];
#pragma unroll
            for (int s = 0; s < 4; ++s) sb[s] = pack_tiles(S[2 * s], S[2 * s + 1]);
            f32x4 R[4];
#pragma unroll
            for (int mt = 0; mt < 4; ++mt) { f32x4 X = (f32x4){0.f, 0.f, 0.f, 0.f};
#pragma unroll
                for (int s = 0; s < 4; ++s) X = MFMA32(lds_a_perm(lds + KN + (16 * mt + fr) * PQ + 64 * s, fq), sb[s], X);
                const f32x4 be4 = *(const LAS f32x4*)(gt + 128 + 16 * mt + 4 * fq), eg4 = *(const LAS f32x4*)(gt + 16 * mt + 4 * fq);
#pragma unroll
                for (int r = 0; r < 4; ++r) { const int i = 16 * mt + 4 * fq + r; const float vv = bf2f(*(const LAS unsigned short*)(lds + VB + i * PQ + (16 * w + fr) * 2));
                    R[mt][r] = be4[r] * (vv - eg4[r] * X[r]); } }
            f32x4 vt[4];
#pragma unroll
            for (int ab = 0; ab < 4; ++ab) { f32x4 acc = R[ab];
#pragma unroll
                for (int bb = 0; bb < ab; ++bb) acc = MFMA16(*(const LAS bf16x4*)(lds + LT + (16 * ab + fr) * PT + (16 * bb + 4 * fq) * 2), pack_tile(vt[bb]), acc);
                const f32x4 z4 = {0.f, 0.f, 0.f, 0.f}; vt[ab] = MFMA16(*(const LAS bf16x4*)(lds + LT + (16 * ab + fr) * PT + (16 * ab + 4 * fq) * 2), pack_tile(acc), z4); }
            if (c >= 4) {
                const bf16x8 vnb0 = pack_tiles(vt[0], vt[1]), vnb1 = pack_tiles(vt[2], vt[3]);
                const int ccn = n0 >> 6;
#pragma unroll
                for (int mt = 0; mt < 4; ++mt) { f32x4 o = (f32x4){0.f, 0.f, 0.f, 0.f};
#pragma unroll
                    for (int s = 0; s < 4; ++s) o = MFMA32(lds_a_perm(lds + QN + (16 * mt + fr) * PQ + 64 * s, fq), sb[s], o);
                    o = o * *(const LAS f32x4*)(gt + 16 * mt + 4 * fq);
                    o = MFMA32(lds_a_perm(lds + AQK + (16 * mt + fr) * PT, fq), vnb0, o);
                    if (mt >= 2) o = MFMA32(lds_a_perm(lds + AQK + (16 * mt + fr) * PT + 64, fq), vnb1, o);
#pragma unroll
                    for (int r = 0; r < 4; ++r) { const int i = 16 * mt + 4 * fq + r, nloc = dir ? 63 - i : i;
                        O[(size_t)(b * SEQ + nloc * 64 + ccn) * 1024 + h * 128 + 16 * w + fr] = (bf16_t)f2bf(o[r]); } }
            }
#pragma unroll
            for (int mt = 0; mt < 4; ++mt) vt[mt] = vt[mt] * *(const LAS f32x4*)(gt + 64 + 16 * mt + 4 * fq);
            const bf16x8 vsb0 = pack_tiles(vt[0], vt[1]), vsb1 = pack_tiles(vt[2], vt[3]);
            const float egl = gt[256];
#pragma unroll
            for (int dt = 0; dt < 8; ++dt) { S[dt] = S[dt] * egl;
                S[dt] = MFMA32(lds_a_perm(lds + KNT + (16 * dt + fr) * PT, fq), vsb0, S[dt]);
                S[dt] = MFMA32(lds_a_perm(lds + KNT + (16 * dt + fr) * PT + 64, fq), vsb1, S[dt]); }
        }
    }
#undef GD_LOAD
#undef GD_GEOM
}

#ifndef SCAN_MODE
#define SCAN_MODE 3
#endif
__device__ __forceinline__ void phase_scan(const Args& a, LAS unsigned char* lds) {
    for (int it = blockIdx.x; it < 128; it += gridDim.x) {
        const int ch = it & 63, b = ch >> 4, h = (ch >> 1) & 7, dir = ch & 1;
        if (it < 64) { if (SCAN_MODE & 1) scan_hgrn_mfma(a, lds, b, h, dir); else scan_hgrn_naive(a, lds, b, h, dir);
 }
        else { if (SCAN_MODE & 2) scan_gdn_mfma(a, lds, b, h, dir); else scan_gdn_naive(a, lds, b, h, dir);
 }
        __syncthreads();
    }
}

__device__ __forceinline__ void phase_mergeprep(const Args& a) {
    const int tid = threadIdx.x, lane = tid & 63, wave = tid >> 6, G = gridDim.x;
    const bf16_t* P = (const bf16_t*)(a.ws + WS_P);
    const bf16_t* OAF = (const bf16_t*)((const unsigned char*)a.out + R2_OAF); const bf16_t* OAB = (const bf16_t*)((const unsigned char*)a.out + R2_OAB);
    const bf16_t* OBF = (const bf16_t*)((const unsigned char*)a.out + R2_OBF); const bf16_t* OBB = (const bf16_t*)((const unsigned char*)a.out + R2_OBB);
    bf16_t* YAB = (bf16_t*)(a.ws + WS_R1 + R1_YAB);
    const int c0 = lane * 16;
    u32x4 L[2][6], Ln[2][6];
#define MP_LOAD(dst, r_) do { _Pragma("unroll") for (int br = 0; br < 2; ++br) { const bf16_t* o1 = (br ? OBF : OAF) + (size_t)(r_) * 1024 + c0; const bf16_t* o2 = (br ? OBB : OAB) + (size_t)(r_) * 1024 + c0; \
        const bf16_t* gp = P + (size_t)(r_) * PC + (br ? C_Z : C_OG) + c0; \
        dst[br][0] = *(const u32x4*)o1; dst[br][1] = *(const u32x4*)(o1 + 8); dst[br][2] = *(const u32x4*)o2; dst[br][3] = *(const u32x4*)(o2 + 8); dst[br][4] = *(const u32x4*)gp; dst[br][5] = *(const u32x4*)(gp + 8); } } while (0)
    { const int r0 = blockIdx.x * NWAVES + wave; if (r0 < MLAT) MP_LOAD(L, r0); }
    for (int r = blockIdx.x * NWAVES + wave; r < MLAT; r += G * NWAVES) {
        { const int rn = r + G * NWAVES; if (rn < MLAT) MP_LOAD(Ln, rn); }
#pragma unroll
        for (int br = 0; br < 2; ++br) {
            const float* gain = (br ? a.gdn_norm : a.hgrn_norm) + c0;
            float val[16], gt[16]; float ss = 0.f;
#pragma unroll
            for (int hx = 0; hx < 2; ++hx) {
                const u32x4 w1 = L[br][hx], w2 = L[br][2 + hx], wg = L[br][4 + hx];
                const unsigned u1[4] = {w1.x, w1.y, w1.z, w1.w}, u2[4] = {w2.x, w2.y, w2.z, w2.w}, ug[4] = {wg.x, wg.y, wg.z, wg.w};
#pragma unroll
                for (int j = 0; j < 4; ++j) {
                    float s0 = bflo(u1[j]) + bflo(u2[j]), s1 = bfhi(u1[j]) + bfhi(u2[j]); const float g0 = bflo(ug[j]), g1 = bfhi(ug[j]);
                    if (br == 0) { s0 *= sigmoid_f(g0); s1 *= sigmoid_f(g1); gt[8 * hx + 2 * j] = 1.f; gt[8 * hx + 2 * j + 1] = 1.f; }
                    else { gt[8 * hx + 2 * j] = silu_f(g0); gt[8 * hx + 2 * j + 1] = silu_f(g1); }
                    val[8 * hx + 2 * j] = s0; val[8 * hx + 2 * j + 1] = s1; ss += s0 * s0 + s1 * s1; }
            }
            ss += __shfl_xor(ss, 1); ss += __shfl_xor(ss, 2); ss += __shfl_xor(ss, 4);
            const float rstd = rsqrtf(ss * (1.f / 128.f) + EPS);
            unsigned ow[8];
#pragma unroll
            for (int j = 0; j < 8; ++j) { const f32x2 gn = *(const f32x2*)(gain + 2 * j);
                ow[j] = pk2(val[2 * j] * rstd * gn.x * gt[2 * j], val[2 * j + 1] * rstd * gn.y * gt[2 * j + 1]); }
            bf16_t* dst = YAB + (size_t)r * D + br * 1024 + c0;
            *(u32x4*)dst = (u32x4){ow[0], ow[1], ow[2], ow[3]}; *(u32x4*)(dst + 8) = (u32x4){ow[4], ow[5], ow[6], ow[7]};
        }
#pragma unroll
        for (int br = 0; br < 2; ++br)
#pragma unroll
            for (int k = 0; k < 6; ++k) L[br][k] = Ln[br][k];
    }
#undef MP_LOAD
}

__device__ __forceinline__ float reduce16(const float (&p)[16], const int lane) {
    float q8[8], q4[4], q2[2];
#pragma unroll
    for (int i = 0; i < 8; ++i) { const bool hi = (lane & 32) != 0; const float snd = hi ? p[i] : p[i + 8], kp = hi ? p[i + 8] : p[i]; q8[i] = kp + __shfl_xor(snd, 32); }
#pragma unroll
    for (int i = 0; i < 4; ++i) { const bool hi = (lane & 16) != 0; const float snd = hi ? q8[i] : q8[i + 4], kp = hi ? q8[i + 4] : q8[i]; q4[i] = kp + __shfl_xor(snd, 16); }
#pragma unroll
    for (int i = 0; i < 2; ++i) { const bool hi = (lane & 8) != 0; const float snd = hi ? q4[i] : q4[i + 2], kp = hi ? q4[i + 2] : q4[i]; q2[i] = kp + __shfl_xor(snd, 8); }
    float q1; { const bool hi = (lane & 4) != 0; const float snd = hi ? q2[0] : q2[1], kp = hi ? q2[1] : q2[0]; q1 = kp + __shfl_xor(snd, 4); }
    q1 += __shfl_xor(q1, 2); q1 += __shfl_xor(q1, 1);
    return q1;
}
__device__ __forceinline__ void phase_norm2(const Args& a, LAS unsigned char* lds) {
    const int tid = threadIdx.x, lane0 = tid & 63, wave = tid >> 6, G = gridDim.x;
    const modfx_t* MOD = (const modfx_t*)(a.ws + WS_MOD); const bf16_t* X1 = (const bf16_t*)(a.ws + WS_P + P_X1);
    bf16_t* H2 = (bf16_t*)(a.ws + WS_R1 + R1_H2); float* AFF = (float*)(a.ws + WS_AFF);
    LAS float* rw = (LAS float*)lds;
    for (int i = tid; i < D * NE; i += NTHR) { const int c = i >> 4, e = i & 15; rw[e * 2052 + c] = a.router_w[i]; }
    __syncthreads();
    for (int r = blockIdx.x * NWAVES + wave; r < MLAT; r += G * NWAVES) {
        int lane_o = lane0; asm volatile("" : "+v"(lane_o));
        const int lane = lane_o;
        const int b = r >> 12, n = r & 4095;
        f32x4 v[8]; float ss = 0.f;
#pragma unroll
        for (int j = 0; j < 8; ++j) { const u32x2 xw = *(const u32x2*)(X1 + (size_t)r * D + lane * 4 + 256 * j); v[j] = (f32x4){bflo(xw.x), bfhi(xw.x), bflo(xw.y), bfhi(xw.y)}; ss += (v[j].x * v[j].x + v[j].y * v[j].y) + (v[j].z * v[j].z + v[j].w * v[j].w); }
        const float rstd = rsqrtf(wave_sum(ss) * (1.f / D) + EPS);
#pragma unroll
        for (int j = 0; j < 8; ++j) { const int c = lane * 4 + 256 * j;
            const f32x4 nf = *(const f32x4*)(a.norm_ffn + c);
            const f32x4 sh = mod4(MOD, b * 12288 + 3 * D + c) + *(const f32x4*)(a.ada_b + 3 * D + c);
            const f32x4 scl = mod4(MOD, b * 12288 + 4 * D + c) + *(const f32x4*)(a.ada_b + 4 * D + c);
            v[j] = v[j] * rstd * nf * (scl + 1.f) + sh;
            *(unsigned*)((unsigned char*)H2 + (size_t)r * D + c) = pk4_fp8(v[j].x, v[j].y, v[j].z, v[j].w); }
        float p[16];
#pragma unroll
        for (int e = 0; e < 16; ++e) { float s = 0.f;
#pragma unroll
            for (int j = 0; j < 8; ++j) { const f32x4 w4 = *(const LAS f32x4*)(rw + e * 2052 + lane * 4 + 256 * j); s += (v[j].x * w4.x + v[j].y * w4.y) + (v[j].z * w4.z + v[j].w * w4.w); }
            p[e] = s; asm volatile("" ::: "memory"); }
        const float lg = reduce16(p, lane);
        float mx = lg;
#pragma unroll
        for (int o = 4; o < 64; o <<= 1) mx = fmaxf(mx, __shfl_xor(mx, o));
        const float ex = __expf(lg - mx); float den = ex;
#pragma unroll
        for (int o = 4; o < 64; o <<= 1) den += __shfl_xor(den, o);
        if ((lane & 3) == 0) AFF[(size_t)(b * NE + ((lane >> 2) & 15)) * SEQ + n] = ex / den;
    }
}

__device__ __forceinline__ void phase_topk(const Args& a, LAS unsigned char* lds) {
    const int tid = threadIdx.x, lane = tid & 63, wave = tid >> 6;
    const float* AFF = (const float*)(a.ws + WS_AFF); int* IDX = (int*)(a.ws + WS_IDX); float* GATEV = (float*)(a.ws + WS_GATEV); int* INV = (int*)(a.ws + WS_INV);
    LAS unsigned* wc = (LAS unsigned*)lds;
    LAS int* sel = (LAS int*)(lds + 256);
    const unsigned char* H2q = (const unsigned char*)(a.ws + WS_R1 + R1_H2); unsigned char* XS = (unsigned char*)a.out;
    const int nq = (gridDim.x >= 256) ? 4 : 1;
    for (int item = blockIdx.x; item < NB * NE * nq; item += gridDim.x) {
        const int be = item / nq, qtr = item % nq, b = be >> 4, e = be & 15;
        unsigned key[8];
        { const u32x4 k0 = *(const u32x4*)(AFF + (size_t)be * SEQ + tid * 8), k1 = *(const u32x4*)(AFF + (size_t)be * SEQ + tid * 8 + 4);
          key[0] = k0.x; key[1] = k0.y; key[2] = k0.z; key[3] = k0.w; key[4] = k1.x; key[5] = k1.y; key[6] = k1.z; key[7] = k1.w; }
        unsigned prefix = 0u;
        __syncthreads();
        for (int bit = 31; bit >= 0; --bit) {
            const unsigned cand = prefix | (1u << bit);
            unsigned cnt = 0;
#pragma unroll
            for (int i = 0; i < 8; ++i) cnt += (unsigned)__popcll(__ballot(key[i] >= cand));
            if (lane == 0) wc[(bit & 1) * 8 + wave] = cnt;
            __syncthreads();
            unsigned tot = 0;
#pragma unroll
            for (int w = 0; w < 8; ++w) tot += wc[(bit & 1) * 8 + w];
            if (tot >= (unsigned)CAP) prefix = cand;
        }
        const unsigned T = prefix;
        int cgt = 0, ceq = 0;
#pragma unroll
        for (int i = 0; i < 8; ++i) { cgt += key[i] > T; ceq += key[i] == T; }
        int val = cgt | (ceq << 16), inc = val;
#pragma unroll
        for (int o = 1; o < 64; o <<= 1) { const int t = __shfl_up(inc, o); if (lane >= o) inc += t; }
        __syncthreads();
        if (lane == 63) wc[16 + wave] = (unsigned)inc;
        __syncthreads();
        int base = 0, total = 0;
#pragma unroll
        for (int w = 0; w < 8; ++w) { const int t = (int)wc[16 + w]; total += t; if (w < wave) base += t; }
        const int excl = base + inc - val;
        int gt_before = excl & 0xffff, eq_before = excl >> 16;
        const int need = CAP - (total & 0xffff);
#pragma unroll
        for (int i = 0; i < 8; ++i) {
            const int n = tid * 8 + i; int slot = -1;
            if (key[i] > T) { slot = gt_before + (eq_before < need ? eq_before : need); ++gt_before; }
            else if (key[i] == T) { if (eq_before < need) slot = gt_before + eq_before; ++eq_before; }
            if (slot >= 0) { sel[slot] = n; if (qtr == 0) { IDX[be * CAP + slot] = n; GATEV[be * CAP + slot] = __uint_as_float(key[i]); } }
            if (qtr == 0) INV[(size_t)(b * SEQ + n) * NE + e] = slot;
        }
        __syncthreads();
        for (int sl = qtr * (CAP / nq) + wave; sl < (qtr + 1) * (CAP / nq); sl += NWAVES) { const int n = sel[sl];
            const u32x4* src = (const u32x4*)(H2q + (size_t)(b * SEQ + n) * D); u32x4* dst = (u32x4*)(XS + (size_t)(be * CAP + sl) * D);
#pragma unroll
            for (int j = 0; j < 2; ++j) dst[lane + 64 * j] = src[lane + 64 * j]; }
        __syncthreads();
    }
}

__device__ __forceinline__ void phase_gather(const Args& a) {
    const int tid = threadIdx.x, lane = tid & 63, wave = tid >> 6, G = gridDim.x;
    const bf16_t* H2 = (const bf16_t*)(a.ws + WS_R1 + R1_H2); const int* IDX = (const int*)(a.ws + WS_IDX); bf16_t* XS = (bf16_t*)a.out;
    for (int r = blockIdx.x * NWAVES + wave; r < NB * NE * CAP; r += G * NWAVES) {
        const int b = r >> 13; const int n = IDX[r];
        const u32x4* src = (const u32x4*)((const unsigned char*)H2 + (size_t)(b * SEQ + n) * D); u32x4* dst = (u32x4*)((unsigned char*)XS + (size_t)r * D);
#pragma unroll
        for (int j = 0; j < 2; ++j) dst[lane + 64 * j] = src[lane + 64 * j];
    }
}

__device__ __forceinline__ void phase_final(const Args& a) {
    const int tid = threadIdx.x, lane = tid & 63, wave = tid >> 6, G = gridDim.x;
    const modfx_t* MOD = (const modfx_t*)(a.ws + WS_MOD); const bf16_t* X1 = (const bf16_t*)(a.ws + WS_P + P_X1);
    const bf16_t* YE = (const bf16_t*)(a.ws + WS_P + P_WGU); const int* INV = (const int*)(a.ws + WS_INV);
    for (int r = blockIdx.x * NWAVES + wave; r < MLAT; r += G * NWAVES) {
        const int b = r >> 12;
        const int myslot = (lane < 16) ? INV[(size_t)r * NE + lane] : -1;
        u32x2 xw[8];
#pragma unroll
        for (int j = 0; j < 8; ++j) xw[j] = *(const u32x2*)(X1 + (size_t)r * D + lane * 4 + 256 * j);
        f32x4 f[8];
#pragma unroll
        for (int j = 0; j < 8; ++j) f[j] = (f32x4){0.f, 0.f, 0.f, 0.f};
        unsigned long long mask = __ballot(myslot >= 0);
        while (mask) {
            const int e0 = __builtin_ctzll(mask); mask &= mask - 1;
            const int e1 = mask ? __builtin_ctzll(mask) : -1; if (mask) mask &= mask - 1;
            const int s0 = __shfl(myslot, e0), s1 = (e1 >= 0) ? __shfl(myslot, e1) : 0;
            const bf16_t* y0 = YE + ((size_t)(b * NE + e0) * CAP + s0) * D; const bf16_t* y1 = YE + ((size_t)(b * NE + (e1 >= 0 ? e1 : e0)) * CAP + s1) * D;
            u32x2 w0[8], w1[8];
#pragma unroll
            for (int j = 0; j < 8; ++j) { w0[j] = *(const u32x2*)(y0 + lane * 4 + 256 * j); w1[j] = *(const u32x2*)(y1 + lane * 4 + 256 * j); }
            const float k1 = (e1 >= 0) ? 1.f : 0.f;
#pragma unroll
            for (int j = 0; j < 8; ++j) { f[j].x += bflo(w0[j].x) + k1 * bflo(w1[j].x); f[j].y += bfhi(w0[j].x) + k1 * bfhi(w1[j].x); f[j].z += bflo(w0[j].y) + k1 * bflo(w1[j].y); f[j].w += bfhi(w0[j].y) + k1 * bfhi(w1[j].y); }
        }
        float ss = 0.f;
#pragma unroll
        for (int j = 0; j < 8; ++j) { const int c = lane * 4 + 256 * j;
            const f32x4 m5 = mod4(MOD, b * 12288 + 5 * D + c) + *(const f32x4*)(a.ada_b + 5 * D + c);
            f[j] = (f32x4){bflo(xw[j].x), bfhi(xw[j].x), bflo(xw[j].y), bfhi(xw[j].y)} + m5 * f[j];
            ss += (f[j].x * f[j].x + f[j].y * f[j].y) + (f[j].z * f[j].z + f[j].w * f[j].w); }
        const float rstd = rsqrtf(wave_sum(ss) * (1.f / D) + EPS);
#pragma unroll
        for (int j = 0; j < 8; ++j) { const int c = lane * 4 + 256 * j; *(f32x4*)(a.out + (size_t)r * D + c) = f[j] * rstd * *(const f32x4*)(a.final_norm + c); }
    }
}

#define XB_TMO      128
#define XB_XCNT(j)  (256  + 64 * (j))
#define XB_XSUB(j)  (1280 + 64 * (j))
#define XB_XGEN(j)  (2304 + 64 * (j))
#define XB_TOP      3328
#define XB_TOPGEN   3392
#define XCD_BAR_WORDS 3456
#define XB_SPIN_CAP (1u << 18)
__device__ __forceinline__ unsigned xb_ld(unsigned* p)              { return __hip_atomic_load(p, __ATOMIC_RELAXED, __HIP_MEMORY_SCOPE_AGENT); }
__device__ __forceinline__ unsigned xb_add(unsigned* p, unsigned v) { return __hip_atomic_fetch_add(p, v, __ATOMIC_RELAXED, __HIP_MEMORY_SCOPE_AGENT); }
__device__ __forceinline__ unsigned xb_xcc_id() { return (unsigned)__builtin_amdgcn_s_getreg((3 << 11) | 20) & 0xFu; }
#define XB_SPIN(cond, bar) do { unsigned _sp = 0; while (cond) { __builtin_amdgcn_s_sleep(1); \
    if ((++_sp & 255u) == 0u) { if (xb_ld(&(bar)[XB_TMO])) break; if (_sp > XB_SPIN_CAP) { atomicAdd(&(bar)[XB_TMO], 1u); break; } } } } while (0)
struct XcdBarrier { unsigned* bar; unsigned x; volatile LAS unsigned* st; };
__device__ __forceinline__ XcdBarrier xcd_barrier_post(unsigned* bar, volatile LAS unsigned* st) {
    XcdBarrier b; b.bar = bar; b.x = xb_xcc_id(); b.st = st;
    if (threadIdx.x == 0) (void)xb_add(&bar[XB_XCNT(b.x)], 1u);
    return b;
}
__device__ __forceinline__ void xcd_barrier_complete(unsigned* bar, unsigned x, unsigned& nloc, unsigned& nx) {
    const unsigned G = gridDim.x * gridDim.y * gridDim.z;
    unsigned sum, cnt, mine, sp = 0u;
    for (;;) {
        sum = 0u; cnt = 0u; mine = 0u;
#pragma unroll
        for (unsigned j = 0; j < 16; ++j) { const unsigned c = xb_ld(&bar[XB_XCNT(j)]); sum += c; cnt += (c > 0u) ? 1u : 0u; mine = (j == x) ? c : mine; }
        if (sum == G) break;
        __builtin_amdgcn_s_sleep(1);
        if ((++sp & 255u) == 0u) { if (xb_ld(&bar[XB_TMO])) break; if (sp > XB_SPIN_CAP) { atomicAdd(&bar[XB_TMO], 1u); break; } }
    }
    nloc = mine > 0u ? mine : 1u; nx = cnt > 0u ? cnt : 1u;
}
__device__ __forceinline__ void xcd_barrier_at(unsigned* bar_, const XcdBarrier& b) {
    asm volatile("s_waitcnt vmcnt(0)" ::: "memory");
    __syncthreads();
    if (threadIdx.x == 0) {
        unsigned* bar = bar_;
        const unsigned bx = (unsigned)__builtin_amdgcn_readfirstlane((int)xb_xcc_id());
        __builtin_amdgcn_s_waitcnt(0);
        unsigned nloc = b.st[0], nx = b.st[1];
        if (nloc == 0u) { xcd_barrier_complete(bar, bx, nloc, nx); b.st[0] = nloc; b.st[1] = nx; }
        const unsigned old = xb_add(&bar[XB_XSUB(bx)], 1u);
        const unsigned gen = old / nloc;
        if (old + 1u == (gen + 1u) * nloc) {
            __builtin_amdgcn_fence(__ATOMIC_RELEASE, "agent");
            asm volatile("s_waitcnt vmcnt(0)" ::: "memory");
            const unsigned og = xb_add(&bar[XB_TOP], 1u);
            const unsigned tg = og / nx;
            if (og + 1u == (tg + 1u) * nx) xb_add(&bar[XB_TOPGEN], 1u);
            else XB_SPIN(xb_ld(&bar[XB_TOPGEN]) == tg, bar);
            __builtin_amdgcn_fence(__ATOMIC_ACQUIRE, "agent");
            xb_add(&bar[XB_XGEN(bx)], 1u);
            asm volatile("s_waitcnt vmcnt(0)" ::: "memory");
        } else {
            XB_SPIN(xb_ld(&bar[XB_XGEN(bx)]) == gen, bar);
            __builtin_amdgcn_fence(__ATOMIC_ACQUIRE, "agent");
            asm volatile("s_waitcnt vmcnt(0)" ::: "memory");
        }
    }
    __syncthreads();
}

constexpr int NPHASE = 13;
constexpr int ZFILL = 76;
__global__ void __launch_bounds__(NTHR, 2) fwd(Args a) {
    extern __shared__ __attribute__((aligned(16))) unsigned char lds_raw[];
    LAS unsigned char* lds = (LAS unsigned char*)lds_raw;
#if ONE_LAUNCH
    constexpr int lo = 0, hi = NPHASE;
#else
    const int lo = a.ph_lo, hi = a.ph_hi;
#endif
    const int G = gridDim.x, cidx = blockIdx.x;
    unsigned char* ws = a.ws;
    volatile LAS unsigned* bst = (volatile LAS unsigned*)(lds + LDS_BYTES - 16);
    if (threadIdx.x < 4) bst[threadIdx.x] = 0u;
    __syncthreads();
    XcdBarrier xbar = xcd_barrier_post((unsigned*)(ws + WS_BAR), bst);
#ifndef PHASE_MASK
#define PHASE_MASK 0xFFFF
#endif
#define IN(k) (((PHASE_MASK >> (k)) & 1) && lo <= (k) && (k) < hi)
#ifndef REPEAT_MASK
#define REPEAT_MASK 0
#endif
#define REP(k) (1 + ((REPEAT_MASK >> (k)) & 1))
#define SEAM(k) do { if (IN(k) && IN((k) + 1)) { if (gridDim.x > 1024u) cg::this_grid().sync(); else xcd_barrier_at((unsigned*)(a.ws + WS_BAR), xbar); } } while (0)
    if (IN(0)) for (int rep_ = 0; rep_ < REP(0); ++rep_) { if (rep_) cg::this_grid().sync(); phase_prep(a, lds); } SEAM(0);
    if (IN(1)) for (int rep_ = 0; rep_ < REP(1); ++rep_) { if (rep_) cg::this_grid().sync(); phase_norm1(a); } SEAM(1);
    if (IN(2)) for (int rep_ = 0; rep_ < REP(2); ++rep_) { if (rep_) cg::this_grid().sync();
        pg8::SchedTwo S; S.G = G; S.c = cidx;
        S.a.init(MTOT, 29 * 256, 1, 0, ws + WS_R1 + R1_H, ws + WS_R1 + R1_WINT, (size_t)256 * D * 2, (size_t)256 * D * 2, 0, 0, 1); S.na = S.a.nwg;
        S.b.init(MLAT, 4 * 256, 1, 0, ws + WS_R1 + R1_H, ws + WS_R1 + R1_WINT, (size_t)256 * D * 2, (size_t)256 * D * 2, 0, 0, 4);
        S.nextra = (G >= 256) ? ZFILL : 0;
        pg8::EpiP E{(bf16_t*)(ws + WS_P), (float*)(ws + WS_AB), 1.f};
        pg8::gemm_phase<pg8::EpiP, pg8::SchedTwo, false>(lds, D, D, D, S, E);
    } SEAM(2);
    if (IN(3)) for (int rep_ = 0; rep_ < REP(3); ++rep_) { if (rep_) cg::this_grid().sync();
        gdnprep_halo(a); xcd_barrier_at((unsigned*)(a.ws + WS_BAR), xbar); gdnprep_conv(a, lds); xcd_barrier_at((unsigned*)(a.ws + WS_BAR), xbar);
        if (G < 256 || cidx < 128) phase_scan(a, lds);
        if (G < 256 || cidx >= 128) {
            const int Gg = (G < 256) ? G : 128, cg_ = (G < 256) ? cidx : cidx - 128;
            {
                pg8::SchedPlain S; S.init(MLAT, 20 * 256, Gg, cg_, ws + WS_R2 + R2_H8, ws + WS_WIN8, (size_t)256 * D, (size_t)256 * D, 0, 0, 3);
                pg8::EpiP E{(bf16_t*)(ws + WS_P), (float*)(ws + WS_AB), 1.f / W8_SCALE};
                pg8::gemm_phase<pg8::EpiP, pg8::SchedPlain, false, true>(lds, D / 2, D / 2, D / 2, S, E);
            }
            {
                pg8::SchedPlain S; S.init(MLAT, 4 * 256, Gg, cg_, ws + WS_R1 + R1_H, ws + WS_R1 + R1_WINT, (size_t)256 * D * 2, (size_t)256 * D * 2, 0, 0, 4);
                if (G >= 256) S.ubeg = ZFILL;
                pg8::EpiP E{(bf16_t*)(ws + WS_P), (float*)(ws + WS_AB), 1.f};
                pg8::gemm_phase<pg8::EpiP, pg8::SchedPlain, false>(lds, D, D, D, S, E);
            }
        }
        {
            const int lane = threadIdx.x & 63, wave = threadIdx.x >> 6; LAS float* scr = (LAS float*)(lds + wave * 16384);
            bf16_t* WguT = (bf16_t*)(ws + WS_R2); bf16_t* WdT = (bf16_t*)(ws + WS_R2 + 67108864);
            unsigned* qctr = (unsigned*)(ws + WS_BAR + 14336 + 240); volatile LAS unsigned* qb = (volatile LAS unsigned*)(lds + LDS_BYTES - 32);
            for (;;) {
                __syncthreads();
                if (threadIdx.x == 0) qb[0] = atomicAdd(qctr, 1u);
                __syncthreads();
                const unsigned bt = qb[0]; if (bt >= 768u) break;
                for (int k = 0; k < 8; ++k) { const int cv = (int)bt * 64 + wave * 8 + k;
                    const int which = cv >> 14, r = cv & 16383, e = r >> 10, q = r & 1023;
                    if (which < 2) { const int kb = q >> 5, nb = q & 31, n0 = nb * 32; const size_t dr = (size_t)e * 2048 + (n0 >> 7) * 256 + (n0 & 127) + which * 128;
                        tr_item((which ? a.w_up : a.w_gate) + (size_t)e * D * DE, DE, kb * 64, n0, WguT, dr, D, 0, scr, lane, true); }
                    else { const int kb = q >> 6, nb = q & 63, n0 = nb * 32;
                        tr_item(a.w_down + (size_t)e * DE * D, D, kb * 64, n0, WdT, (size_t)e * 2048 + n0, DE, 0, scr, lane, true); } }
            }
        }
    } SEAM(3);
    if (IN(4)) for (int rep_ = 0; rep_ < REP(4); ++rep_) { if (rep_) cg::this_grid().sync(); phase_mergeprep(a); } SEAM(4);
    if (IN(5)) for (int rep_ = 0; rep_ < REP(5); ++rep_) { if (rep_) cg::this_grid().sync();
        pg8::SchedPlain S; S.init(MLAT, D, G, cidx, ws + WS_R1 + R1_YAB, ws + WS_WAB, (size_t)256 * D * 2, (size_t)256 * D * 2, 1, (size_t)1024 * 2);
        pg8::EpiMerge E{(const bf16_t*)(ws + WS_P), (bf16_t*)a.out};
        pg8::gemm_phase<pg8::EpiMerge, pg8::SchedPlain, true>(lds, 1024, D, D, S, E);
    } SEAM(5);
    if (IN(6)) for (int rep_ = 0; rep_ < REP(6); ++rep_) { if (rep_) cg::this_grid().sync();
        pg8::SchedPlain S; S.init(MLAT, D, G, cidx, (const void*)a.out, ws + WS_WOUT, (size_t)256 * D * 2, (size_t)256 * D * 2);
        pg8::EpiX1 E{a.x, (const modfx_t*)(ws + WS_MOD), a.ada_b, (bf16_t*)(ws + WS_P + P_X1)};
        pg8::gemm_phase<pg8::EpiX1, pg8::SchedPlain, false>(lds, D, D, D, S, E);
    } SEAM(6);
    if (IN(7)) for (int rep_ = 0; rep_ < REP(7); ++rep_) { if (rep_) cg::this_grid().sync(); phase_norm2(a, lds); } SEAM(7);
    if (IN(8)) for (int rep_ = 0; rep_ < REP(8); ++rep_) { if (rep_) cg::this_grid().sync(); phase_topk(a, lds); } SEAM(8);
    if (IN(9)) for (int rep_ = 0; rep_ < REP(9); ++rep_) { (void)rep_; }
    if (IN(10)) for (int rep_ = 0; rep_ < REP(10); ++rep_) { if (rep_) cg::this_grid().sync();
        pg8::SchedMoe S{G, cidx, (const char*)a.out, (const char*)(ws + WS_R2), (size_t)256 * D, (size_t)256 * D};
        pg8::EpiHact E{(unsigned char*)(ws + WS_P + P_HACT)};
        pg8::gemm_phase<pg8::EpiHact, pg8::SchedMoe, false, true>(lds, D / 2, D / 2, D / 2, S, E);
    } SEAM(10);
    if (IN(11)) for (int rep_ = 0; rep_ < REP(11); ++rep_) { if (rep_) cg::this_grid().sync();
        pg8::SchedMoe S{G, cidx, (const char*)(ws + WS_P + P_HACT), (const char*)(ws + WS_R2 + 67108864), (size_t)256 * DE, (size_t)256 * DE};
        pg8::EpiYE E{(const float*)(ws + WS_GATEV), (bf16_t*)(ws + WS_P + P_WGU)};
        pg8::gemm_phase<pg8::EpiYE, pg8::SchedMoe, false, true>(lds, DE / 2, DE / 2, DE / 2, S, E);
    } SEAM(11);
    if (IN(12)) for (int rep_ = 0; rep_ < REP(12); ++rep_) { if (rep_) cg::this_grid().sync(); phase_final(a); }
#undef IN
#undef SEAM
}

extern "C" void kernel_launch(void* const* d_in, const int* in_sizes, int n_in, void* d_out, int out_size, void* d_ws, size_t ws_size, hipStream_t stream) {
    static int grid = 0;
    if (grid == 0) {
        if (n_in != 23 || out_size != MLAT * D || ws_size < WS_END) { fprintf(stderr, "kernel_launch: unexpected shapes: n_in %d out %d ws %zu (need %zu)\n", n_in, out_size, ws_size, (size_t)WS_END); grid = -1; return; }
        int dev = 0, cus = 0, per_cu = 0;
        if (hipGetDevice(&dev) != hipSuccess || hipDeviceGetAttribute(&cus, hipDeviceAttributeMultiprocessorCount, dev) != hipSuccess) { grid = -1; return; }
        if (hipFuncSetAttribute((const void*)fwd, hipFuncAttributeMaxDynamicSharedMemorySize, LDS_BYTES) != hipSuccess) { fprintf(stderr, "kernel_launch: hipFuncSetAttribute failed\n"); grid = -1; return; }
        if (hipOccupancyMaxActiveBlocksPerMultiprocessor(&per_cu, (const void*)fwd, NTHR, LDS_BYTES) != hipSuccess || per_cu < 1) { fprintf(stderr, "kernel_launch: occupancy query says %d\n", per_cu); per_cu = 1; }
        (void)hipGetLastError();
        grid = cus;
    }
    if (grid < 0) return;
    Args a{};
    a.x = (const float*)d_in[0]; a.c = (const float*)d_in[1]; a.ctx = (const float*)d_in[2]; a.c_ctx = (const float*)d_in[3]; a.ada_w = (const float*)d_in[4]; a.ada_b = (const float*)d_in[5];
    a.norm_mix = (const float*)d_in[6]; a.norm_ffn = (const float*)d_in[7]; a.w_in = (const float*)d_in[8]; a.gdn_conv = (const float*)d_in[9]; a.a_log = (const float*)d_in[10]; a.dt_bias = (const float*)d_in[11];
    a.hgrn_lb = (const float*)d_in[12]; a.hgrn_norm = (const float*)d_in[13]; a.gdn_norm = (const float*)d_in[14]; a.w_ba = (const float*)d_in[15]; a.w_bb = (const float*)d_in[16]; a.w_out = (const float*)d_in[17];
    a.router_w = (const float*)d_in[18]; a.w_gate = (const float*)d_in[19]; a.w_up = (const float*)d_in[20]; a.w_down = (const float*)d_in[21]; a.final_norm = (const float*)d_in[22];
    a.out = (float*)d_out; a.ws = (unsigned char*)d_ws;
    (void)hipMemsetAsync((char*)d_ws + WS_BAR, 0, 16384 + 245760, stream);
#if ONE_LAUNCH
    a.ph_lo = 0; a.ph_hi = NPHASE;
    void* args[] = {&a};
    hipError_t e = hipLaunchCooperativeKernel((const void*)fwd, dim3(grid), dim3(NTHR), args, LDS_BYTES, stream);
    if (e != hipSuccess) fprintf(stderr, "kernel_launch: cooperative launch failed: %s (grid %d)\n", hipGetErrorString(e), grid);
#else
    for (int p = 0; p < NPHASE; ++p) { a.ph_lo = p; a.ph_hi = p + 1; hipLaunchKernelGGL(fwd, dim3(grid), dim3(NTHR), LDS_BYTES, stream, a); }
#endif
}
```

```cpp
#include <hip/hip_runtime.h>
#include <hip/hip_cooperative_groups.h>
#include <cstdio>
#include <cstdint>
namespace cg = cooperative_groups;

#ifndef ONE_LAUNCH
#define ONE_LAUNCH 1
#endif

#define LAS __attribute__((address_space(3)))
typedef unsigned short bf16_t;
typedef short bf16x8 __attribute__((ext_vector_type(8)));
typedef float f32x4 __attribute__((ext_vector_type(4)));
typedef float f32x2 __attribute__((ext_vector_type(2)));
typedef unsigned u32x4 __attribute__((ext_vector_type(4)));
typedef unsigned u32x2 __attribute__((ext_vector_type(2)));

constexpr int D = 2048, NB = 4, SEQ = 4096, CTXL = 256;
constexpr int MLAT = NB * SEQ, MCTX = NB * CTXL, MTOT = MLAT + MCTX;
constexpr int NIN = 13344, NPW = 13568, PC = 10368;
constexpr int C_HQ = 0, C_FF = 1024, C_FB = 2048, C_HI = 3072, C_OG = 4096, C_GQ = 5120, C_GK = 6144, C_GV = 7168  , C_Z = 5120, C_GA = 6144, C_GB = 8192;
constexpr int GTOK = CTXL + SEQ;
constexpr size_t GB_OFF = (size_t)MTOT * PC;
__device__ __forceinline__ size_t gdn_tok(int b, int h, bool isc, int n) { return ((size_t)((b * 8 + h) * GTOK + (isc ? n : CTXL + n))) * 384; }
constexpr int NE = 16, CAP = 512, DE = 1024;
constexpr float EPS = 1e-6f;
constexpr int NTHR = 512, NWAVES = 8;
constexpr int LDS_BYTES = 147456;

constexpr size_t WS_BAR = 0;
constexpr size_t WS_MOD = 16384;
constexpr size_t WS_AFF = WS_MOD + 245760;
constexpr size_t WS_IDX = WS_AFF + 1048576;
constexpr size_t WS_GATEV = WS_IDX + 131072;
constexpr size_t WS_INV = WS_GATEV + 131072;
constexpr size_t WS_AB = WS_INV + 1048576;
constexpr size_t WS_WAB = WS_AB + 2228224;
constexpr size_t WS_WOUT = WS_WAB + 8388608;
constexpr size_t WS_R1 = WS_WOUT + 8388608;
constexpr size_t WS_R2 = WS_R1 + 126877696;
constexpr size_t WS_P = WS_R2 + 134217728;
constexpr size_t WS_HALO = WS_P + 468713472;
constexpr size_t WS_WIN8 = WS_HALO + 6684672;
constexpr size_t WS_END = WS_WIN8 + 10485760;
constexpr size_t R2_H8 = 100663296;
constexpr size_t R1_WINT = 0, R1_H = 55574528, R1_YAB = 0, R1_H2 = 0;
constexpr size_t R2_OAF = 0, R2_OAB = 33554432, R2_OBF = 67108864, R2_OBB = 100663296, R2_T = 0, R2_XS = 0, R2_YE = 0;
constexpr size_t P_X1 = 0, P_WGU = 134217728, P_WD = 268435456, P_HACT = 335544320;

struct Args {
    const float *x, *c, *ctx, *c_ctx, *ada_w, *ada_b, *norm_mix, *norm_ffn, *w_in, *gdn_conv, *a_log, *dt_bias, *hgrn_lb, *hgrn_norm, *gdn_norm,
        *w_ba, *w_bb, *w_out, *router_w, *w_gate, *w_up, *w_down, *final_norm;
    float* out; unsigned char* ws; int ph_lo, ph_hi;
};

__device__ __forceinline__ float bf2f(unsigned short b) { return __uint_as_float(((unsigned)b) << 16); }
__device__ __forceinline__ float bflo(unsigned w) { return __uint_as_float(w << 16); }
__device__ __forceinline__ float bfhi(unsigned w) { return __uint_as_float(w & 0xffff0000u); }
typedef __bf16 bf16x2v __attribute__((ext_vector_type(2)));
__device__ __forceinline__ unsigned pk2(float lo, float hi) { const f32x2 v = {lo, hi}; const bf16x2v b = __builtin_convertvector(v, bf16x2v); return __builtin_bit_cast(unsigned, b); }
__device__ __forceinline__ unsigned f2bf(float f) { return pk2(f, f) & 0xffffu; }
__device__ __forceinline__ float rcp_f(float x) { return __builtin_amdgcn_rcpf(x); }
__device__ __forceinline__ float sigmoid_f(float x) { return __builtin_amdgcn_rcpf(1.f + __builtin_amdgcn_exp2f(-1.4426950408889634f * x)); }
__device__ __forceinline__ float silu_f(float x) { return x * sigmoid_f(x); }
__device__ __forceinline__ float softplus_f(float x) { return x > 20.f ? x : log1pf(__expf(x)); }
__device__ __forceinline__ float wave_sum(float v) {
#pragma unroll
    for (int o = 1; o < 64; o <<= 1) v += __shfl_xor(v, o);
    return v;
}
#define LDS_WAIT() asm volatile("s_waitcnt lgkmcnt(0)" ::: "memory")
typedef int modfx_t;
typedef int v4i_ __attribute__((ext_vector_type(4)));
__device__ __forceinline__ f32x4 mod4(const modfx_t* M, size_t idx) {
    const v4i_ q = *(const v4i_*)(M + idx); const float sc = 3.725290298461914e-09f;
    return (f32x4){(float)q.x * sc, (float)q.y * sc, (float)q.z * sc, (float)q.w * sc}; }
typedef int v8i __attribute__((ext_vector_type(8)));
typedef int v4i __attribute__((ext_vector_type(4)));
__device__ __forceinline__ unsigned pk4_fp8(float a, float b, float c, float d) { unsigned w = 0u; w = (unsigned)__builtin_amdgcn_cvt_pk_fp8_f32(a, b, (int)w, false); w = (unsigned)__builtin_amdgcn_cvt_pk_fp8_f32(c, d, (int)w, true); return w; }
constexpr float W8_SCALE = 64.f;

namespace pg8 {
constexpr int BM = 256, BK = 64, HALF = 128, HTB = HALF * BK * 2, STAGE_BYTES = 8 * HTB, NXCD = 8, WGM = 8;
__device__ __forceinline__ int lds_byte(int r, int c) { const int st = (r >> 4) * 2 + (c >> 5), rr = r & 15, cc = c & 31, ob = rr * 64 + cc * 2; return st * 1024 + (ob ^ (((ob >> 9) & 1) << 5)); }
__device__ __forceinline__ void stage_rc(int b, int& R, int& C) { const int st = b / 1024, sb = b % 1024, swz = sb ^ (((sb >> 9) & 1) << 5); R = (st >> 1) * 16 + swz / 64; C = (st & 1) * 32 + (swz % 64) / 2; }
__device__ __forceinline__ int perm32(int rho) { const int n = rho >> 4, i = rho & 15; return 8 * (i >> 2) + 4 * n + (i & 3); }
struct Unit { int pm, pn; const char* A; const char* B; int half; };
__device__ __forceinline__ unsigned cvt_pk_bf16(float lo, float hi) { unsigned r; asm volatile("v_cvt_pk_bf16_f32 %0, %1, %2" : "=v"(r) : "v"(lo), "v"(hi)); return r; }

struct SchedPlain {
    int nM, nN, nwg, G, c; const char* A; const char* B; size_t tA, tB; int pair; size_t hoff; int remap; int ubeg, uend;
    __device__ __forceinline__ void init(int M, int N, int G_, int c_, const void* A_, const void* B_, size_t tA_, size_t tB_, int pair_ = 0, size_t hoff_ = 0, int remap_ = 0) { nM = M / BM; nN = N / BM; nwg = nM * nN; G = G_; c = c_; A = (const char*)A_; B = (const char*)B_; tA = tA_; tB = tB_; pair = pair_; hoff = hoff_; remap = remap_; ubeg = 0; uend = nwg; }
    __device__ __forceinline__ bool next(int i, Unit& u) const {
        const int hf = pair ? (i & 1) : 1; if (pair) i >>= 1;
        const long L = (long)ubeg + (long)i * G + c; if (L >= uend) return false;
        int wgid = (int)L; { const int q = nwg / NXCD, r = nwg % NXCD, xcd = wgid % NXCD, off = wgid / NXCD; wgid = (xcd < r ? xcd * (q + 1) : r * (q + 1) + (xcd - r) * q) + off; }
        const int nig = WGM * nN, gid = wgid / nig, fm = gid * WGM, gsz = (nM - fm) < WGM ? (nM - fm) : WGM;
        u.pm = fm + ((wgid % nig) % gsz); u.pn = (wgid % nig) / gsz; u.half = hf;
        const int pnd = u.pn;
        if (remap == 1) u.pn = (u.pn < 16) ? u.pn : (u.pn < 28 ? u.pn + 4 : 52);
        else if (remap == 2) u.pn = (u.pn < 4) ? 16 + u.pn : 28 + u.pn;
        else if (remap == 3) u.pn = (u.pn < 4) ? 16 + u.pn : 32 + u.pn;
        else if (remap == 4) u.pn = 32 + u.pn;
        const size_t ho = (pair && hf) ? hoff : 0; u.A = A + (size_t)u.pm * tA + ho; u.B = B + (size_t)(remap == 3 ? pnd : u.pn) * tB + ho; return true;
    }
};
struct SchedTwo {
    SchedPlain a, b; int na, nextra, G, c;
    __device__ __forceinline__ bool next(int i, Unit& u) const {
        const long L = (long)i * G + c;
        if (L < na) { SchedPlain t = a; t.G = 1; t.c = 0; t.ubeg = (int)L; t.uend = (int)L + 1; return t.next(0, u); }
        if (L < na + nextra) { SchedPlain t = b; t.G = 1; t.c = 0; t.ubeg = (int)(L - na); t.uend = t.ubeg + 1; return t.next(0, u); }
        return false;
    }
};
struct SchedMoe {
    int G, c; const char* A; const char* B; size_t tA, tB;
    __device__ __forceinline__ bool next(int i, Unit& u) const {
        const long L = (long)i * G + c; if (L >= 1024) return false;
        const int e = (int)L >> 6, r = (int)L & 63, pn = r >> 3, q = r & 7, b = q >> 1, hf = q & 1;
        u.pm = (b * 16 + e) * 2 + hf; u.pn = pn; u.half = 1; u.A = A + (size_t)u.pm * tA; u.B = B + (size_t)(e * 8 + pn) * tB; return true;
    }
};

struct SchedMoeG {
    const char* A; const char* B; size_t tB; const int* idx; int e, pm, pn0;
    __device__ __forceinline__ bool next(int i, Unit& u) const { if (i >= 4) return false; u.pm = pm; u.pn = pn0 + i; u.half = 1; u.A = A; u.B = B + (size_t)(e * 8 + pn0 + i) * tB; return true; }
};

template <class Epi, class Sched, bool MID, bool F8 = false, bool GATHER = false>
__device__ __forceinline__ void gemm_phase(LAS unsigned char* lds, const int K, const int lda, const int ldb, const Sched& S, const Epi& E) {
    int tid = threadIdx.x; asm volatile("" : "+v"(tid));
    const int wid = __builtin_amdgcn_readfirstlane(tid >> 6), lane = tid & 63, wr = wid >> 2, wc = wid & 3, fr = lane & 15, fq = lane >> 4;
    const int nt = K / BK;
    unsigned voffA[2], voffA1[2], voffB[2];
#pragma unroll
    for (int i = 0; i < 2; ++i) { int R, C; stage_rc(tid * 16 + i * 8192, R, C); const int Rb = Epi::PERM ? ((R & ~31) + perm32(R & 31)) : R;
        if constexpr (GATHER) { voffA[i] = (unsigned)(S.idx[R] * lda + C) * 2u; voffA1[i] = (unsigned)(S.idx[HALF + R] * lda + C) * 2u; }
        else { voffA[i] = (unsigned)(R * lda + C) * 2u; voffA1[i] = 0u; }
        voffB[i] = (unsigned)(Rb * ldb + C) * 2u; }
    const size_t kstep = (size_t)(BK * 2);
    const size_t hstepA = (size_t)HALF * lda * 2, hstepB = (size_t)HALF * ldb * 2;
    const unsigned ldsw = (unsigned)wid * 1024u;
    const int aoff = F8 ? lds_byte(wr * 64 + fr, 32 * (fq >> 1) + 16 * (fq & 1)) : lds_byte(wr * 64 + fr, fq * 8), boff = F8 ? lds_byte(wc * 32 + fr, 32 * (fq >> 1) + 16 * (fq & 1)) : lds_byte(wc * 32 + fr, fq * 8);
#define PG8_SA(b, h) (((b) * 2 + (h)) * HTB)
#define PG8_SB(b, h) ((4 + (b) * 2 + (h)) * HTB)
#define PG8_STAGE(bufoff, gbase, voff) do { _Pragma("unroll") for (int _i = 0; _i < 2; ++_i) \
        __builtin_amdgcn_global_load_lds((const unsigned*)((const char*)(gbase) + (voff)[_i]), (LAS unsigned*)(lds + (bufoff) + ldsw + _i * 8192), 16, 0, 0); } while (0)
#define PG8_STAGE_A1(bufoff, gbase) do { if constexpr (GATHER) PG8_STAGE(bufoff, gbase, voffA1); else PG8_STAGE(bufoff, (gbase) + hstepA, voffA); } while (0)
#define PG8_LDA(dst, b, h) do { if constexpr (F8) { _Pragma("unroll") for (int m = 0; m < 4; ++m) { const v4i lo_ = *(const LAS v4i*)(lds + PG8_SA(b, h) + aoff + m * 2048), hi_ = *(const LAS v4i*)(lds + PG8_SA(b, h) + aoff + m * 2048 + 16); \
            dst##8[m] = __builtin_shufflevector(lo_, hi_, 0, 1, 2, 3, 4, 5, 6, 7); } } \
        else { _Pragma("unroll") for (int m = 0; m < 4; ++m) _Pragma("unroll") for (int k = 0; k < 2; ++k) dst[m][k] = *(const LAS bf16x8*)(lds + PG8_SA(b, h) + aoff + m * 2048 + k * 1024); } } while (0)
#define PG8_LDB(dst, b, h) do { if constexpr (F8) { _Pragma("unroll") for (int n = 0; n < 2; ++n) { const v4i lo_ = *(const LAS v4i*)(lds + PG8_SB(b, h) + boff + n * 2048), hi_ = *(const LAS v4i*)(lds + PG8_SB(b, h) + boff + n * 2048 + 16); \
            dst##8[n] = __builtin_shufflevector(lo_, hi_, 0, 1, 2, 3, 4, 5, 6, 7); } } \
        else { _Pragma("unroll") for (int n = 0; n < 2; ++n) _Pragma("unroll") for (int k = 0; k < 2; ++k) dst[n][k] = *(const LAS bf16x8*)(lds + PG8_SB(b, h) + boff + n * 2048 + k * 1024); } } while (0)
#define PG8_MMA(ai, bj, At, Bt) do { __builtin_amdgcn_s_setprio(1); if constexpr (F8) { _Pragma("unroll") for (int m = 0; m < 4; ++m) _Pragma("unroll") for (int n = 0; n < 2; ++n) \
        asm volatile("v_mfma_scale_f32_16x16x128_f8f6f4 %0, %1, %2, %0, %3, %3 op_sel_hi:[0,0,0]" : "+v"(acc[ai][bj][m][n]) : "v"(Bt##8[n]), "v"(At##8[m]), "v"(sc8)); } \
        else { _Pragma("unroll") for (int m = 0; m < 4; ++m) _Pragma("unroll") for (int n = 0; n < 2; ++n) _Pragma("unroll") for (int k = 0; k < 2; ++k) \
        acc[ai][bj][m][n] = __builtin_amdgcn_mfma_f32_16x16x32_bf16(Bt[n][k], At[m][k], acc[ai][bj][m][n], 0, 0, 0); } __builtin_amdgcn_s_setprio(0); } while (0)
#define PG8_WAIT_V(n) asm volatile("s_waitcnt vmcnt(" #n ")" ::: "memory")
#define PG8_WAIT_L(n) asm volatile("s_waitcnt lgkmcnt(" #n ")" ::: "memory")
#define PG8_BAR __builtin_amdgcn_s_barrier()
#define PG8_SCHED __builtin_amdgcn_sched_barrier(0)
    Unit cur, nxt; int ui = 0;
    if (!S.next(0, cur)) return;
    f32x4 acc[2][2][4][2];
#pragma unroll
    for (int a = 0; a < 2; ++a)
#pragma unroll
        for (int b = 0; b < 2; ++b)
#pragma unroll
            for (int m = 0; m < 4; ++m)
#pragma unroll
                for (int n = 0; n < 2; ++n) acc[a][b][m][n] = (f32x4){0.f, 0.f, 0.f, 0.f};
    bf16x8 At[4][2], B0[2][2], B1[2][2]; v8i At8[4], B08[2], B18[2]; const int sc8 = 0x7F7F7F7F;
    const char* cA = cur.A; const char* cB = cur.B;
    PG8_STAGE(PG8_SB(0, 0), cB, voffB); PG8_STAGE(PG8_SB(0, 1), cB + hstepB, voffB); PG8_STAGE(PG8_SA(0, 0), cA, voffA); PG8_STAGE_A1(PG8_SA(0, 1), cA);
    if (wr == 1) PG8_BAR;
    PG8_WAIT_V(2); PG8_BAR;
    PG8_STAGE(PG8_SB(1, 0), cB + kstep, voffB); PG8_STAGE(PG8_SA(1, 0), cA + kstep, voffA); PG8_STAGE(PG8_SB(1, 1), cB + hstepB + kstep, voffB);
    PG8_WAIT_V(6); PG8_BAR;
    for (;;) {
        const bool has_next = S.next(ui + 1, nxt);
        const char* nA = has_next ? nxt.A : cA; const char* nB = has_next ? nxt.B : cB;
#pragma unroll 1
        for (int t = 0; t < nt; t += 2) {
            const bool last = (t == nt - 2);
            const char* a1 = cA + (size_t)(t + 1) * kstep;
            const char* a2 = last ? nA : cA + (size_t)(t + 2) * kstep; const char* b2 = last ? nB : cB + (size_t)(t + 2) * kstep;
            const char* a3 = a2 + kstep; const char* b3 = b2 + kstep;
            PG8_LDB(B0, 0, 0); PG8_LDB(B1, 0, 1); PG8_SCHED; PG8_LDA(At, 0, 0); PG8_STAGE_A1(PG8_SA(1, 1), a1);
            PG8_WAIT_V(8); PG8_WAIT_L(0); PG8_BAR; PG8_MMA(0, 0, At, B0); PG8_MMA(0, 1, At, B1); PG8_BAR; PG8_SCHED;
            PG8_LDA(At, 0, 1); PG8_STAGE(PG8_SB(0, 0), b2, voffB); PG8_STAGE(PG8_SB(0, 1), b2 + hstepB, voffB); PG8_STAGE(PG8_SA(0, 0), a2, voffA);
            PG8_WAIT_V(8); PG8_WAIT_L(0); PG8_BAR; PG8_MMA(1, 0, At, B0); PG8_MMA(1, 1, At, B1); PG8_BAR; PG8_SCHED;
            PG8_LDB(B0, 1, 0); PG8_LDB(B1, 1, 1); PG8_SCHED; PG8_LDA(At, 1, 0); PG8_STAGE_A1(PG8_SA(0, 1), a2);
            PG8_WAIT_V(8); PG8_WAIT_L(0); PG8_BAR; PG8_MMA(0, 0, At, B0); PG8_MMA(0, 1, At, B1); PG8_BAR; PG8_SCHED;
            PG8_LDA(At, 1, 1); PG8_STAGE(PG8_SB(1, 0), b3, voffB); PG8_STAGE(PG8_SB(1, 1), b3 + hstepB, voffB); PG8_STAGE(PG8_SA(1, 0), a3, voffA);
            PG8_WAIT_V(8); PG8_WAIT_L(0); PG8_BAR; PG8_MMA(1, 0, At, B0); PG8_MMA(1, 1, At, B1); PG8_BAR; PG8_SCHED;
        }
        if (wr == 0) PG8_BAR;
        if constexpr (F8) asm volatile("s_nop 15\n\ts_nop 15" ::: "memory");
        bool fin = true;
        int fr_e = fr, fq_e = fq; asm volatile("" : "+v"(fr_e), "+v"(fq_e));
        if constexpr (MID) { fin = (cur.half != 0); if (!fin) E.mid(acc, cur, wr, wc, fr_e, fq_e); }
        if (fin) E(acc, cur, wr, wc, fr_e, fq_e);
        if (!has_next) break;
        if (fin) {
#pragma unroll
        for (int a = 0; a < 2; ++a)
#pragma unroll
            for (int b = 0; b < 2; ++b)
#pragma unroll
                for (int m = 0; m < 4; ++m)
#pragma unroll
                    for (int n = 0; n < 2; ++n) acc[a][b][m][n] = (f32x4){0.f, 0.f, 0.f, 0.f};
        }
        cur = nxt; cA = nA; cB = nB; ++ui;
        if (wr == 1) PG8_BAR;
    }
    PG8_WAIT_V(0);
    PG8_BAR;
#undef PG8_SA
#undef PG8_SB
#undef PG8_STAGE
#undef PG8_STAGE_A1
#undef PG8_LDA
#undef PG8_LDB
#undef PG8_MMA
#undef PG8_WAIT_V
#undef PG8_WAIT_L
#undef PG8_BAR
#undef PG8_SCHED
}

struct EpiP {
    static constexpr bool PERM = true;
    bf16_t* P; float* AB; float osc;
    __device__ __forceinline__ void operator()(const f32x4 (&acc)[2][2][4][2], const Unit& u, int wr, int wc, int fr, int fq) const {
        const int row0 = u.pm * BM + wr * 64 + fr;
        if (u.pn >= 20 && u.pn < 32) {
            const int ten = (u.pn - 20) >> 2, hb = ((u.pn - 20) & 3) * 2, c = wc * 32 + 8 * fq; bf16_t* GBp = P + GB_OFF;
#pragma unroll
            for (int ai = 0; ai < 2; ++ai)
#pragma unroll
                for (int m = 0; m < 4; ++m) { const int row = row0 + ai * HALF + m * 16; int b, tok, p, ch, ccb, nch;
                    if (row < MLAT) { b = row >> 12; const int rs = row & 4095; tok = CTXL + (rs & 63) * 64 + (rs >> 6); p = rs >> 6; ch = rs & 63; ccb = 4; nch = 64; }
                    else { const int r = row - MLAT; b = r >> 8; tok = r & 255; p = tok & 63; ch = tok >> 6; ccb = 0; nch = 4; }
                    int ht = -1, hr = 0;
                    if (p >= 62 && ch + 1 < nch) { ht = ccb + ch + 1; hr = p - 62; } else if (p < 2 && ch > 0) { ht = ccb + ch - 1; hr = 2 + p; }
#pragma unroll
                    for (int bj = 0; bj < 2; ++bj) { const f32x4 v0 = acc[ai][bj][m][0] * osc, v1 = acc[ai][bj][m][1] * osc;
                        u32x4 w; w.x = cvt_pk_bf16(v0[0], v0[1]); w.y = cvt_pk_bf16(v0[2], v0[3]); w.z = cvt_pk_bf16(v1[0], v1[1]); w.w = cvt_pk_bf16(v1[2], v1[3]);
                        *(u32x4*)(GBp + ((size_t)((b * 8 + hb + bj) * GTOK + tok)) * 384 + ten * 128 + c) = w;
                        if (ht >= 0) *(u32x4*)((bf16_t*)((unsigned char*)P + (WS_HALO - WS_P)) + ((size_t)(((b * 8 + hb + bj) * 68 + ht) * 4 + hr)) * 384 + ten * 128 + c) = w; } }
        } else if (u.pn < 52) {
            const int col0 = (u.pn < 20 ? u.pn : u.pn - 12) * BM + wc * 32 + 8 * fq;
#pragma unroll
            for (int ai = 0; ai < 2; ++ai)
#pragma unroll
                for (int m = 0; m < 4; ++m) { bf16_t* rowp = P + (size_t)(row0 + ai * HALF + m * 16) * PC + col0;
#pragma unroll
                    for (int bj = 0; bj < 2; ++bj) { const f32x4 v0 = acc[ai][bj][m][0] * osc, v1 = acc[ai][bj][m][1] * osc;
                        u32x4 w; w.x = cvt_pk_bf16(v0[0], v0[1]); w.y = cvt_pk_bf16(v0[2], v0[3]); w.z = cvt_pk_bf16(v1[0], v1[1]); w.w = cvt_pk_bf16(v1[2], v1[3]);
                        *(u32x4*)(rowp + bj * HALF) = w; } }
        } else if (wc == 0) {
#pragma unroll
            for (int ai = 0; ai < 2; ++ai)
#pragma unroll
                for (int m = 0; m < 4; ++m) { float* rp = AB + (size_t)(row0 + ai * HALF + m * 16) * 32 + 8 * fq;
                    *(f32x4*)rp = acc[ai][0][m][0]; *(f32x4*)(rp + 4) = acc[ai][0][m][1]; }
        }
    }
};
struct EpiMerge {
    static constexpr bool PERM = true;
    const bf16_t* P; bf16_t* T;
    __device__ __forceinline__ void mid(f32x4 (&acc)[2][2][4][2], const Unit& u, int wr, int wc, int fr, int fq) const {
        const bf16_t* base = P + (size_t)(u.pm * BM + wr * 64 + fr) * PC + (u.pn * BM + wc * 32 + 8 * fq);
#pragma unroll
        for (int ai = 0; ai < 2; ++ai) {
            u32x4 xa[4][2], xb[4][2];
#pragma unroll
            for (int m = 0; m < 4; ++m)
#pragma unroll
                for (int bj = 0; bj < 2; ++bj) { const bf16_t* rowp = base + (size_t)(ai * HALF + m * 16) * PC + bj * HALF; xa[m][bj] = *(const u32x4*)(rowp + C_GA); xb[m][bj] = *(const u32x4*)(rowp + C_GB); }
#pragma unroll
            for (int m = 0; m < 4; ++m)
#pragma unroll
                for (int bj = 0; bj < 2; ++bj) {
                    const unsigned wa[4] = {xa[m][bj].x, xa[m][bj].y, xa[m][bj].z, xa[m][bj].w}, wb[4] = {xb[m][bj].x, xb[m][bj].y, xb[m][bj].z, xb[m][bj].w};
#pragma unroll
                    for (int j = 0; j < 4; ++j) {
                        const float r0 = (1.f + __expf(-bflo(wb[j]))) * __builtin_amdgcn_rcpf(1.f + __expf(-bflo(wa[j]))), r1 = (1.f + __expf(-bfhi(wb[j]))) * __builtin_amdgcn_rcpf(1.f + __expf(-bfhi(wa[j])));
                        acc[ai][bj][m][j >> 1][(j & 1) * 2] *= r0; acc[ai][bj][m][j >> 1][(j & 1) * 2 + 1] *= r1; } }
            asm volatile("" ::: "memory"); }
    }
    __device__ __forceinline__ void operator()(const f32x4 (&acc)[2][2][4][2], const Unit& u, int wr, int wc, int fr, int fq) const {
        const int row0 = u.pm * BM + wr * 64 + fr, col0 = u.pn * BM + wc * 32 + 8 * fq;
#pragma unroll
        for (int ai = 0; ai < 2; ++ai) {
            u32x4 xb[4][2];
#pragma unroll
            for (int m = 0; m < 4; ++m)
#pragma unroll
                for (int bj = 0; bj < 2; ++bj) xb[m][bj] = *(const u32x4*)(P + (size_t)(row0 + ai * HALF + m * 16) * PC + col0 + C_GB + bj * HALF);
#pragma unroll
            for (int m = 0; m < 4; ++m) { const size_t row = (size_t)(row0 + ai * HALF + m * 16);
#pragma unroll
                for (int bj = 0; bj < 2; ++bj) {
                    const unsigned wb[4] = {xb[m][bj].x, xb[m][bj].y, xb[m][bj].z, xb[m][bj].w}; float g[8];
#pragma unroll
                    for (int j = 0; j < 4; ++j) { g[2 * j] = sigmoid_f(bflo(wb[j])); g[2 * j + 1] = sigmoid_f(bfhi(wb[j])); }
                    const f32x4 v0 = acc[ai][bj][m][0], v1 = acc[ai][bj][m][1];
                    u32x4 w; w.x = cvt_pk_bf16(v0[0] * g[0], v0[1] * g[1]); w.y = cvt_pk_bf16(v0[2] * g[2], v0[3] * g[3]); w.z = cvt_pk_bf16(v1[0] * g[4], v1[1] * g[5]); w.w = cvt_pk_bf16(v1[2] * g[6], v1[3] * g[7]);
                    *(u32x4*)(T + row * D + col0 + bj * HALF) = w; } }
            asm volatile("" ::: "memory"); }
    }
};
struct EpiX1 {
    static constexpr bool PERM = false;
    const float* x; const modfx_t* mod; const float* ada_b; bf16_t* X1;
    __device__ __forceinline__ void operator()(const f32x4 (&acc)[2][2][4][2], const Unit& u, int wr, int wc, int fr, int fq) const {
        const int row0 = u.pm * BM + wr * 64 + fr, col0 = u.pn * BM + wc * 32 + 4 * fq, b = u.pm >> 4;
        f32x4 mv[2][2];
#pragma unroll
        for (int bj = 0; bj < 2; ++bj)
#pragma unroll
            for (int n = 0; n < 2; ++n) { const int c = col0 + bj * HALF + n * 16; mv[bj][n] = mod4(mod, (size_t)b * 12288 + 2 * D + c) + *(const f32x4*)(ada_b + 2 * D + c); }
#pragma unroll
        for (int ai = 0; ai < 2; ++ai) {
            f32x4 xi[4][2][2];
#pragma unroll
            for (int m = 0; m < 4; ++m)
#pragma unroll
                for (int bj = 0; bj < 2; ++bj)
#pragma unroll
                    for (int n = 0; n < 2; ++n) xi[m][bj][n] = *(const f32x4*)(x + (size_t)(row0 + ai * HALF + m * 16) * D + col0 + bj * HALF + n * 16);
#pragma unroll
            for (int m = 0; m < 4; ++m) { const size_t off = (size_t)(row0 + ai * HALF + m * 16) * D + col0;
#pragma unroll
                for (int bj = 0; bj < 2; ++bj)
#pragma unroll
                    for (int n = 0; n < 2; ++n) { const f32x4 o = xi[m][bj][n] + mv[bj][n] * acc[ai][bj][m][n];
                        *(u32x2*)(X1 + off + bj * HALF + n * 16) = (u32x2){cvt_pk_bf16(o[0], o[1]), cvt_pk_bf16(o[2], o[3])}; } }
            asm volatile("" ::: "memory"); }
    }
};
struct EpiHact {
    static constexpr bool PERM = true;
    unsigned char* H;
    __device__ __forceinline__ void operator()(const f32x4 (&acc)[2][2][4][2], const Unit& u, int wr, int wc, int fr, int fq) const {
        const int row0 = u.pm * BM + wr * 64 + fr, col0 = u.pn * HALF + wc * 32 + 8 * fq;
#pragma unroll
        for (int ai = 0; ai < 2; ++ai)
#pragma unroll
            for (int m = 0; m < 4; ++m) { const f32x4 a0 = acc[ai][0][m][0] * (1.f / W8_SCALE), a1 = acc[ai][0][m][1] * (1.f / W8_SCALE), u0 = acc[ai][1][m][0] * (1.f / W8_SCALE), u1 = acc[ai][1][m][1] * (1.f / W8_SCALE);
                u32x2 w; w.x = pk4_fp8(silu_f(a0[0]) * u0[0], silu_f(a0[1]) * u0[1], silu_f(a0[2]) * u0[2], silu_f(a0[3]) * u0[3]);
                w.y = pk4_fp8(silu_f(a1[0]) * u1[0], silu_f(a1[1]) * u1[1], silu_f(a1[2]) * u1[2], silu_f(a1[3]) * u1[3]);
                *(u32x2*)(H + (size_t)(row0 + ai * HALF + m * 16) * DE + col0) = w; }
    }
};
struct EpiYE {
    static constexpr bool PERM = true;
    const float* gatev; bf16_t* Y;
    __device__ __forceinline__ void operator()(const f32x4 (&acc)[2][2][4][2], const Unit& u, int wr, int wc, int fr, int fq) const {
        const int row0 = u.pm * BM + wr * 64 + fr, col0 = u.pn * BM + wc * 32 + 8 * fq;
        float g[2][4];
#pragma unroll
        for (int ai = 0; ai < 2; ++ai)
#pragma unroll
            for (int m = 0; m < 4; ++m) g[ai][m] = gatev[row0 + ai * HALF + m * 16] * (1.f / W8_SCALE);
#pragma unroll
        for (int ai = 0; ai < 2; ++ai)
#pragma unroll
            for (int m = 0; m < 4; ++m) { const int row = row0 + ai * HALF + m * 16;
#pragma unroll
                for (int bj = 0; bj < 2; ++bj) { const f32x4 v0 = acc[ai][bj][m][0] * g[ai][m], v1 = acc[ai][bj][m][1] * g[ai][m];
                    u32x4 w; w.x = cvt_pk_bf16(v0[0], v0[1]); w.y = cvt_pk_bf16(v0[2], v0[3]); w.z = cvt_pk_bf16(v1[0], v1[1]); w.w = cvt_pk_bf16(v1[2], v1[3]);
                    *(u32x4*)(Y + (size_t)row * D + col0 + bj * HALF) = w; } }
    }
};
}

__device__ __forceinline__ void tr_item(const float* W, int ldw, int k0, int n0, bf16_t* WT, size_t dst_row, int ldk, int koff, LAS float* scr, int lane, const bool f8 = false) {
    f32x4 v[8];
#pragma unroll
    for (int i = 0; i < 8; ++i) v[i] = *(const f32x4*)(W + (size_t)(k0 + 8 * i + (lane >> 3)) * ldw + n0 + (lane & 7) * 4);
#pragma unroll
    for (int i = 0; i < 8; ++i) { LAS float* p = scr + (8 * i + (lane >> 3)) * 33 + (lane & 7) * 4; p[0] = v[i].x; p[1] = v[i].y; p[2] = v[i].z; p[3] = v[i].w; }
    LDS_WAIT(); asm volatile("" ::: "memory");
    const int c = lane & 7;
    if (!f8) {
#pragma unroll
    for (int j = 0; j < 4; ++j) { const int n = (lane >> 3) + 8 * j; const LAS float* s = scr + (8 * c) * 33 + n;
        u32x4 o; o.x = pk2(s[0 * 33], s[1 * 33]); o.y = pk2(s[2 * 33], s[3 * 33]); o.z = pk2(s[4 * 33], s[5 * 33]); o.w = pk2(s[6 * 33], s[7 * 33]);
        *(u32x4*)(WT + (dst_row + n) * (size_t)ldk + koff + k0 + 8 * c) = o; }
    } else {
#pragma unroll
    for (int j = 0; j < 4; ++j) { const int n = (lane >> 3) + 8 * j; const LAS float* s = scr + (8 * c) * 33 + n;
        u32x2 o; o.x = pk4_fp8(s[0 * 33] * W8_SCALE, s[1 * 33] * W8_SCALE, s[2 * 33] * W8_SCALE, s[3 * 33] * W8_SCALE); o.y = pk4_fp8(s[4 * 33] * W8_SCALE, s[5 * 33] * W8_SCALE, s[6 * 33] * W8_SCALE, s[7 * 33] * W8_SCALE);
        *(u32x2*)((unsigned char*)WT + (dst_row + n) * (size_t)ldk + koff + k0 + 8 * c) = o; }
    }
    LDS_WAIT(); asm volatile("" ::: "memory");
}

#define TRQ_ROW(r_) ((r_) * 33 + (((r_) >> 6) << 2))
__device__ __forceinline__ void trq_load(f32x4 (&v)[16], const float* Wt, const int ldw, const unsigned lo) {
#pragma unroll
    for (int i = 0; i < 16; ++i) v[i] = *(const f32x4*)((const unsigned char*)(Wt + (size_t)(8 * i) * ldw) + lo);
}
__device__ __forceinline__ void trq_proc(const f32x4 (&v)[16], unsigned char* Ot, const int ldk, LAS float* scr, const int lane) {
#pragma unroll
    for (int i = 0; i < 16; ++i) { LAS float* p = scr + TRQ_ROW(8 * i + (lane >> 3)) + (lane & 7) * 4; p[0] = v[i].x; p[1] = v[i].y; p[2] = v[i].z; p[3] = v[i].w; }
    LDS_WAIT(); asm volatile("" ::: "memory");
    const int c = lane & 15; const unsigned so = (unsigned)((lane >> 4) * ldk + 8 * c);
#pragma unroll
    for (int j = 0; j < 8; ++j) { const int n = (lane >> 4) + 4 * j; const LAS float* s = scr + TRQ_ROW(8 * c) + n;
        u32x2 o; o.x = pk4_fp8(s[0 * 33] * W8_SCALE, s[1 * 33] * W8_SCALE, s[2 * 33] * W8_SCALE, s[3 * 33] * W8_SCALE); o.y = pk4_fp8(s[4 * 33] * W8_SCALE, s[5 * 33] * W8_SCALE, s[6 * 33] * W8_SCALE, s[7 * 33] * W8_SCALE);
        *(u32x2*)(Ot + (size_t)(4 * j) * ldk + so) = o; }
    LDS_WAIT(); asm volatile("" ::: "memory");
}
struct TrqItem { const float* Wt; unsigned char* Ot; int ldw, ldk; };
__device__ __forceinline__ TrqItem trq_item(const Args& a, const int cv) {
    TrqItem t; const int which = cv >> 13, r = cv & 8191, e = r >> 9, q = r & 511;
    if (which < 2) { const int kb = q >> 5, nb = q & 31, n0 = nb * 32, k0 = kb * 128; t.ldw = DE; t.ldk = D;
        t.Wt = (which ? a.w_up : a.w_gate) + (size_t)e * D * DE + (size_t)k0 * DE + n0;
        t.Ot = a.ws + WS_R2 + ((size_t)e * 2048 + (n0 >> 7) * 256 + (n0 & 127) + which * 128) * (size_t)D + k0; }
    else { const int kb = q >> 6, nb = q & 63, n0 = nb * 32, k0 = kb * 128; t.ldw = D; t.ldk = DE;
        t.Wt = a.w_down + (size_t)e * DE * D + (size_t)k0 * D + n0; t.Ot = a.ws + WS_R2 + 67108864 + ((size_t)e * 2048 + n0) * (size_t)DE + k0; }
    return t;
}
__device__ __forceinline__ void trq_drain(const Args& a, LAS unsigned char* lds, const int maxb, const unsigned qlim, const int fixed) {
    const int lane = threadIdx.x & 63, wave = __builtin_amdgcn_readfirstlane(threadIdx.x >> 6); LAS float* scr = (LAS float*)(lds + wave * 16912);
    unsigned* qctr = (unsigned*)(a.ws + WS_BAR + 14336 + 240); volatile LAS unsigned* qb = (volatile LAS unsigned*)(lds + LDS_BYTES - 32);
    for (int nb_ = 0; nb_ < maxb; ++nb_) {
        unsigned bt;
        if (fixed >= 0) { bt = (unsigned)fixed; __syncthreads(); }
        else { __syncthreads();
            if (threadIdx.x == 0) qb[0] = atomicAdd(qctr, 1u);
            __syncthreads();
            bt = __builtin_amdgcn_readfirstlane(qb[0]); if (bt >= qlim) break; }
        const int cv0 = (int)bt * 32 + wave * 4;
        const TrqItem t0 = trq_item(a, cv0);
        const unsigned lo = (unsigned)(((lane >> 3) * t0.ldw + (lane & 7) * 4) * 4);
        const size_t ostep = (size_t)32 * t0.ldk;
        f32x4 va[16], vb[16];
        trq_load(va, t0.Wt, t0.ldw, lo);
        trq_load(vb, t0.Wt + 32, t0.ldw, lo);
        trq_proc(va, t0.Ot, t0.ldk, scr, lane);
        trq_load(va, t0.Wt + 64, t0.ldw, lo);
        trq_proc(vb, t0.Ot + ostep, t0.ldk, scr, lane);
        trq_load(vb, t0.Wt + 96, t0.ldw, lo);
        trq_proc(va, t0.Ot + 2 * ostep, t0.ldk, scr, lane);
        trq_proc(vb, t0.Ot + 3 * ostep, t0.ldk, scr, lane);
    }
    __syncthreads();
}

__device__ __forceinline__ void conv_small(const Args& a, LAS unsigned char* lds, const int gw, const int ngw) {
    const int lane = threadIdx.x & 63, wave = threadIdx.x >> 6; LAS float* scr = (LAS float*)(lds + wave * 16384);
    bf16_t* WabT = (bf16_t*)(a.ws + WS_WAB); bf16_t* WoutT = (bf16_t*)(a.ws + WS_WOUT);
    constexpr int I_BA = 16 * 64, I_OUT = 32 * 64;
    for (int it = gw; it < 2 * I_BA + I_OUT; it += ngw) {
        int r = it;
        if (r < I_BA) { tr_item(a.w_ba, D, (r >> 6) * 64, (r & 63) * 32, WabT, (r & 63) * 32, D, 0, scr, lane); continue; }
        r -= I_BA;
        if (r < I_BA) { tr_item(a.w_bb, D, (r >> 6) * 64, (r & 63) * 32, WabT, (r & 63) * 32, D, 1024, scr, lane); continue; }
        r -= I_BA;
        tr_item(a.w_out, D, (r >> 6) * 64, (r & 63) * 32, WoutT, (r & 63) * 32, D, 0, scr, lane);
    }
}

__device__ __forceinline__ void phase_prep(const Args& a, LAS unsigned char* lds) {
    const int tid = threadIdx.x, lane = tid & 63, wave = tid >> 6, G = gridDim.x;
    int* MOD = (int*)(a.ws + WS_MOD);
    LAS float* sc = (LAS float*)lds;
    for (int it = blockIdx.x; it < 256; it += G) {
        const int ks = it >> 3, cb = it & 7, k0 = ks * 64;
        __syncthreads();
        if (tid < 320) { const int v = tid >> 6, r = tid & 63; const float cv = (v < 4) ? a.c[v * D + k0 + r] : a.c_ctx[k0 + r]; sc[v * 64 + r] = silu_f(cv); }
        __syncthreads();
        float acc[5][3];
#pragma unroll
        for (int v = 0; v < 5; ++v)
#pragma unroll
            for (int i = 0; i < 3; ++i) acc[v][i] = 0.f;
        const float* wp = a.ada_w + (size_t)k0 * 12288 + cb * 1536 + tid;
#pragma unroll 8
        for (int r = 0; r < 64; ++r) {
            const float w0 = wp[(size_t)r * 12288], w1 = wp[(size_t)r * 12288 + 512], w2 = wp[(size_t)r * 12288 + 1024];
#pragma unroll
            for (int v = 0; v < 5; ++v) { const float s = sc[v * 64 + r]; acc[v][0] += s * w0; acc[v][1] += s * w1; acc[v][2] += s * w2; }
        }
#pragma unroll
        for (int v = 0; v < 5; ++v)
#pragma unroll
            for (int i = 0; i < 3; ++i) atomicAdd(MOD + v * 12288 + cb * 1536 + tid + 512 * i, __float2int_rn(acc[v][i] * 268435456.f));
    }
    __syncthreads();
    LAS float* scr = (LAS float*)(lds + wave * 16384);
    const int gw = blockIdx.x * NWAVES + wave, NGW = G * NWAVES;
    bf16_t* WinT = (bf16_t*)(a.ws + WS_R1 + R1_WINT);
    constexpr int I_IN = 32 * 417;
    for (int it = gw; it < I_IN; it += NGW) {
        const int r = it;
        { const int kb = r / 417, nb = r % 417, n0 = nb * 32; const size_t dr = (n0 < 9216) ? n0 : (n0 == 9216 ? 13312 : n0 - 32);
            if (dr >= 4096 && dr < 5120) tr_item(a.w_in, NIN, kb * 64, n0, (bf16_t*)(a.ws + WS_WIN8), dr - 4096, D, 0, scr, lane, true);
            else if (dr >= 9216 && dr < 13312) tr_item(a.w_in, NIN, kb * 64, n0, (bf16_t*)(a.ws + WS_WIN8), 1024 + (dr - 9216), D, 0, scr, lane, true);
            else tr_item(a.w_in, NIN, kb * 64, n0, WinT, dr, D, 0, scr, lane); }
    }
    if (G < 256) conv_small(a, lds, gw, NGW);
    { u32x4* z = (u32x4*)(WinT + (size_t)13344 * D); const int n16 = 224 * D * 2 / 16;
      for (int i = blockIdx.x * NTHR + tid; i < n16; i += G * NTHR) z[i] = (u32x4){0u, 0u, 0u, 0u}; }
}

template <bool LAT>
__device__ __forceinline__ void norm1_row(const Args& a, const f32x4 (&v)[8], const LAS unsigned char* lds, const int r, const int lane) {
    bf16_t* H = (bf16_t*)(a.ws + WS_R1 + R1_H);
    float ss = 0.f;
#pragma unroll
    for (int j = 0; j < 8; ++j) ss += (v[j].x * v[j].x + v[j].y * v[j].y) + (v[j].z * v[j].z + v[j].w * v[j].w);
    const float rstd = rsqrtf(wave_sum(ss) * (1.f / D) + EPS);
#pragma unroll
    for (int j = 0; j < 8; ++j) { const int c = lane * 4 + 256 * j;
        const f32x4 h = v[j] * rstd * *(const LAS f32x4*)(lds + c * 4) + *(const LAS f32x4*)(lds + 8192 + c * 4);
        u32x2 w; w.x = pk2(h.x, h.y); w.y = pk2(h.z, h.w);
        *(u32x2*)(H + (size_t)r * D + c) = w;
        if constexpr (LAT) *(unsigned*)(a.ws + WS_R2 + R2_H8 + (size_t)r * D + c) = pk4_fp8(h.x, h.y, h.z, h.w); }
}
__device__ __forceinline__ void norm1_mod(const Args& a, LAS unsigned char* lds, const int mv) {
    const modfx_t* MOD = (const modfx_t*)(a.ws + WS_MOD);
    const int c = threadIdx.x * 4;
    const f32x4 nm = *(const f32x4*)(a.norm_mix + c);
    const f32x4 sh = mod4(MOD, mv * 12288 + c) + *(const f32x4*)(a.ada_b + c);
    const f32x4 scl = mod4(MOD, mv * 12288 + D + c) + *(const f32x4*)(a.ada_b + D + c);
    __syncthreads();
    *(LAS f32x4*)(lds + c * 4) = nm * (scl + 1.f); *(LAS f32x4*)(lds + 8192 + c * 4) = sh;
    __syncthreads();
}
__device__ __forceinline__ void phase_norm1(const Args& a, LAS unsigned char* lds) {
    int tid = threadIdx.x; asm volatile("" : "+v"(tid));
    const int lane = tid & 63, wave = tid >> 6, G = gridDim.x;
    f32x4 v[8], vn[8];
    for (int blk = blockIdx.x; blk < MLAT / 64; blk += G) {
        const int r0 = blk * 64 + wave * 8;
#pragma unroll
        for (int j = 0; j < 8; ++j) v[j] = *(const f32x4*)(a.x + (size_t)r0 * D + lane * 4 + 256 * j);
        norm1_mod(a, lds, r0 >> 12);
#pragma unroll 1
        for (int k = 0; k < 8; ++k) {
            const int r = r0 + k, rn = r0 + (k < 7 ? k + 1 : 7);
#pragma unroll
            for (int j = 0; j < 8; ++j) vn[j] = *(const f32x4*)(a.x + (size_t)rn * D + lane * 4 + 256 * j);
            norm1_row<true>(a, v, lds, r, lane);
#pragma unroll
            for (int j = 0; j < 8; ++j) v[j] = vn[j];
        }
    }
    for (int i = blockIdx.x; i < MCTX / 4; i += G) {
        const int r = MLAT + 4 * i + (wave & 3);
#pragma unroll
        for (int j = 0; j < 8; ++j) v[j] = *(const f32x4*)(a.ctx + (size_t)(r - MLAT) * D + lane * 4 + 256 * j);
        norm1_mod(a, lds, 4);
        if (wave < 4) norm1_row<false>(a, v, lds, r, lane);
    }
}

__device__ __forceinline__ void scan_hgrn_naive(const Args& a, LAS unsigned char* lds, int b, int h, int dir) {
    const int tid = threadIdx.x, v = tid >> 2, dq = tid & 3, tok = tid >> 4, c8 = (tid & 15) * 8;
    LAS float* Lq = (LAS float*)lds; LAS float* Lk = Lq + 4096; LAS float* Lf = Lk + 4096; LAS float* Lv = Lf + 4096;
    const bf16_t* P = (const bf16_t*)(a.ws + WS_P);
    bf16_t* O = (bf16_t*)((unsigned char*)a.out + (dir ? R2_OAB : R2_OAF));
    float lo8[8];
#pragma unroll
    for (int j = 0; j < 8; ++j) { const int d = h * 128 + c8 + j; const float l0 = a.hgrn_lb[(dir * 2 + 0) * 1024 + d], l1 = a.hgrn_lb[(dir * 2 + 1) * 1024 + d]; lo8[j] = 1.f / (1.f + __expf(l1 - l0)); }
    float S[32];
#pragma unroll
    for (int i = 0; i < 32; ++i) S[i] = 0.f;
    const int cf = dir ? C_FB : C_FF;
    for (int p0 = 0; p0 < CTXL + SEQ; p0 += 32) {
        __syncthreads();
        { const int p = p0 + tok;
          const int row = (p < CTXL) ? (MLAT + b * CTXL + (dir ? CTXL - 1 - p : p)) : (b * SEQ + (dir ? SEQ - 1 - (p - CTXL) : (p - CTXL)));
          const bf16_t* pr = P + (size_t)row * PC + h * 128 + c8;
          const u32x4 rq = *(const u32x4*)(pr + C_HQ), rf = *(const u32x4*)(pr + cf), ri = *(const u32x4*)(pr + C_HI);
          const unsigned wq[4] = {rq.x, rq.y, rq.z, rq.w}, wf[4] = {rf.x, rf.y, rf.z, rf.w}, wi[4] = {ri.x, ri.y, ri.z, ri.w};
          float oq[8], ok[8], of[8], ov[8];
#pragma unroll
          for (int j = 0; j < 8; ++j) {
              const float xq = (j & 1) ? bfhi(wq[j >> 1]) : bflo(wq[j >> 1]), xf = (j & 1) ? bfhi(wf[j >> 1]) : bflo(wf[j >> 1]), xi = (j & 1) ? bfhi(wi[j >> 1]) : bflo(wi[j >> 1]);
              const float sg = sigmoid_f(xf), lo = lo8[j];
              oq[j] = silu_f(xq); of[j] = lo + (1.f - lo) * sg; ok[j] = (1.f - lo) * (1.f - sg); ov[j] = xi; }
          const int o = tok * 128 + c8;
          *(LAS f32x4*)(Lq + o) = (f32x4){oq[0], oq[1], oq[2], oq[3]}; *(LAS f32x4*)(Lq + o + 4) = (f32x4){oq[4], oq[5], oq[6], oq[7]};
          *(LAS f32x4*)(Lk + o) = (f32x4){ok[0], ok[1], ok[2], ok[3]}; *(LAS f32x4*)(Lk + o + 4) = (f32x4){ok[4], ok[5], ok[6], ok[7]};
          *(LAS f32x4*)(Lf + o) = (f32x4){of[0], of[1], of[2], of[3]}; *(LAS f32x4*)(Lf + o + 4) = (f32x4){of[4], of[5], of[6], of[7]};
          *(LAS f32x4*)(Lv + o) = (f32x4){ov[0], ov[1], ov[2], ov[3]}; *(LAS f32x4*)(Lv + o + 4) = (f32x4){ov[4], ov[5], ov[6], ov[7]};
        }
        __syncthreads();
        for (int tt = 0; tt < 32; ++tt) {
            const float vv = Lv[tt * 128 + v];
            float o = 0.f;
            const int base = tt * 128 + dq * 32;
#pragma unroll
            for (int i = 0; i < 32; i += 4) {
                const f32x4 f4 = *(const LAS f32x4*)(Lf + base + i), k4 = *(const LAS f32x4*)(Lk + base + i), q4 = *(const LAS f32x4*)(Lq + base + i);
                S[i] = f4.x * S[i] + k4.x * vv; o += q4.x * S[i];
                S[i + 1] = f4.y * S[i + 1] + k4.y * vv; o += q4.y * S[i + 1];
                S[i + 2] = f4.z * S[i + 2] + k4.z * vv; o += q4.z * S[i + 2];
                S[i + 3] = f4.w * S[i + 3] + k4.w * vv; o += q4.w * S[i + 3];
            }
            o += __shfl_xor(o, 1); o += __shfl_xor(o, 2);
            const int p = p0 + tt;
            if (p >= CTXL && dq == 0) { const int pos = dir ? SEQ - 1 - (p - CTXL) : (p - CTXL); O[(size_t)(b * SEQ + pos) * 1024 + h * 128 + v] = (bf16_t)f2bf(o); }
        }
    }
}

__device__ __forceinline__ void scan_gdn_naive(const Args& a, LAS unsigned char* lds, int b, int h, int dir) {
    const int tid = threadIdx.x, v = tid >> 2, dq = tid & 3, tok = tid >> 4, c8 = (tid & 15) * 8;
    LAS float* Lq = (LAS float*)lds; LAS float* Lk = Lq + 4096; LAS float* Lv = Lk + 4096; LAS float* Lg = Lv + 4096; LAS float* Lb = Lg + 32;
    const bf16_t* P = (const bf16_t*)(a.ws + WS_P); const float* AB = (const float*)(a.ws + WS_AB);
    bf16_t* O = (bf16_t*)((unsigned char*)a.out + (dir ? R2_OBB : R2_OBF));
    const float Acoef = -__expf(a.a_log[dir * 8 + h]), dtb = a.dt_bias[dir * 8 + h];
    float S[32];
#pragma unroll
    for (int i = 0; i < 32; ++i) S[i] = 0.f;
    for (int p0 = 0; p0 < CTXL + SEQ; p0 += 32) {
        __syncthreads();
        { const int p = p0 + tok; const bool isc = p < CTXL;
          const int L = isc ? CTXL : SEQ;
          const int sn = isc ? (dir ? CTXL - 1 - p : p) : (dir ? SEQ - 1 - (p - CTXL) : (p - CTXL));
          float aq[8], ak[8], av[8];
#pragma unroll
          for (int j = 0; j < 8; ++j) { aq[j] = 0.f; ak[j] = 0.f; av[j] = 0.f; }
          int rowc = 0;
#pragma unroll 1
          for (int tap = 0; tap < 5; ++tap) {
              const int s2 = sn + tap - 2;
              const int s2c = s2 < 0 ? 0 : (s2 >= L ? L - 1 : s2);
              const int row = isc ? (MLAT + b * CTXL + s2c) : (b * SEQ + (s2c & 63) * 64 + (s2c >> 6));
              if (tap == 2) rowc = row;
              const float ok = (s2 >= 0 && s2 < L) ? 1.f : 0.f;
              const bf16_t* pr = P + (size_t)row * PC + h * 128 + c8;
              const u32x4 rq = *(const u32x4*)(pr + C_GQ), rk = *(const u32x4*)(pr + C_GK), rv = *(const u32x4*)(pr + C_GV);
              const float* cw = a.gdn_conv + (size_t)tap * 3072 + h * 128 + c8;
              const f32x4 wq0 = *(const f32x4*)(cw), wq1 = *(const f32x4*)(cw + 4), wk0 = *(const f32x4*)(cw + 1024), wk1 = *(const f32x4*)(cw + 1028), wv0 = *(const f32x4*)(cw + 2048), wv1 = *(const f32x4*)(cw + 2052);
              const float cq[8] = {wq0.x, wq0.y, wq0.z, wq0.w, wq1.x, wq1.y, wq1.z, wq1.w}, ck[8] = {wk0.x, wk0.y, wk0.z, wk0.w, wk1.x, wk1.y, wk1.z, wk1.w}, cv[8] = {wv0.x, wv0.y, wv0.z, wv0.w, wv1.x, wv1.y, wv1.z, wv1.w};
              const unsigned uq[4] = {rq.x, rq.y, rq.z, rq.w}, uk[4] = {rk.x, rk.y, rk.z, rk.w}, uv[4] = {rv.x, rv.y, rv.z, rv.w};
#pragma unroll
              for (int j = 0; j < 8; ++j) {
                  const float xq = (j & 1) ? bfhi(uq[j >> 1]) : bflo(uq[j >> 1]), xk = (j & 1) ? bfhi(uk[j >> 1]) : bflo(uk[j >> 1]), xv = (j & 1) ? bfhi(uv[j >> 1]) : bflo(uv[j >> 1]);
                  aq[j] += ok * cq[j] * xq; ak[j] += ok * ck[j] * xk; av[j] += ok * cv[j] * xv; }
          }
          float sq = 0.f, sk = 0.f;
#pragma unroll
          for (int j = 0; j < 8; ++j) { aq[j] = silu_f(aq[j]); ak[j] = silu_f(ak[j]); av[j] = silu_f(av[j]); sq += aq[j] * aq[j]; sk += ak[j] * ak[j]; }
#pragma unroll
          for (int o = 1; o < 16; o <<= 1) { sq += __shfl_xor(sq, o); sk += __shfl_xor(sk, o); }
          const float rq_ = rsqrtf(sq + EPS) * 0.08838834764831845f, rk_ = rsqrtf(sk + EPS);
          const int o = tok * 128 + c8;
          *(LAS f32x4*)(Lq + o) = (f32x4){aq[0] * rq_, aq[1] * rq_, aq[2] * rq_, aq[3] * rq_}; *(LAS f32x4*)(Lq + o + 4) = (f32x4){aq[4] * rq_, aq[5] * rq_, aq[6] * rq_, aq[7] * rq_};
          *(LAS f32x4*)(Lk + o) = (f32x4){ak[0] * rk_, ak[1] * rk_, ak[2] * rk_, ak[3] * rk_}; *(LAS f32x4*)(Lk + o + 4) = (f32x4){ak[4] * rk_, ak[5] * rk_, ak[6] * rk_, ak[7] * rk_};
          *(LAS f32x4*)(Lv + o) = (f32x4){av[0], av[1], av[2], av[3]}; *(LAS f32x4*)(Lv + o + 4) = (f32x4){av[4], av[5], av[6], av[7]};
          if ((tid & 15) == 0) { const float al = AB[(size_t)rowc * 32 + dir * 8 + h], bl = AB[(size_t)rowc * 32 + 16 + dir * 8 + h];
              Lg[tok] = __expf(Acoef * softplus_f(al + dtb)); Lb[tok] = sigmoid_f(bl); }
        }
        __syncthreads();
        for (int tt = 0; tt < 32; ++tt) {
            const float vv = Lv[tt * 128 + v], eg = Lg[tt], be = Lb[tt];
            const int base = tt * 128 + dq * 32;
            float ks = 0.f;
#pragma unroll
            for (int i = 0; i < 32; i += 4) { const f32x4 k4 = *(const LAS f32x4*)(Lk + base + i);
                S[i] *= eg; S[i + 1] *= eg; S[i + 2] *= eg; S[i + 3] *= eg;
                ks += k4.x * S[i] + k4.y * S[i + 1] + k4.z * S[i + 2] + k4.w * S[i + 3]; }
            ks += __shfl_xor(ks, 1); ks += __shfl_xor(ks, 2);
            const float err = be * (vv - ks);
            float o = 0.f;
#pragma unroll
            for (int i = 0; i < 32; i += 4) { const f32x4 k4 = *(const LAS f32x4*)(Lk + base + i), q4 = *(const LAS f32x4*)(Lq + base + i);
                S[i] += k4.x * err; S[i + 1] += k4.y * err; S[i + 2] += k4.z * err; S[i + 3] += k4.w * err;
                o += q4.x * S[i] + q4.y * S[i + 1] + q4.z * S[i + 2] + q4.w * S[i + 3]; }
            o += __shfl_xor(o, 1); o += __shfl_xor(o, 2);
            const int p = p0 + tt;
            if (p >= CTXL && dq == 0) { const int sn = dir ? SEQ - 1 - (p - CTXL) : (p - CTXL); const int pos = (sn & 63) * 64 + (sn >> 6);
                O[(size_t)(b * SEQ + pos) * 1024 + h * 128 + v] = (bf16_t)f2bf(o); }
        }
    }
}


__device__ __forceinline__ int gdn_row(int b, bool isc, int n) { return isc ? (MLAT + b * CTXL + n) : (b * SEQ + (n & 63) * 64 + (n >> 6)); }
__device__ __forceinline__ void gdnprep_halo(const Args& a) {
    const int tid = threadIdx.x;
    const bf16_t* P = (const bf16_t*)(a.ws + WS_P); bf16_t* HALO = (bf16_t*)(a.ws + WS_HALO);
    for (int t = blockIdx.x; t < NB * 8 * 68; t += gridDim.x) {
        const int cc = t % 68, bh = t / 68, b = bh >> 3, h = bh & 7; const bool isc = cc < 4; const int L = isc ? CTXL : SEQ, n0 = 64 * (isc ? cc : cc - 4);
        if (tid < 192) { const int hr = tid / 48, c16 = tid % 48; const int n = (hr < 2) ? n0 - 2 + hr : n0 + 62 + hr;
            u32x4 v = (u32x4){0u, 0u, 0u, 0u};
            if (n >= 0 && n < L) v = *(const u32x4*)(P + GB_OFF + gdn_tok(b, h, isc, n) + c16 * 8);
            *(u32x4*)(HALO + ((size_t)t * 4 + hr) * 384 + c16 * 8) = v; }
    }
}
__device__ __forceinline__ void gdnprep_conv(const Args& a, LAS unsigned char* lds) {
    const int tid = threadIdx.x;
    constexpr int RAW = 0, PRAW = 784, CW = 53312;
    bf16_t* P = (bf16_t*)(a.ws + WS_P); const bf16_t* HALO = (const bf16_t*)(a.ws + WS_HALO);
    constexpr int NT = NB * 8 * 68;
    u32x4 rr[7]; float cwr[4];
#define GP_LOAD(t_) do { const int cc_ = (t_) % 68, bh_ = (t_) / 68, b_ = bh_ >> 3, h_ = bh_ & 7; const bool isc_ = cc_ < 4; const int n0_ = 64 * (isc_ ? cc_ : cc_ - 4); \
        _Pragma("unroll") for (int k = 0; k < 7; ++k) { int piece = tid + NTHR * k; piece = piece < 68 * 48 ? piece : 68 * 48 - 1; const int wr_ = piece / 48, c16 = piece % 48; \
            const bf16_t* src = (wr_ >= 2 && wr_ < 66) ? (P + GB_OFF + gdn_tok(b_, h_, isc_, n0_ + wr_ - 2) + c16 * 8) \
                                                      : (HALO + ((size_t)(t_) * 4 + (wr_ < 2 ? wr_ : wr_ - 64)) * 384 + c16 * 8); \
            rr[k] = *(const u32x4*)src; } \
        _Pragma("unroll") for (int k = 0; k < 4; ++k) { int i = tid + NTHR * k; i = i < 1920 ? i : 1919; const int tap = i / 384, c3 = i % 384; cwr[k] = a.gdn_conv[(size_t)tap * 3072 + (c3 >> 7) * 1024 + h_ * 128 + (c3 & 127)]; } } while (0)
    if ((int)blockIdx.x < NT) GP_LOAD((int)blockIdx.x);
    for (int t = blockIdx.x; t < NT; t += gridDim.x) {
        const int cc = t % 68, bh = t / 68, b = bh >> 3, h = bh & 7; const bool isc = cc < 4; const int n0 = 64 * (isc ? cc : cc - 4);
        __syncthreads();
#pragma unroll
        for (int k = 0; k < 4; ++k) { const int i = tid + NTHR * k; if (i < 1920) ((LAS float*)(lds + CW))[i] = cwr[k]; }
#pragma unroll
        for (int k = 0; k < 7; ++k) { const int piece = tid + NTHR * k; if (piece < 68 * 48) { const int wr_ = piece / 48, c16 = piece % 48;
            const bool oob = (wr_ < 2 && (cc == 0 || cc == 4)) || (wr_ >= 66 && (cc == 3 || cc == 67));
            *(LAS u32x4*)(lds + RAW + wr_ * PRAW + c16 * 16) = oob ? (u32x4){0u, 0u, 0u, 0u} : rr[k]; } }
        if (t + (int)gridDim.x < NT) GP_LOAD(t + (int)gridDim.x);
        if (tid < 128) {
            const int dirg = tid >> 6, nl = tid & 63; float* ABw = (float*)(a.ws + WS_AB);
            const size_t row = (size_t)gdn_row(b, isc, n0 + nl);
            const float al = ABw[row * 32 + dirg * 8 + h], bl = ABw[row * 32 + 16 + dirg * 8 + h];
            const float g = -__expf(a.a_log[dirg * 8 + h]) * softplus_f(al + a.dt_bias[dirg * 8 + h]);
            float Gc = g;
#pragma unroll
            for (int o = 1; o < 64; o <<= 1) { const float t = dirg ? __shfl_down(Gc, o) : __shfl_up(Gc, o); if (dirg ? (nl + o < 64) : (nl >= o)) Gc += t; }
            ABw[row * 32 + dirg * 8 + h] = Gc; ABw[row * 32 + 16 + dirg * 8 + h] = sigmoid_f(bl);
        }
        __syncthreads();
        {
            const int cg = tid & 31, tg = tid >> 5, nb = 4 * tg;
#pragma unroll 1
            for (int ten = 0; ten < 3; ++ten) {
                f32x4 wt[5];
#pragma unroll
                for (int tap = 0; tap < 5; ++tap) wt[tap] = *(const LAS f32x4*)((const LAS float*)(lds + CW) + tap * 384 + ten * 128 + 4 * cg);
                f32x4 acc[4];
#pragma unroll
                for (int u = 0; u < 4; ++u) acc[u] = (f32x4){0.f, 0.f, 0.f, 0.f};
#pragma unroll
                for (int rw_ = 0; rw_ < 8; ++rw_) { const u32x2 x = *(const LAS u32x2*)(lds + RAW + (nb + rw_) * PRAW + (ten * 128 + 4 * cg) * 2);
                    const f32x4 xv = (f32x4){bflo(x.x), bfhi(x.x), bflo(x.y), bfhi(x.y)};
#pragma unroll
                    for (int u = 0; u < 4; ++u) { const int tap = rw_ - u; if (tap >= 0 && tap < 5) acc[u] += wt[tap] * xv; } }
                float ss[4];
#pragma unroll
                for (int u = 0; u < 4; ++u) { acc[u].x = silu_f(acc[u].x); acc[u].y = silu_f(acc[u].y); acc[u].z = silu_f(acc[u].z); acc[u].w = silu_f(acc[u].w);
                    ss[u] = (acc[u].x * acc[u].x + acc[u].y * acc[u].y) + (acc[u].z * acc[u].z + acc[u].w * acc[u].w); }
                if (ten < 2) {
#pragma unroll
                    for (int o = 1; o < 32; o <<= 1) {
#pragma unroll
                        for (int u = 0; u < 4; ++u) ss[u] += __shfl_xor(ss[u], o); }
#pragma unroll
                    for (int u = 0; u < 4; ++u) { const float sc = rsqrtf(ss[u] + EPS) * (ten == 0 ? 0.08838834764831845f : 1.f); acc[u] = acc[u] * sc; }
                }
                const int cgs = (ten < 2) ? ((cg & ~7) | ((cg & 3) << 1) | ((cg >> 2) & 1)) : cg;
#pragma unroll
                for (int u = 0; u < 4; ++u) *(u32x2*)(P + GB_OFF + gdn_tok(b, h, isc, n0 + nb + u) + ten * 128 + 4 * cgs) = (u32x2){pk2(acc[u].x, acc[u].y), pk2(acc[u].z, acc[u].w)};
            }
        }
    }
}

#undef GP_LOAD

typedef short bf16x4 __attribute__((ext_vector_type(4)));
__device__ __forceinline__ unsigned cvtpk(float lo, float hi) { return pk2(lo, hi); }
__device__ __forceinline__ bf16x8 pack_tiles(const f32x4 t0, const f32x4 t1) {
    u32x4 r; r.x = cvtpk(t0[0], t0[1]); r.y = cvtpk(t0[2], t0[3]); r.z = cvtpk(t1[0], t1[1]); r.w = cvtpk(t1[2], t1[3]); return __builtin_bit_cast(bf16x8, r); }
__device__ __forceinline__ bf16x4 pack_tile(const f32x4 t) { u32x2 r; r.x = cvtpk(t[0], t[1]); r.y = cvtpk(t[2], t[3]); return __builtin_bit_cast(bf16x4, r); }
__device__ __forceinline__ bf16x8 lds_a_perm(const LAS unsigned char* p, int fq) {
    const u32x2 lo = *(const LAS u32x2*)(p + 8 * fq), hi = *(const LAS u32x2*)(p + 32 + 8 * fq);
    u32x4 r; r.x = lo.x; r.y = lo.y; r.z = hi.x; r.w = hi.y; return __builtin_bit_cast(bf16x8, r); }
#define MFMA32(A, B, C) __builtin_amdgcn_mfma_f32_16x16x32_bf16((A), (B), (C), 0, 0, 0)
#define MFMA16(A, B, C) __builtin_amdgcn_mfma_f32_16x16x16bf16_1k((A), (B), (C), 0, 0, 0)

__device__ __forceinline__ void scan_hgrn_mfma(const Args& a, LAS unsigned char* lds, const int b, const int h, const int dir) {
    int tid0 = threadIdx.x; asm volatile("" : "+v"(tid0)); const int w = __builtin_amdgcn_readfirstlane(tid0 >> 6);
    const int d = tid0 & 127, tq = tid0 >> 7;
    constexpr int QM = 0, KM = 20480, RI = 40960, KHT = 58368, VT = 76800, AM = 95232, AV = 104448, PMD = 104960, SEG = 105472;
    constexpr int PQ = 272, PT = 144, PK = 320;
    const bf16_t* P = (const bf16_t*)(a.ws + WS_P);
    bf16_t* O = (bf16_t*)((unsigned char*)a.out + (dir ? R2_OAB : R2_OAF));
    float lo;
    { const int ch = h * 128 + d; const float l0 = a.hgrn_lb[(dir * 2 + 0) * 1024 + ch], l1 = a.hgrn_lb[(dir * 2 + 1) * 1024 + ch]; lo = 1.f / (1.f + __expf(l1 - l0)); }
    const int cf = dir ? C_FB : C_FF;
    f32x4 S[8];
#pragma unroll
    for (int i = 0; i < 8; ++i) S[i] = (f32x4){0.f, 0.f, 0.f, 0.f};
    u32x4 rr[6];
#define HG_LOAD(cc) do { const int i_ = tid >> 3, part_ = tid & 7; const int p = 64 * (cc) + i_; \
        const int row = (p < CTXL) ? (MLAT + b * CTXL + (dir ? CTXL - 1 - p : p)) : (b * SEQ + (dir ? SEQ - 1 - (p - CTXL) : (p - CTXL))); \
        const bf16_t* pr = P + (size_t)row * PC + h * 128 + part_ * 16; \
        rr[0] = *(const u32x4*)(pr + C_HQ); rr[1] = *(const u32x4*)(pr + C_HQ + 8); rr[2] = *(const u32x4*)(pr + cf); rr[3] = *(const u32x4*)(pr + cf + 8); \
        rr[4] = *(const u32x4*)(pr + C_HI); rr[5] = *(const u32x4*)(pr + C_HI + 8); } while (0)
    if (w >= 4) __builtin_amdgcn_s_setprio(1);
    { const int tid = tid0; HG_LOAD(0); }
    for (int c = 0; c < 68; ++c) {
        int tid = tid0; asm volatile("" : "+v"(tid)); const int lane = tid & 63, fr = lane & 15, fq = lane >> 4;
        __syncthreads();
        { const int i_ = tid >> 3, part_ = tid & 7;
          *(LAS u32x4*)(lds + QM + i_ * PK + part_ * 32) = rr[0]; *(LAS u32x4*)(lds + QM + i_ * PK + part_ * 32 + 16) = rr[1];
          *(LAS u32x4*)(lds + KM + i_ * PK + part_ * 32) = rr[2]; *(LAS u32x4*)(lds + KM + i_ * PK + part_ * 32 + 16) = rr[3];
          *(LAS u32x4*)(lds + RI + i_ * PQ + part_ * 32) = rr[4]; *(LAS u32x4*)(lds + RI + i_ * PQ + part_ * 32 + 16) = rr[5]; }
        if (c + 1 < 68) HG_LOAD(c + 1);
        __syncthreads();
        unsigned short ri[16];
        float fv[16], kk[16], qs[16]; float pl = 1.f;
#pragma unroll
        for (int t = 0; t < 16; ++t) { const int i_ = tq * 16 + t;
            const float xq = bf2f(*(const LAS unsigned short*)(lds + QM + i_ * PK + d * 2)), xf = bf2f(*(const LAS unsigned short*)(lds + KM + i_ * PK + d * 2)); ri[t] = *(const LAS unsigned short*)(lds + RI + i_ * PQ + d * 2);
            const float sg = sigmoid_f(xf); const float f = lo + (1.f - lo) * sg; kk[t] = (1.f - lo) * (1.f - sg); pl *= f; fv[t] = pl; qs[t] = silu_f(xq); }
        ((LAS float*)(lds + SEG))[tq * 128 + d] = pl;
        { u32x4 v0, v1; v0.x = ri[0] | ((unsigned)ri[1] << 16); v0.y = ri[2] | ((unsigned)ri[3] << 16); v0.z = ri[4] | ((unsigned)ri[5] << 16); v0.w = ri[6] | ((unsigned)ri[7] << 16);
          v1.x = ri[8] | ((unsigned)ri[9] << 16); v1.y = ri[10] | ((unsigned)ri[11] << 16); v1.z = ri[12] | ((unsigned)ri[13] << 16); v1.w = ri[14] | ((unsigned)ri[15] << 16);
          *(LAS u32x4*)(lds + VT + d * PT + tq * 32) = v0; *(LAS u32x4*)(lds + VT + d * PT + tq * 32 + 16) = v1; }
        __syncthreads();
        {
            const LAS float* sg = (const LAS float*)(lds + SEG);
            const float s0 = sg[d], s1 = sg[128 + d], s2 = sg[256 + d], s3 = sg[384 + d];
            const float pre = (tq == 0) ? 1.f : (tq == 1 ? s0 : (tq == 2 ? s0 * s1 : s0 * s1 * s2));
            const float pmid = s0 * s1, plast = pmid * s2 * s3, rmid = rcp_f(pmid), c1 = plast * rmid;
            unsigned kh[8]; float kbv[16];
            const int dq_ = (d >> 2) & 3, off0 = 64 * (d >> 5) + 16 * dq_ + 8 * ((d >> 4) & 1) + 2 * (d & 3), off1 = off0 ^ 32;
#pragma unroll
            for (int t = 0; t < 16; ++t) {
                const float Pt = pre * fv[t], e1 = Pt * rmid, r1 = rcp_f(e1);
                const int i = tq * 16 + t; const int off = (t < 8) ? off0 : off1;
                *(LAS unsigned short*)(lds + QM + i * PK + off) = (unsigned short)f2bf(qs[t] * e1);
                const float k1 = kk[t] * r1;
                *(LAS unsigned short*)(lds + KM + i * PK + off) = (unsigned short)f2bf(k1);
                kbv[t] = k1 * c1;
            }
#pragma unroll
            for (int t2 = 0; t2 < 8; ++t2) kh[t2] = pk2(kbv[2 * t2], kbv[2 * t2 + 1]);
            *(LAS u32x4*)(lds + KHT + d * PT + tq * 32) = (u32x4){kh[0], kh[1], kh[2], kh[3]}; *(LAS u32x4*)(lds + KHT + d * PT + tq * 32 + 16) = (u32x4){kh[4], kh[5], kh[6], kh[7]};
            if (tq == 0) { ((LAS float*)(lds + AV))[d] = plast; ((LAS float*)(lds + PMD))[d] = pmid; }
        }
        __syncthreads();
        {
            const int mt = w >> 1;
#pragma unroll
            for (int nn = 0; nn < 2; ++nn) { const int nt = (w & 1) * 2 + nn;
                f32x4 acc = (f32x4){0.f, 0.f, 0.f, 0.f};
                if (nt <= mt) {
#pragma unroll
                    for (int s = 0; s < 4; ++s) { const int po = 64 * s + 16 * (fq ^ ((fr >> 3) << 1)); const bf16x8 A = *(const LAS bf16x8*)(lds + QM + (16 * mt + fr) * PK + po), B = *(const LAS bf16x8*)(lds + KM + (16 * nt + fr) * PK + po);
                        acc = MFMA32(A, B, acc); } }
#pragma unroll
                for (int r = 0; r < 4; ++r) { const int i = 16 * mt + 4 * fq + r, j = 16 * nt + fr; *(LAS unsigned short*)(lds + AM + i * PT + j * 2) = (unsigned short)f2bf(j <= i ? acc[r] : 0.f); }
            }
        }
        __syncthreads();
        {
            bf16x8 vb[2];
#pragma unroll
            for (int s2 = 0; s2 < 2; ++s2) vb[s2] = *(const LAS bf16x8*)(lds + VT + (16 * w + fr) * PT + (32 * s2 + 8 * fq) * 2);
            if (c >= 4) {
                bf16x8 sb[4];
#pragma unroll
                for (int s = 0; s < 4; ++s) sb[s] = pack_tiles(S[2 * s] * *(const LAS f32x4*)(lds + PMD + (32 * s + 4 * fq) * 4), S[2 * s + 1] * *(const LAS f32x4*)(lds + PMD + (32 * s + 16 + 4 * fq) * 4));
#pragma unroll
                for (int hf = 0; hf < 2; ++hf) {
                    bf16x8 qf[2][4], af[2][2];
#pragma unroll
                    for (int m2 = 0; m2 < 2; ++m2) { const int mt = 2 * hf + m2;
#pragma unroll
                        for (int s = 0; s < 4; ++s) qf[m2][s] = *(const LAS bf16x8*)(lds + QM + (16 * mt + fr) * PK + 64 * s + 16 * (fq ^ ((fr >> 3) << 1)));
#pragma unroll
                        for (int s2 = 0; s2 < 2; ++s2) if (2 * s2 <= mt) af[m2][s2] = *(const LAS bf16x8*)(lds + AM + (16 * mt + fr) * PT + (32 * s2 + 8 * fq) * 2); }
                    __builtin_amdgcn_sched_barrier(0);
                    f32x4 o[2] = {(f32x4){0.f, 0.f, 0.f, 0.f}, (f32x4){0.f, 0.f, 0.f, 0.f}};
#pragma unroll
                    for (int s = 0; s < 4; ++s) { o[0] = MFMA32(sb[s], qf[0][s], o[0]); o[1] = MFMA32(sb[s], qf[1][s], o[1]); }
#pragma unroll
                    for (int m2 = 0; m2 < 2; ++m2) { const int mt = 2 * hf + m2;
#pragma unroll
                        for (int s2 = 0; s2 < 2; ++s2) if (2 * s2 <= mt) o[m2] = MFMA32(vb[s2], af[m2][s2], o[m2]);
                        const int sidx = 64 * (c - 4) + 16 * mt + fr, pos = dir ? SEQ - 1 - sidx : sidx;
                        *(u32x2*)(O + (size_t)(b * SEQ + pos) * 1024 + h * 128 + 16 * w + 4 * fq) = (u32x2){pk2(o[m2][0], o[m2][1]), pk2(o[m2][2], o[m2][3])}; }
                }
            }
#pragma unroll
            for (int dh = 0; dh < 2; ++dh) {
                bf16x8 kf[4][2]; f32x4 a4[4];
#pragma unroll
                for (int d4 = 0; d4 < 4; ++d4) { const int dt = 4 * dh + d4; a4[d4] = *(const LAS f32x4*)(lds + AV + (16 * dt + 4 * fq) * 4);
#pragma unroll
                    for (int s2 = 0; s2 < 2; ++s2) kf[d4][s2] = *(const LAS bf16x8*)(lds + KHT + (16 * dt + fr) * PT + (32 * s2 + 8 * fq) * 2); }
                __builtin_amdgcn_sched_barrier(0);
#pragma unroll
                for (int d4 = 0; d4 < 4; ++d4) S[4 * dh + d4] = S[4 * dh + d4] * a4[d4];
#pragma unroll
                for (int s2 = 0; s2 < 2; ++s2)
#pragma unroll
                    for (int d4 = 0; d4 < 4; ++d4) S[4 * dh + d4] = MFMA32(kf[d4][s2], vb[s2], S[4 * dh + d4]);
            }
        }
    }
    __builtin_amdgcn_s_setprio(0);
#undef HG_LOAD
}

__device__ __forceinline__ void scan_gdn_mfma(const Args& a, LAS unsigned char* lds, const int b, const int h, const int dir) {
    int tid0 = threadIdx.x; asm volatile("" : "+v"(tid0)); const int w = __builtin_amdgcn_readfirstlane(tid0 >> 6);
    constexpr int RAW = 0, PRAW = 784;
    constexpr int LT = 0, AQK = 9216, LD = 18432, PT = 144;
    constexpr int QN = 53312, KN = 73792, PQ = 272, PK = 320;
    constexpr int KNT = 94272;
    constexpr int VB = 112704;
    constexpr int GT = 130112;
    constexpr int CW = 131152;
    const bf16_t* P = (const bf16_t*)(a.ws + WS_P); const float* AB = (const float*)(a.ws + WS_AB);
    bf16_t* O = (bf16_t*)((unsigned char*)a.out + (dir ? R2_OBB : R2_OBF));
    __syncthreads();
    for (int i = tid0; i < 64 * 72 / 2; i += NTHR) ((LAS unsigned*)(lds + AQK))[i] = 0u;
    f32x4 S[8];
#pragma unroll
    for (int i = 0; i < 8; ++i) S[i] = (f32x4){0.f, 0.f, 0.f, 0.f};
    u32x4 rr[6]; float g_nx = 0.f, b_nx = 0.f;
#define GD_GEOM(c_, isc_, L_, n0_) const bool isc_ = (c_) < 4; const int L_ = isc_ ? CTXL : SEQ; const int n0_ = 64 * (isc_ ? (dir ? 3 - (c_) : (c_)) : (dir ? 63 - ((c_) - 4) : ((c_) - 4)));
#define GD_LOAD(c_) do { GD_GEOM(c_, isc, L, n0) (void)L; { const int i_ = tid >> 3, part_ = tid & 7; const int n = n0 + (dir ? 63 - i_ : i_); \
        const bf16_t* pr = P + GB_OFF + gdn_tok(b, h, isc, n) + part_ * 16; \
        rr[0] = *(const u32x4*)(pr); rr[1] = *(const u32x4*)(pr + 8); rr[2] = *(const u32x4*)(pr + 128); rr[3] = *(const u32x4*)(pr + 136); rr[4] = *(const u32x4*)(pr + 256); rr[5] = *(const u32x4*)(pr + 264); } \
        if (w == 0) { const int ln = tid & 63; const int n = n0 + (dir ? 63 - ln : ln); const size_t row = (size_t)gdn_row(b, isc, n); g_nx = AB[row * 32 + dir * 8 + h]; b_nx = AB[row * 32 + 16 + dir * 8 + h]; } } while (0)
    { const int tid = tid0; GD_LOAD(0); }
    for (int c = 0; c < 68; ++c) {
        GD_GEOM(c, isc, L, n0) (void)L; (void)isc;
        int tid = tid0; asm volatile("" : "+v"(tid));
        int lane = tid & 63, fr = lane & 15, fq = lane >> 4;
        __syncthreads();
        {
            const int i_ = tid >> 3, part_ = tid & 7;
            const int psw = (part_ ^ ((i_ >> 3) & 1)) * 32;
            *(LAS u32x4*)(lds + QN + i_ * PK + psw) = rr[0]; *(LAS u32x4*)(lds + QN + i_ * PK + psw + 16) = rr[1];
            *(LAS u32x4*)(lds + KN + i_ * PK + psw) = rr[2]; *(LAS u32x4*)(lds + KN + i_ * PK + psw + 16) = rr[3];
            *(LAS u32x4*)(lds + VB + i_ * PQ + part_ * 32) = rr[4]; *(LAS u32x4*)(lds + VB + i_ * PQ + part_ * 32 + 16) = rr[5];
            const unsigned kw[8] = {rr[2].x, rr[2].y, rr[2].z, rr[2].w, rr[3].x, rr[3].y, rr[3].z, rr[3].w};
#pragma unroll
            for (int j = 0; j < 8; ++j) {
                const int dd = 32 * (part_ >> 1) + 8 * (part_ & 1) + 16 * ((j >> 1) & 1) + 4 * (j >> 2) + 2 * (j & 1);
                const int csw = ((((i_ >> 2) ^ (dd >> 4)) << 2) | (i_ & 3)) * 2;
                *(LAS unsigned short*)(lds + KNT + dd * PT + csw) = (unsigned short)(kw[j] & 0xffffu);
                *(LAS unsigned short*)(lds + KNT + (dd + 1) * PT + csw) = (unsigned short)(kw[j] >> 16); }
        }
        const float g_in = g_nx, b_in = b_nx;
        if (c + 1 < 68) GD_LOAD(c + 1);
        if (w == 0) {
            const float G = g_in;
            const float Glast = __shfl(G, 63);
            LAS float* gt = (LAS float*)(lds + GT);
            gt[lane] = __expf(G); gt[64 + lane] = __expf(Glast - G); gt[128 + lane] = b_in; gt[192 + lane] = G;
            if (lane == 0) gt[256] = __expf(Glast);
        }
        __syncthreads();
        tid = tid0; asm volatile("" : "+v"(tid)); lane = tid & 63; fr = lane & 15; fq = lane >> 4;
        {
            const LAS float* gt = (const LAS float*)(lds + GT);
#pragma unroll
            for (int nn = 0; nn < 2; ++nn) {
                int mt, nt;
                if (w < 4) { mt = w; nt = w; if (nn == 1) break; }
                else { const int id = (w - 4) * 2 + nn; if (id >= 6) break;
                    mt = (id == 0) ? 1 : (id <= 2 ? 2 : 3); nt = (id == 0 || id == 1 || id == 3) ? 0 : ((id == 2 || id == 4) ? 1 : 2); }
                f32x4 akk = (f32x4){0.f, 0.f, 0.f, 0.f}, aqk = (f32x4){0.f, 0.f, 0.f, 0.f};
#pragma unroll
                for (int s = 0; s < 4; ++s) { const int po = 64 * s + 16 * (fq ^ ((fr >> 3) << 1));
                    const bf16x8 Bk = *(const LAS bf16x8*)(lds + KN + (16 * nt + fr) * PK + po);
                    akk = MFMA32(*(const LAS bf16x8*)(lds + KN + (16 * mt + fr) * PK + po), Bk, akk);
                    aqk = MFMA32(*(const LAS bf16x8*)(lds + QN + (16 * mt + fr) * PK + po), Bk, aqk); }
                const int j = 16 * nt + fr; const float Gj = gt[192 + j];
                const f32x4 Gi4 = *(const LAS f32x4*)(gt + 192 + 16 * mt + 4 * fq), bi4 = *(const LAS f32x4*)(gt + 128 + 16 * mt + 4 * fq);
#pragma unroll
                for (int r = 0; r < 4; ++r) { const int i = 16 * mt + 4 * fq + r; const float Gi = Gi4[r], bi = bi4[r];
                    const float gam = (j <= i) ? __expf(Gi - Gj) : 0.f;
                    *(LAS unsigned short*)(lds + AQK + i * PT + j * 2) = (unsigned short)f2bf(aqk[r] * gam);
                    const float Lij = (j < i) ? bi * akk[r] * gam : 0.f;
                    if (w < 4) *(LAS unsigned short*)(lds + LD + (mt * 16 + (4 * fq + r)) * 40 + fr * 2) = (unsigned short)f2bf(-Lij);
                    else *(LAS unsigned short*)(lds + LT + i * PT + j * 2) = (unsigned short)f2bf(-Lij); }
            }
            if (w < 4) {
                asm volatile("s_waitcnt lgkmcnt(0)" ::: "memory"); __builtin_amdgcn_wave_barrier();
                const bf16x4 nl = *(const LAS bf16x4*)(lds + LD + (w * 16 + fr) * 40 + (4 * fq) * 2);
                f32x4 eye; eye[0] = (4 * fq + 0 == fr) ? 1.f : 0.f; eye[1] = (4 * fq + 1 == fr) ? 1.f : 0.f; eye[2] = (4 * fq + 2 == fr) ? 1.f : 0.f; eye[3] = (4 * fq + 3 == fr) ? 1.f : 0.f;
                f32x4 X = eye;
#pragma unroll
                for (int it = 0; it < 15; ++it) X = MFMA16(nl, pack_tile(X), eye);
#pragma unroll
                for (int r = 0; r < 4; ++r) *(LAS unsigned short*)(lds + LT + (16 * w + 4 * fq + r) * PT + (16 * w + fr) * 2) = (unsigned short)f2bf(X[r]);
            }
        }
        __syncthreads();
        tid = tid0; asm volatile("" : "+v"(tid)); lane = tid & 63; fr = lane & 15; fq = lane >> 4;
        {
            const LAS float* gt = (const LAS float*)(lds + GT);
            const bool lat = c >= 4;
            bf16x8 sb[4];
#pragma unroll
            for (int s = 0; s < 4; ++s) sb[s] = pack_tiles(S[2 * s], S[2 * s + 1]);
            f32x4 R[4], oq[4];
#pragma unroll
            for (int hf = 0; hf < 2; ++hf) {
                bf16x8 kf[2][4];
#pragma unroll
                for (int m2 = 0; m2 < 2; ++m2)
#pragma unroll
                    for (int s = 0; s < 4; ++s) kf[m2][s] = *(const LAS bf16x8*)(lds + KN + (16 * (2 * hf + m2) + fr) * PK + 64 * s + 16 * (fq ^ ((fr >> 3) << 1)));
                f32x4 be4[2], eg4[2]; unsigned short vraw[2][4];
#pragma unroll
                for (int m2 = 0; m2 < 2; ++m2) { const int mt = 2 * hf + m2; be4[m2] = *(const LAS f32x4*)(gt + 128 + 16 * mt + 4 * fq); eg4[m2] = *(const LAS f32x4*)(gt + 16 * mt + 4 * fq);
#pragma unroll
                    for (int r = 0; r < 4; ++r) vraw[m2][r] = *(const LAS unsigned short*)(lds + VB + (16 * mt + 4 * fq + r) * PQ + (16 * w + fr) * 2); }
                __builtin_amdgcn_sched_barrier(0);
                f32x4 X[2] = {(f32x4){0.f, 0.f, 0.f, 0.f}, (f32x4){0.f, 0.f, 0.f, 0.f}};
#pragma unroll
                for (int s = 0; s < 4; ++s)
#pragma unroll
                    for (int m2 = 0; m2 < 2; ++m2) X[m2] = MFMA32(kf[m2][s], sb[s], X[m2]);
                if (lat) {
                    bf16x8 qf[2][4];
#pragma unroll
                    for (int m2 = 0; m2 < 2; ++m2)
#pragma unroll
                        for (int s = 0; s < 4; ++s) qf[m2][s] = *(const LAS bf16x8*)(lds + QN + (16 * (2 * hf + m2) + fr) * PK + 64 * s + 16 * (fq ^ ((fr >> 3) << 1)));
                    const float eg0 = gt[16 * (2 * hf) + fr], eg1 = gt[16 * (2 * hf + 1) + fr];
                    __builtin_amdgcn_sched_barrier(0);
                    f32x4 q0 = (f32x4){0.f, 0.f, 0.f, 0.f}, q1 = (f32x4){0.f, 0.f, 0.f, 0.f};
#pragma unroll
                    for (int s = 0; s < 4; ++s) { q0 = MFMA32(sb[s], qf[0][s], q0); q1 = MFMA32(sb[s], qf[1][s], q1); }
                    oq[2 * hf] = q0 * eg0; oq[2 * hf + 1] = q1 * eg1;
                }
#pragma unroll
                for (int m2 = 0; m2 < 2; ++m2)
#pragma unroll
                    for (int r = 0; r < 4; ++r) R[2 * hf + m2][r] = be4[m2][r] * (bf2f(vraw[m2][r]) - eg4[m2][r] * X[m2][r]);
            }
            bf16x4 ltf[4][4];
#pragma unroll
            for (int ab = 0; ab < 4; ++ab)
#pragma unroll
                for (int bb = 0; bb <= ab; ++bb) ltf[ab][bb] = *(const LAS bf16x4*)(lds + LT + (16 * ab + fr) * PT + (16 * bb + 4 * fq) * 2);
            bf16x8 aqf[4][2];
            if (lat) {
#pragma unroll
                for (int mt = 0; mt < 4; ++mt) { aqf[mt][0] = lds_a_perm(lds + AQK + (16 * mt + fr) * PT, fq); if (mt >= 2) aqf[mt][1] = lds_a_perm(lds + AQK + (16 * mt + fr) * PT + 64, fq); }
            }
            __builtin_amdgcn_sched_barrier(0);
            f32x4 vt[4];
#pragma unroll
            for (int ab = 0; ab < 4; ++ab) { f32x4 acc = R[ab];
#pragma unroll
                for (int bb = 0; bb < ab; ++bb) acc = MFMA16(ltf[ab][bb], pack_tile(vt[bb]), acc);
                const f32x4 z4 = {0.f, 0.f, 0.f, 0.f}; vt[ab] = MFMA16(ltf[ab][ab], pack_tile(acc), z4); }
            if (lat) {
                const bf16x8 vnb0 = pack_tiles(vt[0], vt[1]), vnb1 = pack_tiles(vt[2], vt[3]);
                const int ccn = n0 >> 6;
#pragma unroll
                for (int mt = 0; mt < 4; ++mt) { f32x4 o = oq[mt];
                    o = MFMA32(vnb0, aqf[mt][0], o);
                    if (mt >= 2) o = MFMA32(vnb1, aqf[mt][1], o);
                    const int i = 16 * mt + fr, nloc = dir ? 63 - i : i;
                    *(u32x2*)(O + (size_t)(b * SEQ + nloc * 64 + ccn) * 1024 + h * 128 + 16 * w + 4 * fq) = (u32x2){pk2(o[0], o[1]), pk2(o[2], o[3])}; }
            }
#pragma unroll
            for (int mt = 0; mt < 4; ++mt) vt[mt] = vt[mt] * *(const LAS f32x4*)(gt + 64 + 16 * mt + 4 * fq);
            const bf16x8 vsb0 = pack_tiles(vt[0], vt[1]), vsb1 = pack_tiles(vt[2], vt[3]);
            const float egl = gt[256];
#pragma unroll
            for (int dh = 0; dh < 2; ++dh) {
                bf16x8 ktf[4][2];
#pragma unroll
                for (int d4 = 0; d4 < 4; ++d4) { const int dt = 4 * dh + d4; const LAS unsigned char* rp = lds + KNT + (16 * dt + fr) * PT + 8 * (fq ^ (dt & 3));
#pragma unroll
                    for (int hh = 0; hh < 2; ++hh) { const u32x2 lo = *(const LAS u32x2*)(rp + 32 * ((2 * hh) ^ (dt >> 2))), hi = *(const LAS u32x2*)(rp + 32 * ((2 * hh + 1) ^ (dt >> 2)));
                        u32x4 r4; r4.x = lo.x; r4.y = lo.y; r4.z = hi.x; r4.w = hi.y; ktf[d4][hh] = __builtin_bit_cast(bf16x8, r4); } }
                __builtin_amdgcn_sched_barrier(0);
#pragma unroll
                for (int d4 = 0; d4 < 4; ++d4) S[4 * dh + d4] = S[4 * dh + d4] * egl;
#pragma unroll
                for (int d4 = 0; d4 < 4; ++d4) S[4 * dh + d4] = MFMA32(ktf[d4][0], vsb0, S[4 * dh + d4]);
#pragma unroll
                for (int d4 = 0; d4 < 4; ++d4) S[4 * dh + d4] = MFMA32(ktf[d4][1], vsb1, S[4 * dh + d4]);
            }
        }
    }
#undef GD_LOAD
#undef GD_GEOM
}

#ifndef SCAN_MODE
#define SCAN_MODE 3
#endif
__device__ __forceinline__ void phase_scan(const Args& a, LAS unsigned char* lds) {
    for (int it = blockIdx.x; it < 128; it += gridDim.x) {
        const int ch = it & 63, b = ch >> 4, h = (ch >> 1) & 7, dir = ch & 1;
        if (it < 64) { if (SCAN_MODE & 1) scan_hgrn_mfma(a, lds, b, h, dir); else scan_hgrn_naive(a, lds, b, h, dir);
 }
        else { if (SCAN_MODE & 2) scan_gdn_mfma(a, lds, b, h, dir); else scan_gdn_naive(a, lds, b, h, dir);
 }
        __syncthreads();
    }
}

__device__ __forceinline__ void phase_mergeprep(const Args& a) {
    const int tid = threadIdx.x, lane = tid & 63, wave = tid >> 6, G = gridDim.x;
    const bf16_t* P = (const bf16_t*)(a.ws + WS_P);
    const bf16_t* OAF = (const bf16_t*)((const unsigned char*)a.out + R2_OAF); const bf16_t* OAB = (const bf16_t*)((const unsigned char*)a.out + R2_OAB);
    const bf16_t* OBF = (const bf16_t*)((const unsigned char*)a.out + R2_OBF); const bf16_t* OBB = (const bf16_t*)((const unsigned char*)a.out + R2_OBB);
    bf16_t* YAB = (bf16_t*)(a.ws + WS_R1 + R1_YAB);
    const int c0 = lane * 16;
    u32x4 L[2][6], Ln[2][6];
#define MP_LOAD(dst, r_) do { _Pragma("unroll") for (int br = 0; br < 2; ++br) { const bf16_t* o1 = (br ? OBF : OAF) + (size_t)(r_) * 1024 + c0; const bf16_t* o2 = (br ? OBB : OAB) + (size_t)(r_) * 1024 + c0; \
        const bf16_t* gp = P + (size_t)(r_) * PC + (br ? C_Z : C_OG) + c0; \
        dst[br][0] = *(const u32x4*)o1; dst[br][1] = *(const u32x4*)(o1 + 8); dst[br][2] = *(const u32x4*)o2; dst[br][3] = *(const u32x4*)(o2 + 8); dst[br][4] = *(const u32x4*)gp; dst[br][5] = *(const u32x4*)(gp + 8); } } while (0)
    { const int r0 = blockIdx.x * NWAVES + wave; if (r0 < MLAT) MP_LOAD(L, r0); }
    for (int r = blockIdx.x * NWAVES + wave; r < MLAT; r += G * NWAVES) {
        { const int rn = r + G * NWAVES; if (rn < MLAT) MP_LOAD(Ln, rn); }
#pragma unroll
        for (int br = 0; br < 2; ++br) {
            const float* gain = (br ? a.gdn_norm : a.hgrn_norm) + c0;
            float val[16], gt[16]; float ss = 0.f;
#pragma unroll
            for (int hx = 0; hx < 2; ++hx) {
                const u32x4 w1 = L[br][hx], w2 = L[br][2 + hx], wg = L[br][4 + hx];
                const unsigned u1[4] = {w1.x, w1.y, w1.z, w1.w}, u2[4] = {w2.x, w2.y, w2.z, w2.w}, ug[4] = {wg.x, wg.y, wg.z, wg.w};
#pragma unroll
                for (int j = 0; j < 4; ++j) {
                    float s0 = bflo(u1[j]) + bflo(u2[j]), s1 = bfhi(u1[j]) + bfhi(u2[j]); const float g0 = bflo(ug[j]), g1 = bfhi(ug[j]);
                    if (br == 0) { s0 *= sigmoid_f(g0); s1 *= sigmoid_f(g1); gt[8 * hx + 2 * j] = 1.f; gt[8 * hx + 2 * j + 1] = 1.f; }
                    else { gt[8 * hx + 2 * j] = silu_f(g0); gt[8 * hx + 2 * j + 1] = silu_f(g1); }
                    val[8 * hx + 2 * j] = s0; val[8 * hx + 2 * j + 1] = s1; ss += s0 * s0 + s1 * s1; }
            }
            ss += __shfl_xor(ss, 1); ss += __shfl_xor(ss, 2); ss += __shfl_xor(ss, 4);
            const float rstd = rsqrtf(ss * (1.f / 128.f) + EPS);
            unsigned ow[8];
#pragma unroll
            for (int j = 0; j < 8; ++j) { const f32x2 gn = *(const f32x2*)(gain + 2 * j);
                ow[j] = pk2(val[2 * j] * rstd * gn.x * gt[2 * j], val[2 * j + 1] * rstd * gn.y * gt[2 * j + 1]); }
            bf16_t* dst = YAB + (size_t)r * D + br * 1024 + c0;
            *(u32x4*)dst = (u32x4){ow[0], ow[1], ow[2], ow[3]}; *(u32x4*)(dst + 8) = (u32x4){ow[4], ow[5], ow[6], ow[7]};
        }
#pragma unroll
        for (int br = 0; br < 2; ++br)
#pragma unroll
            for (int k = 0; k < 6; ++k) L[br][k] = Ln[br][k];
    }
#undef MP_LOAD
}

__device__ __forceinline__ float reduce16(const float (&p)[16], const int lane) {
    float q8[8], q4[4], q2[2];
#pragma unroll
    for (int i = 0; i < 8; ++i) { const bool hi = (lane & 32) != 0; const float snd = hi ? p[i] : p[i + 8], kp = hi ? p[i + 8] : p[i]; q8[i] = kp + __shfl_xor(snd, 32); }
#pragma unroll
    for (int i = 0; i < 4; ++i) { const bool hi = (lane & 16) != 0; const float snd = hi ? q8[i] : q8[i + 4], kp = hi ? q8[i + 4] : q8[i]; q4[i] = kp + __shfl_xor(snd, 16); }
#pragma unroll
    for (int i = 0; i < 2; ++i) { const bool hi = (lane & 8) != 0; const float snd = hi ? q4[i] : q4[i + 2], kp = hi ? q4[i + 2] : q4[i]; q2[i] = kp + __shfl_xor(snd, 8); }
    float q1; { const bool hi = (lane & 4) != 0; const float snd = hi ? q2[0] : q2[1], kp = hi ? q2[1] : q2[0]; q1 = kp + __shfl_xor(snd, 4); }
    q1 += __shfl_xor(q1, 2); q1 += __shfl_xor(q1, 1);
    return q1;
}
__device__ __forceinline__ void phase_norm2(const Args& a, LAS unsigned char* lds) {
    const int tid = threadIdx.x, lane0 = tid & 63, wave = tid >> 6, G = gridDim.x;
    const modfx_t* MOD = (const modfx_t*)(a.ws + WS_MOD); const bf16_t* X1 = (const bf16_t*)(a.ws + WS_P + P_X1);
    bf16_t* H2 = (bf16_t*)(a.ws + WS_R1 + R1_H2); float* AFF = (float*)(a.ws + WS_AFF);
    LAS float* rw = (LAS float*)lds;
    for (int i = tid; i < D * NE; i += NTHR) { const int c = i >> 4, e = i & 15; rw[e * 2052 + c] = a.router_w[i]; }
    __syncthreads();
    for (int q = blockIdx.x * NWAVES + wave; q < MLAT / 8; q += G * NWAVES) {
        int lane_o = lane0; asm volatile("" : "+v"(lane_o));
        const int lane = lane_o;
        const int r0 = q * 8, b = r0 >> 12;
        f32x4 mulv[8], shv[8];
#pragma unroll
        for (int j = 0; j < 8; ++j) { const int c = lane * 4 + 256 * j;
            const f32x4 nf = *(const f32x4*)(a.norm_ffn + c);
            const f32x4 sh = mod4(MOD, b * 12288 + 3 * D + c) + *(const f32x4*)(a.ada_b + 3 * D + c);
            const f32x4 scl = mod4(MOD, b * 12288 + 4 * D + c) + *(const f32x4*)(a.ada_b + 4 * D + c);
            mulv[j] = nf * (scl + 1.f); shv[j] = sh; }
        u32x2 xw[8], xn[8];
#pragma unroll
        for (int j = 0; j < 8; ++j) xw[j] = *(const u32x2*)(X1 + (size_t)r0 * D + lane * 4 + 256 * j);
#pragma unroll 1
        for (int k = 0; k < 8; ++k) {
            const int r = r0 + k, n = r & 4095, rn = r0 + (k < 7 ? k + 1 : 7);
#pragma unroll
            for (int j = 0; j < 8; ++j) xn[j] = *(const u32x2*)(X1 + (size_t)rn * D + lane * 4 + 256 * j);
            f32x4 v[8]; float ss = 0.f;
#pragma unroll
            for (int j = 0; j < 8; ++j) { v[j] = (f32x4){bflo(xw[j].x), bfhi(xw[j].x), bflo(xw[j].y), bfhi(xw[j].y)}; ss += (v[j].x * v[j].x + v[j].y * v[j].y) + (v[j].z * v[j].z + v[j].w * v[j].w); }
            const float rstd = rsqrtf(wave_sum(ss) * (1.f / D) + EPS);
#pragma unroll
            for (int j = 0; j < 8; ++j) { const int c = lane * 4 + 256 * j;
                v[j] = v[j] * rstd * mulv[j] + shv[j];
                *(unsigned*)((unsigned char*)H2 + (size_t)r * D + c) = pk4_fp8(v[j].x, v[j].y, v[j].z, v[j].w); }
            float p[16];
#pragma unroll
            for (int e = 0; e < 16; ++e) { f32x2 s2 = (f32x2){0.f, 0.f};
#pragma unroll
                for (int j = 0; j < 8; ++j) { const f32x4 w4 = *(const LAS f32x4*)(rw + e * 2052 + lane * 4 + 256 * j);
                    s2 = __builtin_elementwise_fma((f32x2){v[j].x, v[j].y}, (f32x2){w4.x, w4.y}, s2); s2 = __builtin_elementwise_fma((f32x2){v[j].z, v[j].w}, (f32x2){w4.z, w4.w}, s2); }
                p[e] = s2.x + s2.y; asm volatile("" ::: "memory"); }
            const float lg = reduce16(p, lane);
            float mx = lg;
#pragma unroll
            for (int o = 4; o < 64; o <<= 1) mx = fmaxf(mx, __shfl_xor(mx, o));
            const float ex = __expf(lg - mx); float den = ex;
#pragma unroll
            for (int o = 4; o < 64; o <<= 1) den += __shfl_xor(den, o);
            if ((lane & 3) == 0) AFF[(size_t)(b * NE + ((lane >> 2) & 15)) * SEQ + n] = ex / den;
#pragma unroll
            for (int j = 0; j < 8; ++j) xw[j] = xn[j];
        }
    }
}

__device__ __forceinline__ void phase_topk(const Args& a, LAS unsigned char* lds) {
    const int tid = threadIdx.x, lane = tid & 63, wave = tid >> 6;
    const float* AFF = (const float*)(a.ws + WS_AFF); int* IDX = (int*)(a.ws + WS_IDX); float* GATEV = (float*)(a.ws + WS_GATEV); int* INV = (int*)(a.ws + WS_INV);
    LAS unsigned* wc = (LAS unsigned*)lds;
    LAS int* sel = (LAS int*)(lds + 256);
    const unsigned char* H2q = (const unsigned char*)(a.ws + WS_R1 + R1_H2); unsigned char* XS = (unsigned char*)a.out;
    const int nq = 1;
    for (int item = blockIdx.x; item < NB * NE * nq; item += gridDim.x) {
        const int be = item / nq, qtr = item % nq, b = be >> 4, e = be & 15;
        unsigned key[8];
        { const u32x4 k0 = *(const u32x4*)(AFF + (size_t)be * SEQ + tid * 8), k1 = *(const u32x4*)(AFF + (size_t)be * SEQ + tid * 8 + 4);
          key[0] = k0.x; key[1] = k0.y; key[2] = k0.z; key[3] = k0.w; key[4] = k1.x; key[5] = k1.y; key[6] = k1.z; key[7] = k1.w; }
        unsigned prefix = 0u;
        __syncthreads();
        for (int bit = 31; bit >= 0; --bit) {
            const unsigned cand = prefix | (1u << bit);
            unsigned cnt = 0;
#pragma unroll
            for (int i = 0; i < 8; ++i) cnt += (unsigned)__popcll(__ballot(key[i] >= cand));
            if (lane == 0) wc[(bit & 1) * 8 + wave] = cnt;
            __syncthreads();
            unsigned tot = 0;
#pragma unroll
            for (int w = 0; w < 8; ++w) tot += wc[(bit & 1) * 8 + w];
            if (tot >= (unsigned)CAP) prefix = cand;
        }
        const unsigned T = prefix;
        int cgt = 0, ceq = 0;
#pragma unroll
        for (int i = 0; i < 8; ++i) { cgt += key[i] > T; ceq += key[i] == T; }
        int val = cgt | (ceq << 16), inc = val;
#pragma unroll
        for (int o = 1; o < 64; o <<= 1) { const int t = __shfl_up(inc, o); if (lane >= o) inc += t; }
        __syncthreads();
        if (lane == 63) wc[16 + wave] = (unsigned)inc;
        __syncthreads();
        int base = 0, total = 0;
#pragma unroll
        for (int w = 0; w < 8; ++w) { const int t = (int)wc[16 + w]; total += t; if (w < wave) base += t; }
        const int excl = base + inc - val;
        int gt_before = excl & 0xffff, eq_before = excl >> 16;
        const int need = CAP - (total & 0xffff);
#pragma unroll
        for (int i = 0; i < 8; ++i) {
            const int n = tid * 8 + i; int slot = -1;
            if (key[i] > T) { slot = gt_before + (eq_before < need ? eq_before : need); ++gt_before; }
            else if (key[i] == T) { if (eq_before < need) slot = gt_before + eq_before; ++eq_before; }
            if (slot >= 0) { sel[slot] = n; if (qtr == 0) { IDX[be * CAP + slot] = n; GATEV[be * CAP + slot] = __uint_as_float(key[i]); } }
            if (qtr == 0) INV[(size_t)(b * SEQ + n) * NE + e] = slot;
        }
        __syncthreads();
        __syncthreads();
    }
}

__device__ __forceinline__ void phase_gather(const Args& a) {
    const int tid = threadIdx.x, lane = tid & 63, wave = tid >> 6, G = gridDim.x;
    const bf16_t* H2 = (const bf16_t*)(a.ws + WS_R1 + R1_H2); const int* IDX = (const int*)(a.ws + WS_IDX); bf16_t* XS = (bf16_t*)a.out;
    for (int r = blockIdx.x * NWAVES + wave; r < NB * NE * CAP; r += G * NWAVES) {
        const int b = r >> 13; const int n = IDX[r];
        const u32x4* src = (const u32x4*)((const unsigned char*)H2 + (size_t)(b * SEQ + n) * D); u32x4* dst = (u32x4*)((unsigned char*)XS + (size_t)r * D);
#pragma unroll
        for (int j = 0; j < 2; ++j) dst[lane + 64 * j] = src[lane + 64 * j];
    }
}

__device__ __forceinline__ void phase_final(const Args& a) {
    int tid = threadIdx.x; asm volatile("" : "+v"(tid));
    const int lane = tid & 63, wave = tid >> 6, G = gridDim.x;
    const modfx_t* MOD = (const modfx_t*)(a.ws + WS_MOD); const bf16_t* X1 = (const bf16_t*)(a.ws + WS_P + P_X1);
    const bf16_t* YE = (const bf16_t*)(a.ws + WS_P + P_WGU); const int* INV = (const int*)(a.ws + WS_INV);
    for (int q = blockIdx.x * NWAVES + wave; q < MLAT / 8; q += G * NWAVES) {
        const int r0 = q * 8, b = r0 >> 12;
        f32x4 m5v[8], fnv[8];
#pragma unroll
        for (int j = 0; j < 8; ++j) { const int c = lane * 4 + 256 * j; m5v[j] = mod4(MOD, b * 12288 + 5 * D + c) + *(const f32x4*)(a.ada_b + 5 * D + c); fnv[j] = *(const f32x4*)(a.final_norm + c); }
        int myslot = (lane < 16) ? INV[(size_t)r0 * NE + lane] : -1;
        u32x2 xw[8], xn[8];
#pragma unroll
        for (int j = 0; j < 8; ++j) xw[j] = *(const u32x2*)(X1 + (size_t)r0 * D + lane * 4 + 256 * j);
#pragma unroll 1
        for (int k = 0; k < 8; ++k) {
            const int r = r0 + k, rn = r0 + (k < 7 ? k + 1 : 7);
            const int nslot = (lane < 16) ? INV[(size_t)rn * NE + lane] : -1;
#pragma unroll
            for (int j = 0; j < 8; ++j) xn[j] = *(const u32x2*)(X1 + (size_t)rn * D + lane * 4 + 256 * j);
            f32x4 f[8];
#pragma unroll
            for (int j = 0; j < 8; ++j) f[j] = (f32x4){0.f, 0.f, 0.f, 0.f};
            unsigned long long mask = __ballot(myslot >= 0);
            while (mask) {
                const int e0 = __builtin_ctzll(mask); mask &= mask - 1;
                const int e1 = mask ? __builtin_ctzll(mask) : -1; if (mask) mask &= mask - 1;
                const int s0 = __shfl(myslot, e0), s1 = (e1 >= 0) ? __shfl(myslot, e1) : 0;
                const bf16_t* y0 = YE + ((size_t)(b * NE + e0) * CAP + s0) * D; const bf16_t* y1 = YE + ((size_t)(b * NE + (e1 >= 0 ? e1 : e0)) * CAP + s1) * D;
                u32x2 w0[8], w1[8];
#pragma unroll
                for (int j = 0; j < 8; ++j) { w0[j] = *(const u32x2*)(y0 + lane * 4 + 256 * j); w1[j] = *(const u32x2*)(y1 + lane * 4 + 256 * j); }
                const float k1 = (e1 >= 0) ? 1.f : 0.f;
#pragma unroll
                for (int j = 0; j < 8; ++j) { f[j].x += bflo(w0[j].x) + k1 * bflo(w1[j].x); f[j].y += bfhi(w0[j].x) + k1 * bfhi(w1[j].x); f[j].z += bflo(w0[j].y) + k1 * bflo(w1[j].y); f[j].w += bfhi(w0[j].y) + k1 * bfhi(w1[j].y); }
            }
            float ss = 0.f;
#pragma unroll
            for (int j = 0; j < 8; ++j) {
                f[j] = (f32x4){bflo(xw[j].x), bfhi(xw[j].x), bflo(xw[j].y), bfhi(xw[j].y)} + m5v[j] * f[j];
                ss += (f[j].x * f[j].x + f[j].y * f[j].y) + (f[j].z * f[j].z + f[j].w * f[j].w); }
            const float rstd = rsqrtf(wave_sum(ss) * (1.f / D) + EPS);
#pragma unroll
            for (int j = 0; j < 8; ++j) { const int c = lane * 4 + 256 * j; *(f32x4*)(a.out + (size_t)r * D + c) = f[j] * rstd * fnv[j]; }
            myslot = nslot;
#pragma unroll
            for (int j = 0; j < 8; ++j) xw[j] = xn[j];
        }
    }
}

#define XB_TMO      128
#define XB_XCNT(j)  (256  + 64 * (j))
#define XB_XSUB(j)  (1280 + 64 * (j))
#define XB_XGEN(j)  (2304 + 64 * (j))
#define XB_TOP      3328
#define XB_TOPGEN   3392
#define XCD_BAR_WORDS 3456
#define XB_SPIN_CAP (1u << 18)
__device__ __forceinline__ unsigned xb_ld(unsigned* p)              { return __hip_atomic_load(p, __ATOMIC_RELAXED, __HIP_MEMORY_SCOPE_AGENT); }
__device__ __forceinline__ unsigned xb_add(unsigned* p, unsigned v) { return __hip_atomic_fetch_add(p, v, __ATOMIC_RELAXED, __HIP_MEMORY_SCOPE_AGENT); }
__device__ __forceinline__ unsigned xb_xcc_id() { return (unsigned)__builtin_amdgcn_s_getreg((3 << 11) | 20) & 0xFu; }
#define XB_SPIN(cond, bar) do { unsigned _sp = 0; while (cond) { __builtin_amdgcn_s_sleep(1); \
    if ((++_sp & 255u) == 0u) { if (xb_ld(&(bar)[XB_TMO])) break; if (_sp > XB_SPIN_CAP) { atomicAdd(&(bar)[XB_TMO], 1u); break; } } } } while (0)
struct XcdBarrier { unsigned* bar; unsigned x; volatile LAS unsigned* st; };
__device__ __forceinline__ XcdBarrier xcd_barrier_post(unsigned* bar, volatile LAS unsigned* st) {
    XcdBarrier b; b.bar = bar; b.x = xb_xcc_id(); b.st = st;
    if (threadIdx.x == 0) (void)xb_add(&bar[XB_XCNT(b.x)], 1u);
    return b;
}
__device__ __forceinline__ void xcd_barrier_complete(unsigned* bar, unsigned x, unsigned& nloc, unsigned& nx) {
    const unsigned G = gridDim.x * gridDim.y * gridDim.z;
    unsigned sum, cnt, mine, sp = 0u;
    for (;;) {
        sum = 0u; cnt = 0u; mine = 0u;
#pragma unroll
        for (unsigned j = 0; j < 16; ++j) { const unsigned c = xb_ld(&bar[XB_XCNT(j)]); sum += c; cnt += (c > 0u) ? 1u : 0u; mine = (j == x) ? c : mine; }
        if (sum == G) break;
        __builtin_amdgcn_s_sleep(1);
        if ((++sp & 255u) == 0u) { if (xb_ld(&bar[XB_TMO])) break; if (sp > XB_SPIN_CAP) { atomicAdd(&bar[XB_TMO], 1u); break; } }
    }
    nloc = mine > 0u ? mine : 1u; nx = cnt > 0u ? cnt : 1u;
}
__device__ __forceinline__ void xcd_barrier_at(unsigned* bar_, const XcdBarrier& b) {
    asm volatile("s_waitcnt vmcnt(0)" ::: "memory");
    __syncthreads();
    if (threadIdx.x == 0) {
        unsigned* bar = bar_;
        const unsigned bx = (unsigned)__builtin_amdgcn_readfirstlane((int)xb_xcc_id());
        __builtin_amdgcn_s_waitcnt(0);
        unsigned nloc = b.st[0], nx = b.st[1];
        if (nloc == 0u) { xcd_barrier_complete(bar, bx, nloc, nx); b.st[0] = nloc; b.st[1] = nx; }
        const unsigned old = xb_add(&bar[XB_XSUB(bx)], 1u);
        const unsigned gen = old / nloc;
        if (old + 1u == (gen + 1u) * nloc) {
            __builtin_amdgcn_fence(__ATOMIC_RELEASE, "agent");
            asm volatile("s_waitcnt vmcnt(0)" ::: "memory");
            const unsigned og = xb_add(&bar[XB_TOP], 1u);
            const unsigned tg = og / nx;
            if (og + 1u == (tg + 1u) * nx) xb_add(&bar[XB_TOPGEN], 1u);
            else XB_SPIN(xb_ld(&bar[XB_TOPGEN]) == tg, bar);
            __builtin_amdgcn_fence(__ATOMIC_ACQUIRE, "agent");
            xb_add(&bar[XB_XGEN(bx)], 1u);
            asm volatile("s_waitcnt vmcnt(0)" ::: "memory");
        } else {
            XB_SPIN(xb_ld(&bar[XB_XGEN(bx)]) == gen, bar);
            __builtin_amdgcn_fence(__ATOMIC_ACQUIRE, "agent");
            asm volatile("s_waitcnt vmcnt(0)" ::: "memory");
        }
    }
    __syncthreads();
}

constexpr int NPHASE = 13;
constexpr int ZFILL = 76;
__global__ void __launch_bounds__(NTHR, 2) fwd(Args a) {
    extern __shared__ __attribute__((aligned(16))) unsigned char lds_raw[];
    LAS unsigned char* lds = (LAS unsigned char*)lds_raw;
#if ONE_LAUNCH
    constexpr int lo = 0, hi = NPHASE;
#else
    const int lo = a.ph_lo, hi = a.ph_hi;
#endif
    const int G = gridDim.x, cidx = blockIdx.x;
    unsigned char* ws = a.ws;
    volatile LAS unsigned* bst = (volatile LAS unsigned*)(lds + LDS_BYTES - 16);
    if (threadIdx.x < 4) bst[threadIdx.x] = 0u;
    __syncthreads();
    XcdBarrier xbar = xcd_barrier_post((unsigned*)(ws + WS_BAR), bst);
#ifndef PHASE_MASK
#define PHASE_MASK 0xFFFF
#endif
#define IN(k) (((PHASE_MASK >> (k)) & 1) && lo <= (k) && (k) < hi)
#ifndef REPEAT_MASK
#define REPEAT_MASK 0
#endif
#define REP(k) (1 + ((REPEAT_MASK >> (k)) & 1))
#define SEAM(k) do { if (IN(k) && IN((k) + 1)) { if (gridDim.x > 1024u) cg::this_grid().sync(); else xcd_barrier_at((unsigned*)(a.ws + WS_BAR), xbar); } } while (0)
    if (IN(0)) for (int rep_ = 0; rep_ < REP(0); ++rep_) { if (rep_) cg::this_grid().sync(); phase_prep(a, lds); } SEAM(0);
    if (IN(1)) for (int rep_ = 0; rep_ < REP(1); ++rep_) { if (rep_) cg::this_grid().sync(); phase_norm1(a, lds); } SEAM(1);
    if (IN(2)) for (int rep_ = 0; rep_ < REP(2); ++rep_) { if (rep_) cg::this_grid().sync();
        if (G >= 256 && ((cidx >> 3) & 1)) { conv_small(a, lds, ((cidx >> 4) * 8 + (cidx & 7)) * NWAVES + (int)(threadIdx.x >> 6), 128 * NWAVES); __syncthreads(); }
        pg8::SchedTwo S; S.G = G; S.c = cidx;
        S.a.init(MTOT, 29 * 256, 1, 0, ws + WS_R1 + R1_H, ws + WS_R1 + R1_WINT, (size_t)256 * D * 2, (size_t)256 * D * 2, 0, 0, 1); S.na = S.a.nwg;
        S.b.init(MLAT, 4 * 256, 1, 0, ws + WS_R1 + R1_H, ws + WS_R1 + R1_WINT, (size_t)256 * D * 2, (size_t)256 * D * 2, 0, 0, 4);
        S.nextra = (G >= 256) ? ZFILL : 0;
        pg8::EpiP E{(bf16_t*)(ws + WS_P), (float*)(ws + WS_AB), 1.f};
        pg8::gemm_phase<pg8::EpiP, pg8::SchedTwo, false>(lds, D, D, D, S, E);
    } SEAM(2);
    if (IN(3)) for (int rep_ = 0; rep_ < REP(3); ++rep_) { if (rep_) cg::this_grid().sync();
        gdnprep_conv(a, lds); xcd_barrier_at((unsigned*)(a.ws + WS_BAR), xbar);
        if (G < 256 || cidx < 128) phase_scan(a, lds);
        if (G < 256 || cidx >= 128) {
            const int Gg = (G < 256) ? G : 128, cg_ = (G < 256) ? cidx : cidx - 128;
            {
                pg8::SchedPlain S; S.init(MLAT, 20 * 256, Gg, cg_, ws + WS_R2 + R2_H8, ws + WS_WIN8, (size_t)256 * D, (size_t)256 * D, 0, 0, 3);
                pg8::EpiP E{(bf16_t*)(ws + WS_P), (float*)(ws + WS_AB), 1.f / W8_SCALE};
                pg8::gemm_phase<pg8::EpiP, pg8::SchedPlain, false, true>(lds, D / 2, D / 2, D / 2, S, E);
            }
            {
                pg8::SchedPlain S; S.init(MLAT, 4 * 256, Gg, cg_, ws + WS_R1 + R1_H, ws + WS_R1 + R1_WINT, (size_t)256 * D * 2, (size_t)256 * D * 2, 0, 0, 4);
                if (G >= 256) S.ubeg = ZFILL;
                pg8::EpiP E{(bf16_t*)(ws + WS_P), (float*)(ws + WS_AB), 1.f};
                pg8::gemm_phase<pg8::EpiP, pg8::SchedPlain, false>(lds, D, D, D, S, E);
            }
        }
        trq_drain(a, lds, 0x7fffffff, (G >= 256) ? 384u : 768u, -1);
    } SEAM(3);
    if (IN(4)) for (int rep_ = 0; rep_ < REP(4); ++rep_) { if (rep_) cg::this_grid().sync(); phase_mergeprep(a); } SEAM(4);
    if (IN(5)) for (int rep_ = 0; rep_ < REP(5); ++rep_) { if (rep_) cg::this_grid().sync();
        if (G >= 256 && ((cidx >> 3) & 1)) trq_drain(a, lds, 1, 0u, 512 + (cidx >> 4) * 8 + (cidx & 7));
        pg8::SchedPlain S; S.init(MLAT, D, G, cidx, ws + WS_R1 + R1_YAB, ws + WS_WAB, (size_t)256 * D * 2, (size_t)256 * D * 2, 1, (size_t)1024 * 2);
        pg8::EpiMerge E{(const bf16_t*)(ws + WS_P), (bf16_t*)a.out};
        pg8::gemm_phase<pg8::EpiMerge, pg8::SchedPlain, true>(lds, 1024, D, D, S, E);
    } SEAM(5);
    if (IN(6)) for (int rep_ = 0; rep_ < REP(6); ++rep_) { if (rep_) cg::this_grid().sync();
        if (G >= 256 && ((cidx >> 3) & 1)) trq_drain(a, lds, 1, 0u, 640 + (cidx >> 4) * 8 + (cidx & 7));
        pg8::SchedPlain S; S.init(MLAT, D, G, cidx, (const void*)a.out, ws + WS_WOUT, (size_t)256 * D * 2, (size_t)256 * D * 2);
        pg8::EpiX1 E{a.x, (const modfx_t*)(ws + WS_MOD), a.ada_b, (bf16_t*)(ws + WS_P + P_X1)};
        pg8::gemm_phase<pg8::EpiX1, pg8::SchedPlain, false>(lds, D, D, D, S, E);
    } SEAM(6);
    if (IN(7)) for (int rep_ = 0; rep_ < REP(7); ++rep_) { if (rep_) cg::this_grid().sync(); phase_norm2(a, lds); } SEAM(7);
    if (IN(8)) for (int rep_ = 0; rep_ < REP(8); ++rep_) { if (rep_) cg::this_grid().sync();
        if (G >= 256 && cidx >= 128) trq_drain(a, lds, 1, 0u, 384 + (cidx - 128));
        else phase_topk(a, lds); } SEAM(8);
    if (IN(9)) for (int rep_ = 0; rep_ < REP(9); ++rep_) { (void)rep_; }
    if (IN(10)) for (int rep_ = 0; rep_ < REP(10); ++rep_) { if (rep_) cg::this_grid().sync();
        for (int it0 = cidx; it0 < 256; it0 += G) {
            const int it = (G >= 256) ? ((it0 & 7) * 32 + (it0 >> 3)) : it0;
            const int e = it >> 4, b = (it >> 2) & 3, hf = (it >> 1) & 1, pm = (b * 16 + e) * 2 + hf;
            pg8::SchedMoeG S{(const char*)(ws + WS_R1 + R1_H2) + (size_t)b * SEQ * D, (const char*)(ws + WS_R2), (size_t)256 * D, (const int*)(ws + WS_IDX) + pm * 256, e, pm, 4 * (it & 1)};
            pg8::EpiHact E{(unsigned char*)(ws + WS_P + P_HACT)};
            pg8::gemm_phase<pg8::EpiHact, pg8::SchedMoeG, false, true, true>(lds, D / 2, D / 2, D / 2, S, E);
        }
    } SEAM(10);
    if (IN(11)) for (int rep_ = 0; rep_ < REP(11); ++rep_) { if (rep_) cg::this_grid().sync();
        for (int it0 = cidx; it0 < 256; it0 += G) {
            const int it = (G >= 256) ? ((it0 & 7) * 32 + (it0 >> 3)) : it0;
            const int e = it >> 4, b = (it >> 2) & 3, hf = (it >> 1) & 1, pm = (b * 16 + e) * 2 + hf;
            pg8::SchedMoeG S{(const char*)(ws + WS_P + P_HACT) + (size_t)pm * 256 * DE, (const char*)(ws + WS_R2 + 67108864), (size_t)256 * DE, (const int*)nullptr, e, pm, 4 * (it & 1)};
            pg8::EpiYE E{(const float*)(ws + WS_GATEV), (bf16_t*)(ws + WS_P + P_WGU)};
            pg8::gemm_phase<pg8::EpiYE, pg8::SchedMoeG, false, true>(lds, DE / 2, DE / 2, DE / 2, S, E);
        }
    } SEAM(11);
    if (IN(12)) for (int rep_ = 0; rep_ < REP(12); ++rep_) { if (rep_) cg::this_grid().sync(); phase_final(a); }
#undef IN
#undef SEAM
}

extern "C" void kernel_launch(void* const* d_in, const int* in_sizes, int n_in, void* d_out, int out_size, void* d_ws, size_t ws_size, hipStream_t stream) {
    static int grid = 0;
    if (grid == 0) {
        if (n_in != 23 || out_size != MLAT * D || ws_size < WS_END) { fprintf(stderr, "kernel_launch: unexpected shapes: n_in %d out %d ws %zu (need %zu)\n", n_in, out_size, ws_size, (size_t)WS_END); grid = -1; return; }
        int dev = 0, cus = 0, per_cu = 0;
        if (hipGetDevice(&dev) != hipSuccess || hipDeviceGetAttribute(&cus, hipDeviceAttributeMultiprocessorCount, dev) != hipSuccess) { grid = -1; return; }
        if (hipFuncSetAttribute((const void*)fwd, hipFuncAttributeMaxDynamicSharedMemorySize, LDS_BYTES) != hipSuccess) { fprintf(stderr, "kernel_launch: hipFuncSetAttribute failed\n"); grid = -1; return; }
        if (hipOccupancyMaxActiveBlocksPerMultiprocessor(&per_cu, (const void*)fwd, NTHR, LDS_BYTES) != hipSuccess || per_cu < 1) { fprintf(stderr, "kernel_launch: occupancy query says %d\n", per_cu); per_cu = 1; }
        (void)hipGetLastError();
        grid = cus;
    }
    if (grid < 0) return;
    Args a{};
    a.x = (const float*)d_in[0]; a.c = (const float*)d_in[1]; a.ctx = (const float*)d_in[2]; a.c_ctx = (const float*)d_in[3]; a.ada_w = (const float*)d_in[4]; a.ada_b = (const float*)d_in[5];
    a.norm_mix = (const float*)d_in[6]; a.norm_ffn = (const float*)d_in[7]; a.w_in = (const float*)d_in[8]; a.gdn_conv = (const float*)d_in[9]; a.a_log = (const float*)d_in[10]; a.dt_bias = (const float*)d_in[11];
    a.hgrn_lb = (const float*)d_in[12]; a.hgrn_norm = (const float*)d_in[13]; a.gdn_norm = (const float*)d_in[14]; a.w_ba = (const float*)d_in[15]; a.w_bb = (const float*)d_in[16]; a.w_out = (const float*)d_in[17];
    a.router_w = (const float*)d_in[18]; a.w_gate = (const float*)d_in[19]; a.w_up = (const float*)d_in[20]; a.w_down = (const float*)d_in[21]; a.final_norm = (const float*)d_in[22];
    a.out = (float*)d_out; a.ws = (unsigned char*)d_ws;
    (void)hipMemsetAsync((char*)d_ws + WS_BAR, 0, 16384 + 245760, stream);
#if ONE_LAUNCH
    a.ph_lo = 0; a.ph_hi = NPHASE;
    void* args[] = {&a};
    hipError_t e = hipLaunchCooperativeKernel((const void*)fwd, dim3(grid), dim3(NTHR), args, LDS_BYTES, stream);
    if (e != hipSuccess) fprintf(stderr, "kernel_launch: cooperative launch failed: %s (grid %d)\n", hipGetErrorString(e), grid);
#else
    for (int p = 0; p < NPHASE; ++p) { a.ph_lo = p; a.ph_hi = p + 1; hipLaunchKernelGGL(fwd, dim3(grid), dim3(NTHR), LDS_BYTES, stream, a); }
#endif
}
```
